# Optimizing an MI355X kernel written in HIP

```python
import math
import jax, jax.numpy as jnp
from jax import lax
import numpy as np

D_MODEL = 1024
BATCH = 2
SEQ = 8192
DEPTH = 2

N_MEM = 256
CONV_CH = D_MODEL // 4
CONV_WIDTH = 31
DSA_HEADS = 8
DSA_HEAD_DIM = D_MODEL // 16
DSA_WIDTH = DSA_HEADS * DSA_HEAD_DIM
KV_RANK = D_MODEL // 8
IDX_HEADS = 4
IDX_DIM = 64
DSA_TOPK = 256
Q_BLOCK = 128
MLSTM_HEADS = 4
MLSTM_HEAD_DIM = D_MODEL // 16
MLSTM_WIDTH = MLSTM_HEADS * MLSTM_HEAD_DIM
MLSTM_CONV = 4
MLSTM_CHUNK = 64
MIX_WIDTH = CONV_CH + DSA_WIDTH + MLSTM_WIDTH
REL_BUCKETS = 32
REL_MAX_DIST = 128
XATTN_HEADS = 4
XATTN_HEAD_DIM = D_MODEL // XATTN_HEADS
PEER_HEADS = 8
PEER_KEYS = 128
PEER_EXPERTS = PEER_KEYS * PEER_KEYS
PEER_QDIM = 256
PEER_TOPK = 16
PEER_BLOCK = 128
DEEPNORM_ALPHA = (2.0 * DEPTH) ** 0.25
DEEPNORM_BETA = (8.0 * DEPTH) ** -0.25
LN_EPS = 1e-5

SPLIT_SIZES = (2 * CONV_CH,
               DSA_WIDTH, KV_RANK,
               IDX_HEADS * IDX_DIM, IDX_DIM, IDX_HEADS,
               MLSTM_WIDTH, MLSTM_WIDTH, MLSTM_WIDTH,
               MLSTM_HEADS, MLSTM_HEADS)
PROJ_WIDTH = sum(SPLIT_SIZES)
SPLIT_POINTS = tuple(int(p) for p in np.cumsum(SPLIT_SIZES)[:-1])

kernel_name = 'hybrid_conv_dsa_mlstm_peer_trunk'


def layer_norm(x, g, b):
    xf = x.astype(jnp.float32)
    mu = xf.mean(-1, keepdims=True)
    var = jnp.square(xf - mu).mean(-1, keepdims=True)
    return ((xf - mu) * lax.rsqrt(var + LN_EPS)).astype(x.dtype) * g + b


def rms_norm(x, g):
    xf = x.astype(jnp.float32)
    return (xf * lax.rsqrt(jnp.square(xf).mean(-1, keepdims=True) + LN_EPS)).astype(x.dtype) * g


def head_norm(h, g):
    B, L, H, dh = h.shape
    hf = h.astype(jnp.float32)
    mu = hf.mean(-1, keepdims=True)
    var = jnp.square(hf - mu).mean(-1, keepdims=True)
    hn = ((hf - mu) * lax.rsqrt(var + LN_EPS)).astype(h.dtype)
    return hn.reshape(B, L, H * dh) * g


def causal_depthwise_conv(x, w, b):
    K, C = w.shape
    xp = jnp.pad(x, ((0, 0), (K - 1, 0), (0, 0)))
    out = lax.conv_general_dilated(xp, w.reshape(K, 1, C), window_strides=(1,), padding='VALID',
                                   dimension_numbers=('NWC', 'WIO', 'NWC'), feature_group_count=C)
    return out + b


def rel_bucket(dist):
    max_exact = REL_BUCKETS // 2
    d = jnp.maximum(dist, 0)
    df = jnp.maximum(d, 1).astype(jnp.float32)
    large = max_exact + (jnp.log(df / max_exact) / math.log(REL_MAX_DIST / max_exact)
                         * (REL_BUCKETS - max_exact)).astype(jnp.int32)
    large = jnp.minimum(large, REL_BUCKETS - 1)
    return jnp.where(d < max_exact, d, large)


def conformer_conv_group(a_in, conv_w, conv_b, ln_g, ln_b):
    val, gate = jnp.split(a_in, 2, axis=-1)
    u = val * jax.nn.sigmoid(gate)
    u = causal_depthwise_conv(u, conv_w, conv_b)
    return jax.nn.silu(layer_norm(u, ln_g, ln_b))


def dsa_group(q, c_kv, q_idx, k_idx, w_idx, w_uk, w_uv, rel_bias):
    B, L = q.shape[0], q.shape[1]
    k_sel = min(DSA_TOPK, L // 4)
    n_blocks = L // Q_BLOCK
    q_lat = jnp.einsum('blhd,hdr->blhr', q, w_uk)
    key_pos = jnp.arange(L)
    attn_scale = DSA_HEAD_DIM ** -0.5
    idx_scale = IDX_DIM ** -0.5
    w_scale = IDX_HEADS ** -0.5

    def block(i):
        start = i * Q_BLOCK
        qi = lax.dynamic_slice_in_dim(q_idx, start, Q_BLOCK, axis=1)
        wi = lax.dynamic_slice_in_dim(w_idx, start, Q_BLOCK, axis=1)
        ql = lax.dynamic_slice_in_dim(q_lat, start, Q_BLOCK, axis=1)
        qpos = start + jnp.arange(Q_BLOCK)
        rel = jax.nn.relu(jnp.einsum('bqhd,bsd->bqhs', qi, k_idx) * idx_scale)
        score = jnp.einsum('bqhs,bqh->bqs', rel, wi * w_scale).astype(jnp.float32)
        causal = key_pos[None, :] <= qpos[:, None]
        score = jnp.where(causal[None], score, -jnp.inf)
        _, sel = lax.top_k(score, k_sel)
        valid = sel <= qpos[None, :, None]
        c_sel = jax.vmap(lambda c, ix: c[ix])(c_kv, sel)
        logits = jnp.einsum('bqhr,bqkr->bhqk', ql, c_sel).astype(jnp.float32) * attn_scale
        bias = rel_bias.astype(jnp.float32)[rel_bucket(qpos[None, :, None] - sel)]
        logits = logits + jnp.moveaxis(bias, -1, 1)
        logits = jnp.where(valid[:, None], logits, -jnp.inf)
        p = jax.nn.softmax(logits, axis=-1).astype(c_sel.dtype)
        o_lat = jnp.einsum('bhqk,bqkr->bqhr', p, c_sel)
        return jnp.einsum('bqhr,hrd->bqhd', o_lat, w_uv)

    out = lax.map(block, jnp.arange(n_blocks))
    return jnp.moveaxis(out, 0, 1).reshape(B, L, DSA_WIDTH)


def mlstm_chunkwise(q, k, v, i_pre, f_pre):
    B, H, L, dh = q.shape
    C = MLSTM_CHUNK
    nc = L // C

    def to_chunks(a):
        return jnp.moveaxis(a.reshape(B, H, nc, C, *a.shape[3:]), 2, 0)

    qc, kc, vc = to_chunks(q * dh ** -0.5), to_chunks(k), to_chunks(v)
    ic, fc = to_chunks(i_pre), to_chunks(jax.nn.log_sigmoid(f_pre))
    tri = jnp.tril(jnp.ones((C, C), dtype=bool))

    def step(carry, inp):
        Cm, n, m = carry
        qj, kj, vj, ij, fj = inp
        b = jnp.cumsum(fj, axis=-1)
        Dm = jnp.where(tri, b[..., :, None] - b[..., None, :] + ij[..., None, :], -jnp.inf)
        inter = b + m[..., None]
        m_row = jnp.maximum(inter, Dm.max(-1))
        w_inter = jnp.exp(inter - m_row)
        S = jnp.einsum('bhtd,bhsd->bhts', qj, kj) * jnp.exp(Dm - m_row[..., None])
        num = (jnp.einsum('bhts,bhsd->bhtd', S, vj)
               + w_inter[..., None] * jnp.einsum('bhvk,bhtk->bhtv', Cm, qj))
        den = S.sum(-1) + w_inter * jnp.einsum('bhk,bhtk->bht', n, qj)
        h = num / jnp.maximum(jnp.abs(den), jnp.exp(-m_row))[..., None]
        bL = b[..., -1]
        g = bL[..., None] - b + ij
        m_new = jnp.maximum(bL + m, g.max(-1))
        decay = jnp.exp(bL + m - m_new)
        wg = jnp.exp(g - m_new[..., None])
        Cm = decay[..., None, None] * Cm + jnp.einsum('bhs,bhsv,bhsk->bhvk', wg, vj, kj)
        n = decay[..., None] * n + jnp.einsum('bhs,bhsk->bhk', wg, kj)
        return (Cm, n, m_new), h

    init = (jnp.zeros((B, H, dh, dh), jnp.float32), jnp.zeros((B, H, dh), jnp.float32),
            jnp.zeros((B, H), jnp.float32))
    _, hs = lax.scan(step, init, (qc, kc, vc, ic, fc))
    return jnp.moveaxis(hs, 0, 2).reshape(B, H, L, dh)


def mlstm_group(xc_in, v_in, o_pre, i_pre, f_pre, conv_w, conv_b, w_qm, w_km, b_i, b_f, norm_g):
    B, L, _ = xc_in.shape
    H, dh = MLSTM_HEADS, MLSTM_HEAD_DIM
    xc = jax.nn.silu(causal_depthwise_conv(xc_in, conv_w, conv_b)).reshape(B, L, H, dh)
    q = jnp.einsum('blhd,hde->bhle', xc, w_qm).astype(jnp.float32)
    k = jnp.einsum('blhd,hde->bhle', xc, w_km).astype(jnp.float32)
    v = v_in.reshape(B, L, H, dh).transpose(0, 2, 1, 3).astype(jnp.float32)
    ig = (i_pre + b_i).astype(jnp.float32).transpose(0, 2, 1)
    fg = (f_pre + b_f).astype(jnp.float32).transpose(0, 2, 1)
    h = mlstm_chunkwise(q, k, v, ig, fg).astype(xc_in.dtype)
    h = head_norm(h.transpose(0, 2, 1, 3), norm_g)
    return jax.nn.sigmoid(o_pre) * h


def memory_cross_attention(x, mem, w_q, w_kv, w_o):
    B, L, D = x.shape
    M = mem.shape[1]
    q = (x @ w_q).reshape(B, L, XATTN_HEADS, XATTN_HEAD_DIM)
    k, v = jnp.split(mem @ w_kv, 2, axis=-1)
    k = k.reshape(B, M, XATTN_HEADS, XATTN_HEAD_DIM)
    v = v.reshape(B, M, XATTN_HEADS, XATTN_HEAD_DIM)
    logits = jnp.einsum('blhd,bmhd->bhlm', q, k).astype(jnp.float32) * XATTN_HEAD_DIM ** -0.5
    p = jax.nn.softmax(logits, axis=-1).astype(x.dtype)
    o = jnp.einsum('bhlm,bmhd->blhd', p, v).reshape(B, L, D)
    return o @ w_o


def peer(x, w_pq, sub_k1, sub_k2, peer_u, peer_v):
    B, L, D = x.shape
    T = B * L
    t = x.reshape(T, D)
    q = (t @ w_pq).reshape(T, PEER_HEADS, PEER_QDIM)
    q1, q2 = jnp.split(q, 2, axis=-1)
    s1 = jnp.einsum('thd,nd->thn', q1, sub_k1).astype(jnp.float32)
    s2 = jnp.einsum('thd,nd->thn', q2, sub_k2).astype(jnp.float32)
    v1, i1 = lax.top_k(s1, PEER_TOPK)
    v2, i2 = lax.top_k(s2, PEER_TOPK)
    cand = (v1[..., :, None] + v2[..., None, :]).reshape(T, PEER_HEADS, PEER_TOPK * PEER_TOPK)
    cand_idx = (i1[..., :, None] * PEER_KEYS + i2[..., None, :]).reshape(T, PEER_HEADS, PEER_TOPK * PEER_TOPK)
    top_s, pos = lax.top_k(cand, PEER_TOPK)
    experts = jnp.take_along_axis(cand_idx, pos, axis=-1)
    gates = jax.nn.softmax(top_s, axis=-1).astype(x.dtype)

    def block(i):
        start = i * PEER_BLOCK
        xs = lax.dynamic_slice_in_dim(t, start, PEER_BLOCK, axis=0)
        e = lax.dynamic_slice_in_dim(experts, start, PEER_BLOCK, axis=0)
        g = lax.dynamic_slice_in_dim(gates, start, PEER_BLOCK, axis=0)
        act = jax.nn.gelu(jnp.einsum('thkd,td->thk', peer_u[e], xs), approximate=False)
        return jnp.einsum('thk,thkd->td', g * act, peer_v[e])

    out = lax.map(block, jnp.arange(T // PEER_BLOCK))
    return out.reshape(B, L, D)


def setup_inputs(seed: int = 0) -> dict:
    key = jax.random.key(seed)
    ks = iter(jax.random.split(key, 40))

    def nrm(shape, scale):
        return scale * jax.random.normal(next(ks), shape, jnp.float32)

    def gain(shape):
        return 1.0 + nrm(shape, 0.02)

    Dm, Lr = D_MODEL, DEPTH
    beta = DEEPNORM_BETA
    return {
        'x': nrm((BATCH, SEQ, Dm), 1.0),
        'mem': nrm((BATCH, N_MEM, Dm), 1.0),
        'ln_in_g': gain((Dm,)),
        'ln_in_b': nrm((Dm,), 0.02),
        'rel_bias': nrm((REL_BUCKETS, DSA_HEADS), 0.5),
        'w_in': nrm((Lr, Dm, PROJ_WIDTH), Dm ** -0.5),
        'conv_a_w': nrm((Lr, CONV_WIDTH, CONV_CH), CONV_WIDTH ** -0.5),
        'conv_a_b': nrm((Lr, CONV_CH), 0.02),
        'norm_a_g': gain((Lr, CONV_CH)),
        'norm_a_b': nrm((Lr, CONV_CH), 0.02),
        'kv_norm_g': gain((Lr, KV_RANK)),
        'w_uk': nrm((Lr, DSA_HEADS, DSA_HEAD_DIM, KV_RANK), DSA_HEAD_DIM ** -0.5),
        'w_uv': nrm((Lr, DSA_HEADS, KV_RANK, DSA_HEAD_DIM), KV_RANK ** -0.5),
        'conv_m_w': nrm((Lr, MLSTM_CONV, MLSTM_WIDTH), MLSTM_CONV ** -0.5),
        'conv_m_b': nrm((Lr, MLSTM_WIDTH), 0.02),
        'w_qm': nrm((Lr, MLSTM_HEADS, MLSTM_HEAD_DIM, MLSTM_HEAD_DIM), MLSTM_HEAD_DIM ** -0.5),
        'w_km': nrm((Lr, MLSTM_HEADS, MLSTM_HEAD_DIM, MLSTM_HEAD_DIM), MLSTM_HEAD_DIM ** -0.5),
        'b_i': nrm((Lr, MLSTM_HEADS), 0.1),
        'b_f': jnp.linspace(3.0, 6.0, MLSTM_HEADS)[None, :] + nrm((Lr, MLSTM_HEADS), 0.1),
        'norm_m_g': gain((Lr, MLSTM_WIDTH)),
        'w_out': nrm((Lr, MIX_WIDTH, Dm), beta * MIX_WIDTH ** -0.5),
        'ln1_g': gain((Lr, Dm)),
        'ln1_b': nrm((Lr, Dm), 0.02),
        'w_cq': nrm((Lr, Dm, Dm), Dm ** -0.5),
        'w_ckv': nrm((Lr, Dm, 2 * Dm), Dm ** -0.5),
        'w_co': nrm((Lr, Dm, Dm), beta * Dm ** -0.5),
        'ln2_g': gain((Lr, Dm)),
        'ln2_b': nrm((Lr, Dm), 0.02),
        'w_pq': nrm((Lr, Dm, PEER_HEADS * PEER_QDIM), Dm ** -0.5),
        'sub_k1': nrm((Lr, PEER_KEYS, PEER_QDIM // 2), (PEER_QDIM // 2) ** -0.5),
        'sub_k2': nrm((Lr, PEER_KEYS, PEER_QDIM // 2), (PEER_QDIM // 2) ** -0.5),
        'peer_u': nrm((Lr, PEER_EXPERTS, Dm), Dm ** -0.5),
        'peer_v': nrm((Lr, PEER_EXPERTS, Dm), beta * PEER_HEADS ** -0.5),
        'ln3_g': gain((Lr, Dm)),
        'ln3_b': nrm((Lr, Dm), 0.02),
    }


def reference(x, mem, ln_in_g, ln_in_b, rel_bias, w_in, conv_a_w, conv_a_b, norm_a_g, norm_a_b,
              kv_norm_g, w_uk, w_uv, conv_m_w, conv_m_b, w_qm, w_km, b_i, b_f, norm_m_g, w_out,
              ln1_g, ln1_b, w_cq, w_ckv, w_co, ln2_g, ln2_b, w_pq, sub_k1, sub_k2, peer_u, peer_v,
              ln3_g, ln3_b):
    B, L, D = x.shape
    x = layer_norm(x, ln_in_g, ln_in_b)
    for l in range(DEPTH):
        h = x @ w_in[l]
        (a_in, q_b, c_b, qi_b, ki_b, wi_b, xc_m, v_m, o_m, i_m, f_m) = jnp.split(h, SPLIT_POINTS, axis=-1)
        y_a = conformer_conv_group(a_in, conv_a_w[l], conv_a_b[l], norm_a_g[l], norm_a_b[l])
        y_b = dsa_group(q_b.reshape(B, L, DSA_HEADS, DSA_HEAD_DIM), rms_norm(c_b, kv_norm_g[l]),
                        qi_b.reshape(B, L, IDX_HEADS, IDX_DIM), ki_b, wi_b, w_uk[l], w_uv[l], rel_bias)
        y_c = mlstm_group(xc_m, v_m, o_m, i_m, f_m, conv_m_w[l], conv_m_b[l], w_qm[l], w_km[l],
                          b_i[l], b_f[l], norm_m_g[l])
        y = jnp.concatenate([y_a, y_b, y_c], axis=-1) @ w_out[l]
        x = layer_norm(DEEPNORM_ALPHA * x + y, ln1_g[l], ln1_b[l])
        y = memory_cross_attention(x, mem, w_cq[l], w_ckv[l], w_co[l])
        x = layer_norm(DEEPNORM_ALPHA * x + y, ln2_g[l], ln2_b[l])
        y = peer(x, w_pq[l], sub_k1[l], sub_k2[l], peer_u[l], peer_v[l])
        x = layer_norm(DEEPNORM_ALPHA * x + y, ln3_g[l], ln3_b[l])
    return x
```

```cpp
#include <hip/hip_runtime.h>
#include <cstdio>
#include <cstdint>
namespace pg8 {
#define PG8_LAS __attribute__((address_space(3)))
typedef unsigned short bf16_t;
typedef short bf16x8 __attribute__((ext_vector_type(8)));
typedef float f32x4 __attribute__((ext_vector_type(4)));
typedef unsigned u32x4 __attribute__((ext_vector_type(4)));
constexpr int BM = 256, BK = 64, HALF = 128, HTB = HALF * BK * 2  , STAGE_BYTES = 8 * HTB, NXCD = 8, WGM = 8;

__host__ __device__ __forceinline__ int lds_byte(int r, int c) { const int st = (r >> 4) * 2 + (c >> 5), rr = r & 15, cc = c & 31, ob = rr * 64 + cc * 2; return st * 1024 + (ob ^ (((ob >> 9) & 1) << 5)); }
__host__ __device__ __forceinline__ void stage_rc(int b, int& R, int& C) { const int st = b / 1024, sb = b % 1024, swz = sb ^ (((sb >> 9) & 1) << 5); R = (st >> 1) * 16 + swz / 64; C = (st & 1) * 32 + (swz % 64) / 2; }
__host__ __device__ __forceinline__ int perm32(int rho) { const int n = rho >> 4, i = rho & 15; return 8 * (i >> 2) + 4 * n + (i & 3); }

struct Unit { int pm, pn; };
struct Gemm { const bf16_t* A; const bf16_t* Bt; int M, N, K; };

struct StaticOrder {
    int nM, nN, nwg, G, c;
    __host__ __device__ void init(int M, int N, int G_, int c_) { nM = M / BM; nN = N / BM; nwg = nM * nN; G = G_; c = c_; }
    __host__ __device__ bool next(int i, Unit& u) const {
        const long L = (long)i * G + c; if (L >= nwg) return false;
        int wgid = (int)L; { const int q = nwg / NXCD, r = nwg % NXCD, xcd = wgid % NXCD, off = wgid / NXCD; wgid = (xcd < r ? xcd * (q + 1) : r * (q + 1) + (xcd - r) * q) + off; }
        const int nig = WGM * nN, gid = wgid / nig, fm = gid * WGM, gsz = (nM - fm) < WGM ? (nM - fm) : WGM;
        u.pm = fm + ((wgid % nig) % gsz); u.pn = (wgid % nig) / gsz; return true;
    }
    __device__ __forceinline__ void a_ready(const Unit&) const {}
    __device__ __forceinline__ void done(const Unit&) const {}
};
__device__ __forceinline__ unsigned cvt_pk_bf16(float lo, float hi) { unsigned r; asm volatile("v_cvt_pk_bf16_f32 %0, %1, %2" : "=v"(r) : "v"(lo), "v"(hi)); return r; }
template <class Epi, class Sched, bool ALIGN_EPI = false, bool SP2 = false>
__device__ __forceinline__ void gemm_phase(PG8_LAS unsigned char* lds, const Gemm g, const Sched& S, const Epi& E) {
    const int tid = threadIdx.x, wid = __builtin_amdgcn_readfirstlane(tid >> 6), lane = tid & 63, wr = wid >> 2, wc = wid & 3, fr = lane & 15, fq = lane >> 4;
    const int K = g.K, nt = K / BK;
    unsigned voffA[2], voffB[2];
#pragma unroll
    for (int i = 0; i < 2; ++i) { int R, C; stage_rc(tid * 16 + i * 8192, R, C); const int Rb = Epi::PERM ? ((R & ~31) + perm32(R & 31)) : R;
        voffA[i] = (unsigned)(R * K + C) * 2u; voffB[i] = (unsigned)(Rb * K + C) * 2u; }
    const size_t kstep = (size_t)(BK * 2);
    const size_t hstep = (size_t)HALF * K * 2;
    const size_t tstep = 2 * hstep;
    const unsigned ldsw = (unsigned)wid * 1024u;
    const int aoff = lds_byte(wr * 64 + fr, fq * 8), boff = lds_byte(wc * 32 + fr, fq * 8);
#define PG8_SA(b, h) (((b) * 2 + (h)) * HTB)
#define PG8_SB(b, h) ((4 + (b) * 2 + (h)) * HTB)
#define PG8_STAGE(bufoff, gbase, voff) do { _Pragma("unroll") for (int _i = 0; _i < 2; ++_i) \
        __builtin_amdgcn_global_load_lds((const unsigned*)((const char*)(gbase) + (voff)[_i]), (PG8_LAS unsigned*)(lds + (bufoff) + ldsw + _i * 8192), 16, 0, 0); } while (0)
#define PG8_LDA(dst, b, h) do { _Pragma("unroll") for (int m = 0; m < 4; ++m) _Pragma("unroll") for (int k = 0; k < 2; ++k) dst[m][k] = *(const PG8_LAS bf16x8*)(lds + PG8_SA(b, h) + aoff + m * 2048 + k * 1024); } while (0)
#define PG8_LDB(dst, b, h) do { _Pragma("unroll") for (int n = 0; n < 2; ++n) _Pragma("unroll") for (int k = 0; k < 2; ++k) dst[n][k] = *(const PG8_LAS bf16x8*)(lds + PG8_SB(b, h) + boff + n * 2048 + k * 1024); } while (0)
#define PG8_MMA(ai, bj, At, Bt) do { __builtin_amdgcn_s_setprio(1); _Pragma("unroll") for (int m = 0; m < 4; ++m) _Pragma("unroll") for (int n = 0; n < 2; ++n) _Pragma("unroll") for (int k = 0; k < 2; ++k) \
        acc[ai][bj][m][n] = __builtin_amdgcn_mfma_f32_16x16x32_bf16(Bt[n][k], At[m][k], acc[ai][bj][m][n], 0, 0, 0); __builtin_amdgcn_s_setprio(0); } while (0)
#define PG8_WAIT_V(n) asm volatile("s_waitcnt vmcnt(" #n ")" ::: "memory")
#define PG8_WAIT_L(n) asm volatile("s_waitcnt lgkmcnt(" #n ")" ::: "memory")
#define PG8_BAR __builtin_amdgcn_s_barrier()
#define PG8_SCHED __builtin_amdgcn_sched_barrier(0)
    Unit cur, nxt; int ui = 0;
    if (!S.next(0, cur)) return;
    f32x4 acc[2][2][4][2];
#pragma unroll
    for (int a = 0; a < 2; ++a)
#pragma unroll
        for (int b = 0; b < 2; ++b)
#pragma unroll
            for (int m = 0; m < 4; ++m)
#pragma unroll
                for (int n = 0; n < 2; ++n) acc[a][b][m][n] = (f32x4){0.f, 0.f, 0.f, 0.f};
    bf16x8 At[4][2], B0[2][2], B1[2][2];
    const char* cA = (const char*)g.A + (size_t)cur.pm * tstep; const char* cB = (const char*)g.Bt + (size_t)cur.pn * tstep;
    S.a_ready(cur);
    if constexpr (SP2) {
        PG8_STAGE(PG8_SB(0, 0), cB, voffB); PG8_STAGE(PG8_SB(0, 1), cB + hstep, voffB); PG8_STAGE(PG8_SA(0, 0), cA, voffA); PG8_STAGE(PG8_SA(0, 1), cA + hstep, voffA);
        if (wr == 1) PG8_BAR;
        PG8_WAIT_V(2); PG8_BAR;
        PG8_STAGE(PG8_SB(1, 0), cB + kstep, voffB); PG8_STAGE(PG8_SA(1, 0), cA + kstep, voffA); PG8_STAGE(PG8_SB(1, 1), cB + hstep + kstep, voffB);
        PG8_WAIT_V(6); PG8_BAR;
    } else {
        PG8_STAGE(PG8_SB(0, 0), cB, voffB); PG8_STAGE(PG8_SA(0, 0), cA, voffA); PG8_STAGE(PG8_SB(0, 1), cB + hstep, voffB); PG8_STAGE(PG8_SA(0, 1), cA + hstep, voffA);
        if (wr == 1) PG8_BAR;
        PG8_WAIT_V(4); PG8_BAR;
        PG8_STAGE(PG8_SB(1, 0), cB + kstep, voffB); PG8_STAGE(PG8_SA(1, 0), cA + kstep, voffA); PG8_STAGE(PG8_SB(1, 1), cB + hstep + kstep, voffB);
        PG8_WAIT_V(6); PG8_BAR;
    }
    for (;;) {
        const bool has_next = S.next(ui + 1, nxt);
        const char* nA = has_next ? (const char*)g.A + (size_t)nxt.pm * tstep : cA; const char* nB = has_next ? (const char*)g.Bt + (size_t)nxt.pn * tstep : cB;
        for (int t = 0; t < nt; t += 2) {
            const bool last = (t == nt - 2);
            const char* a1 = cA + (size_t)(t + 1) * kstep;
            const char* a2 = last ? nA : cA + (size_t)(t + 2) * kstep; const char* b2 = last ? nB : cB + (size_t)(t + 2) * kstep;
            const char* a3 = a2 + kstep; const char* b3 = b2 + kstep;
            if (last && has_next) S.a_ready(nxt);
            if constexpr (SP2) {
            PG8_LDB(B0, 0, 0); PG8_LDB(B1, 0, 1); PG8_SCHED; PG8_LDA(At, 0, 0); PG8_STAGE(PG8_SA(1, 1), a1 + hstep, voffA);
            PG8_WAIT_V(8); PG8_WAIT_L(0); PG8_BAR; PG8_MMA(0, 0, At, B0); PG8_MMA(0, 1, At, B1); PG8_BAR; PG8_SCHED;
            PG8_LDA(At, 0, 1); PG8_STAGE(PG8_SB(0, 0), b2, voffB); PG8_STAGE(PG8_SB(0, 1), b2 + hstep, voffB); PG8_STAGE(PG8_SA(0, 0), a2, voffA);
            PG8_WAIT_V(8); PG8_WAIT_L(0); PG8_BAR; PG8_MMA(1, 0, At, B0); PG8_MMA(1, 1, At, B1); PG8_BAR; PG8_SCHED;
            PG8_LDB(B0, 1, 0); PG8_LDB(B1, 1, 1); PG8_SCHED; PG8_LDA(At, 1, 0); PG8_STAGE(PG8_SA(0, 1), a2 + hstep, voffA);
            PG8_WAIT_V(8); PG8_WAIT_L(0); PG8_BAR; PG8_MMA(0, 0, At, B0); PG8_MMA(0, 1, At, B1); PG8_BAR; PG8_SCHED;
            PG8_LDA(At, 1, 1); PG8_STAGE(PG8_SB(1, 0), b3, voffB); PG8_STAGE(PG8_SB(1, 1), b3 + hstep, voffB); PG8_STAGE(PG8_SA(1, 0), a3, voffA);
            PG8_WAIT_V(8); PG8_WAIT_L(0); PG8_BAR; PG8_MMA(1, 0, At, B0); PG8_MMA(1, 1, At, B1); PG8_BAR; PG8_SCHED;
            } else {
            PG8_LDB(B0, 0, 0); PG8_SCHED; PG8_LDA(At, 0, 0); PG8_STAGE(PG8_SA(1, 1), a1 + hstep, voffA);
            PG8_WAIT_L(8); PG8_BAR; PG8_WAIT_L(0); PG8_MMA(0, 0, At, B0); PG8_BAR; PG8_SCHED;
            PG8_LDB(B1, 0, 1); PG8_STAGE(PG8_SB(0, 0), b2, voffB);
            PG8_BAR; PG8_WAIT_L(0); PG8_MMA(0, 1, At, B1); PG8_BAR;
            PG8_LDA(At, 0, 1); PG8_STAGE(PG8_SA(0, 0), a2, voffA);
            PG8_BAR; PG8_WAIT_L(0); PG8_MMA(1, 0, At, B0); PG8_BAR; PG8_SCHED;
            PG8_STAGE(PG8_SB(0, 1), b2 + hstep, voffB);
            PG8_WAIT_V(6); PG8_BAR; PG8_MMA(1, 1, At, B1); PG8_BAR;
            PG8_LDB(B0, 1, 0); PG8_SCHED; PG8_LDA(At, 1, 0); PG8_STAGE(PG8_SA(0, 1), a2 + hstep, voffA);
            PG8_WAIT_L(8); PG8_BAR; PG8_WAIT_L(0); PG8_MMA(0, 0, At, B0); PG8_BAR; PG8_SCHED;
            PG8_LDB(B1, 1, 1); PG8_STAGE(PG8_SB(1, 0), b3, voffB);
            PG8_BAR; PG8_WAIT_L(0); PG8_MMA(0, 1, At, B1); PG8_BAR;
            PG8_LDA(At, 1, 1); PG8_STAGE(PG8_SA(1, 0), a3, voffA);
            PG8_BAR; PG8_WAIT_L(0); PG8_MMA(1, 0, At, B0); PG8_BAR; PG8_SCHED;
            PG8_STAGE(PG8_SB(1, 1), b3 + hstep, voffB);
            PG8_WAIT_V(6); PG8_BAR; PG8_MMA(1, 1, At, B1); PG8_BAR;
            }
        }
        if constexpr (ALIGN_EPI) { if (wr == 0) PG8_BAR; }
        if constexpr (!Epi::AFTER_DRAIN) { E(acc, cur, wr, wc, fr, fq); S.done(cur); }
        if (!has_next) break;
#pragma unroll
        for (int a = 0; a < 2; ++a)
#pragma unroll
            for (int b = 0; b < 2; ++b)
#pragma unroll
                for (int m = 0; m < 4; ++m)
#pragma unroll
                    for (int n = 0; n < 2; ++n) acc[a][b][m][n] = (f32x4){0.f, 0.f, 0.f, 0.f};
        cur = nxt; cA = nA; cB = nB; ++ui;
        if constexpr (ALIGN_EPI) { if (wr == 1) PG8_BAR; }
    }
    PG8_WAIT_V(0);
    if constexpr (!ALIGN_EPI) { if (wr == 0) PG8_BAR; }
    PG8_BAR;
    if constexpr (Epi::AFTER_DRAIN) { E.fused(acc, cur, wr, wc, fr, fq, lds, wid, lane); S.done(cur); }
#undef PG8_SA
#undef PG8_SB
#undef PG8_STAGE
#undef PG8_LDA
#undef PG8_LDB
#undef PG8_MMA
#undef PG8_WAIT_V
#undef PG8_WAIT_L
#undef PG8_BAR
#undef PG8_SCHED
}
}

#define LAS __attribute__((address_space(3)))
typedef unsigned short bf16;
typedef unsigned v4u __attribute__((ext_vector_type(4)));
typedef unsigned v2u __attribute__((ext_vector_type(2)));
typedef float f32x4 __attribute__((ext_vector_type(4)));

#ifndef MK_SINGLE
#define MK_SINGLE 0
#endif

constexpr int NB = 2, L = 8192, T = NB * L, D = 1024;
constexpr int HN = 2816;
constexpr int H_A = 0, H_QL = 512, H_CB = 1536, H_QI = 1664, H_KI = 1920, H_XC = 1984, H_V = 2240, H_O = 2496, H_S = 2752;
constexpr int CATW = 1536, CAT_A = 0, CAT_B = 256, CAT_C = 1280;
constexpr int WIN_N = 2252;
constexpr float ALPHA = 1.4142135623730951f;
constexpr float LN_EPS = 1e-5f;
constexpr int NCHUNK = 1024;

constexpr size_t MiB = 1u << 20;
constexpr size_t WS_CTL = 0, CTL_ZERO_BYTES = 1 * MiB;
constexpr size_t WS_WIN  = 1 * MiB;
constexpr size_t WS_WOUT = 12 * MiB;
constexpr size_t WS_WCQ  = 18 * MiB;
constexpr size_t WS_WCKV = 22 * MiB;
constexpr size_t WS_WCO  = 30 * MiB;
constexpr size_t WS_WPQ  = 34 * MiB;
constexpr size_t WS_MEMB = 42 * MiB;
constexpr size_t WS_KV   = 43 * MiB;
constexpr size_t WS_PU   = 48 * MiB;
constexpr size_t WS_PV   = 112 * MiB;
constexpr size_t WS_XB   = 176 * MiB;
constexpr size_t WS_HB   = 208 * MiB;
constexpr size_t WS_QX   = 208 * MiB;
constexpr size_t WS_OX   = 240 * MiB;
constexpr size_t WS_QP   = 208 * MiB;
constexpr size_t WS_HS   = 296 * MiB;
constexpr size_t WS_CAT  = 297 * MiB;
constexpr size_t WS_CKV  = 345 * MiB;
constexpr size_t WS_SEL  = 349 * MiB;
constexpr size_t WS_MQ   = 357 * MiB;
constexpr size_t WS_MK   = 373 * MiB;
constexpr size_t WS_MC   = 389 * MiB;
constexpr size_t WS_MN   = 405 * MiB;
constexpr size_t WS_SCL  = WS_MN + 512 * 1024;
constexpr size_t WS_BC   = 406 * MiB;
constexpr size_t WS_IG   = WS_BC + 512 * 1024;
constexpr size_t WS_NSEL = 407 * MiB;
constexpr size_t WS_END  = 408 * MiB;

constexpr int LDS_BYTES = 147456;
constexpr int MISC_OFF = 131072 + 320;

__device__ __forceinline__ float bf2f(unsigned h) { return __uint_as_float(h << 16); }
__device__ __forceinline__ unsigned f2bf(float f) { unsigned u = __float_as_uint(f); return (u + 0x7fffu + ((u >> 16) & 1u)) >> 16; }
__device__ __forceinline__ unsigned pk2(float lo, float hi) { return f2bf(lo) | (f2bf(hi) << 16); }
__device__ __forceinline__ float lo16(unsigned u) { return __uint_as_float(u << 16); }
__device__ __forceinline__ float hi16(unsigned u) { return __uint_as_float(u & 0xffff0000u); }
__device__ __forceinline__ float wave_sum(float v) {
#pragma unroll
    for (int o = 1; o < 64; o <<= 1) v += __shfl_xor(v, o);
    return v;
}
__device__ __forceinline__ float wave_max(float v) {
#pragma unroll
    for (int o = 1; o < 64; o <<= 1) v = fmaxf(v, __shfl_xor(v, o));
    return v;
}
__device__ __forceinline__ int wave_sum_i(int v) {
#pragma unroll
    for (int o = 1; o < 64; o <<= 1) v += __shfl_xor(v, o);
    return v;
}
#define WAVE_LDS_SYNC() asm volatile("s_waitcnt lgkmcnt(0)" ::: "memory")
__device__ __forceinline__ float sigmoidf_(float x) { return 1.f / (1.f + __expf(-x)); }
__device__ __forceinline__ float dot8(v4u a, const float (&x)[8]) {
    return lo16(a.x) * x[0] + hi16(a.x) * x[1] + lo16(a.y) * x[2] + hi16(a.y) * x[3] + lo16(a.z) * x[4] + hi16(a.z) * x[5] + lo16(a.w) * x[6] + hi16(a.w) * x[7];
}
__device__ __forceinline__ float dot8bb(v4u a, v4u b) {
    return lo16(a.x) * lo16(b.x) + hi16(a.x) * hi16(b.x) + lo16(a.y) * lo16(b.y) + hi16(a.y) * hi16(b.y) + lo16(a.z) * lo16(b.z) + hi16(a.z) * hi16(b.z) + lo16(a.w) * lo16(b.w) + hi16(a.w) * hi16(b.w);
}

#define XB_TMO      128
#define XB_XCNT(j)  (256  + 64 * (j))
#define XB_XSUB(j)  (1280 + 64 * (j))
#define XB_XGEN(j)  (2304 + 64 * (j))
#define XB_TOP      3328
#define XB_TOPGEN   3392
#define XCD_BAR_WORDS 3456
#define XB_SPIN_CAP (1u << 18)

__device__ __forceinline__ unsigned xb_ld(unsigned* p)              { return __hip_atomic_load(p, __ATOMIC_RELAXED, __HIP_MEMORY_SCOPE_AGENT); }
__device__ __forceinline__ unsigned xb_add(unsigned* p, unsigned v) { return __hip_atomic_fetch_add(p, v, __ATOMIC_RELAXED, __HIP_MEMORY_SCOPE_AGENT); }
__device__ __forceinline__ unsigned xb_xcc_id() { return (unsigned)__builtin_amdgcn_s_getreg((3 << 11) | 20) & 0xFu; }
#define XB_SPIN(cond, bar) do { unsigned _sp = 0; while (cond) { __builtin_amdgcn_s_sleep(1); \
    if ((++_sp & 255u) == 0u) { if (xb_ld(&(bar)[XB_TMO])) break; if (_sp > XB_SPIN_CAP) { atomicAdd(&(bar)[XB_TMO], 1u); break; } } } } while (0)

struct XcdBarrier { unsigned* bar; unsigned x; volatile LAS unsigned* st; };

__device__ __forceinline__ XcdBarrier xcd_barrier_post(unsigned* bar, volatile LAS unsigned* st) {
    XcdBarrier b; b.bar = bar; b.x = xb_xcc_id(); b.st = st;
    if (threadIdx.x == 0) (void)xb_add(&bar[XB_XCNT(b.x)], 1u);
    return b;
}
__device__ __forceinline__ void xcd_barrier_complete(unsigned* bar, unsigned x, unsigned& nloc, unsigned& nx) {
    const unsigned G = gridDim.x * gridDim.y * gridDim.z;
    unsigned sum, cnt, mine, sp = 0u;
    for (;;) {
        sum = 0u; cnt = 0u; mine = 0u;
#pragma unroll
        for (unsigned j = 0; j < 16; ++j) { const unsigned c = xb_ld(&bar[XB_XCNT(j)]); sum += c; cnt += (c > 0u) ? 1u : 0u; mine = (j == x) ? c : mine; }
        if (sum == G) break;
        __builtin_amdgcn_s_sleep(1);
        if ((++sp & 255u) == 0u) { if (xb_ld(&bar[XB_TMO])) break; if (sp > XB_SPIN_CAP) { atomicAdd(&bar[XB_TMO], 1u); break; } }
    }
    nloc = mine > 0u ? mine : 1u; nx = cnt > 0u ? cnt : 1u;
}
__device__ __forceinline__ void xcd_barrier(const XcdBarrier& b) {
    asm volatile("s_waitcnt vmcnt(0)" ::: "memory");
    __syncthreads();
    if (threadIdx.x == 0) {
        unsigned* bar = b.bar;
        __builtin_amdgcn_s_waitcnt(0);
        unsigned nloc = b.st[0], nx = b.st[1];
        if (nloc == 0u) { xcd_barrier_complete(bar, b.x, nloc, nx); b.st[0] = nloc; b.st[1] = nx; }
        const unsigned old = xb_add(&bar[XB_XSUB(b.x)], 1u);
        const unsigned gen = old / nloc;
        if (old + 1u == (gen + 1u) * nloc) {
            __builtin_amdgcn_fence(__ATOMIC_RELEASE, "agent");
            asm volatile("s_waitcnt vmcnt(0)" ::: "memory");
            const unsigned og = xb_add(&bar[XB_TOP], 1u);
            const unsigned tg = og / nx;
            if (og + 1u == (tg + 1u) * nx) xb_add(&bar[XB_TOPGEN], 1u);
            else XB_SPIN(xb_ld(&bar[XB_TOPGEN]) == tg, bar);
            __builtin_amdgcn_fence(__ATOMIC_ACQUIRE, "agent");
            xb_add(&bar[XB_XGEN(b.x)], 1u);
            asm volatile("s_waitcnt vmcnt(0)" ::: "memory");
        } else {
            XB_SPIN(xb_ld(&bar[XB_XGEN(b.x)]) == gen, bar);
            __builtin_amdgcn_fence(__ATOMIC_ACQUIRE, "agent");
            asm volatile("s_waitcnt vmcnt(0)" ::: "memory");
        }
    }
    __syncthreads();
}

struct EpiH {
    static constexpr bool PERM = true, AFTER_DRAIN = false;
    bf16* H; float* Hs;
    __device__ __forceinline__ void operator()(const pg8::f32x4 (&acc)[2][2][4][2], const pg8::Unit& u, int wr, int wc, int fr, int fq) const {
        const int row0 = u.pm * 256 + wr * 64 + fr, col0 = u.pn * 256 + wc * 32 + 8 * fq;
#pragma unroll
        for (int ai = 0; ai < 2; ++ai)
#pragma unroll
            for (int m = 0; m < 4; ++m) {
                const int row = row0 + ai * 128 + m * 16;
#pragma unroll
                for (int bj = 0; bj < 2; ++bj) {
                    const int c = col0 + bj * 128;
                    const pg8::f32x4 v0 = acc[ai][bj][m][0], v1 = acc[ai][bj][m][1];
                    v4u w; w.x = pk2(v0[0], v0[1]); w.y = pk2(v0[2], v0[3]); w.z = pk2(v1[0], v1[1]); w.w = pk2(v1[2], v1[3]);
                    *(v4u*)(H + (size_t)row * HN + c) = w;
                    if (c == H_S || c == H_S + 8) { float* s = Hs + (size_t)row * 16 + (c - H_S); *(pg8::f32x4*)s = v0; *(pg8::f32x4*)(s + 4) = v1; }
                }
            }
    }
};
struct EpiB16 {
    static constexpr bool PERM = true, AFTER_DRAIN = false;
    bf16* O; int ldc;
    __device__ __forceinline__ void operator()(const pg8::f32x4 (&acc)[2][2][4][2], const pg8::Unit& u, int wr, int wc, int fr, int fq) const {
        const int row0 = u.pm * 256 + wr * 64 + fr, col0 = u.pn * 256 + wc * 32 + 8 * fq;
#pragma unroll
        for (int ai = 0; ai < 2; ++ai)
#pragma unroll
            for (int m = 0; m < 4; ++m) {
                const int row = row0 + ai * 128 + m * 16;
#pragma unroll
                for (int bj = 0; bj < 2; ++bj) {
                    const int c = col0 + bj * 128;
                    const pg8::f32x4 v0 = acc[ai][bj][m][0], v1 = acc[ai][bj][m][1];
                    v4u w; w.x = pk2(v0[0], v0[1]); w.y = pk2(v0[2], v0[3]); w.z = pk2(v1[0], v1[1]); w.w = pk2(v1[2], v1[3]);
                    *(v4u*)(O + (size_t)row * ldc + c) = w;
                }
            }
    }
};
struct EpiResid {
    static constexpr bool PERM = false, AFTER_DRAIN = false;
    float* O; int ldc; float alpha;
    __device__ __forceinline__ void operator()(const pg8::f32x4 (&acc)[2][2][4][2], const pg8::Unit& u, int wr, int wc, int fr, int fq) const {
        const int row0 = u.pm * 256 + wr * 64 + fr, col0 = u.pn * 256 + wc * 32 + 4 * fq;
#pragma unroll
        for (int ai = 0; ai < 2; ++ai)
#pragma unroll
            for (int m = 0; m < 4; ++m) {
                float* rowp = O + (size_t)(row0 + ai * 128 + m * 16) * ldc + col0;
#pragma unroll
                for (int bj = 0; bj < 2; ++bj)
#pragma unroll
                    for (int n = 0; n < 2; ++n) {
                        pg8::f32x4* p = (pg8::f32x4*)(rowp + bj * 128 + n * 16);
                        const pg8::f32x4 x = *p;
                        *p = x * alpha + acc[ai][bj][m][n];
                    }
            }
    }
};

struct Args { const float* in[35]; float* out; unsigned char* ws; int lo, hi, li, pad; };
typedef const __attribute__((address_space(4))) Args* KArgs;
__device__ __forceinline__ KArgs kargs() { KArgs p = (KArgs)__builtin_amdgcn_kernarg_segment_ptr(); asm volatile("" : "+s"(p)); return p; }
enum { I_X = 0, I_MEM, I_LNIN_G, I_LNIN_B, I_RELB, I_WIN, I_CAW, I_CAB, I_NAG, I_NAB, I_KVG, I_WUK, I_WUV, I_CMW, I_CMB, I_WQM, I_WKM, I_BI, I_BF, I_NMG,
       I_WOUT, I_LN1G, I_LN1B, I_WCQ, I_WCKV, I_WCO, I_LN2G, I_LN2B, I_WPQ, I_SK1, I_SK2, I_PU, I_PV, I_LN3G, I_LN3B };

__device__ __forceinline__ void tr_item(LAS float* scr, const float* W, int ldw, int k0, int n0, int ncv, bf16* WT, int ldk, int dr0, int kofs, int tid) {
    const int c = tid & 63, r0 = tid >> 6;
#pragma unroll
    for (int i = 0; i < 8; ++i) { const int r = r0 + 8 * i; scr[r * 65 + c] = (c < ncv) ? W[(size_t)(k0 + r) * ldw + n0 + c] : 0.f; }
    __syncthreads();
#pragma unroll
    for (int i = 0; i < 8; ++i) { const int n = r0 + 8 * i; if (n < ncv) WT[(size_t)(dr0 + n) * ldk + kofs + k0 + c] = (bf16)f2bf(scr[c * 65 + n]); }
    __syncthreads();
}
__device__ __forceinline__ void tr_job(LAS float* scr, const float* W, int K, int ldw, int n0, int nc, bf16* WT, int ldk, int dr0, int kofs, int tid, int G, int bid) {
    const int nnt = (nc + 63) / 64, nitems = (K / 64) * nnt;
    for (int it = bid; it < nitems; it += G) {
        const int kt = it / nnt, nt = it % nnt;
        const int ncv = (nc - nt * 64) < 64 ? (nc - nt * 64) : 64;
        tr_item(scr, W, ldw, kt * 64, n0 + nt * 64, ncv, WT, ldk, dr0 + nt * 64, kofs, tid);
    }
}
__device__ __forceinline__ void ln_row(const float* src, const float* g, const float* b, float* dstf, bf16* dstb, int lane) {
    const f32x4* xr = (const f32x4*)src + lane;
    f32x4 v[4]; float s = 0.f;
#pragma unroll
    for (int j = 0; j < 4; ++j) { v[j] = xr[64 * j]; s += (v[j].x + v[j].y) + (v[j].z + v[j].w); }
    const float mean = wave_sum(s) * (1.f / D); float s2 = 0.f;
#pragma unroll
    for (int j = 0; j < 4; ++j) { v[j] = v[j] - mean; s2 += (v[j].x * v[j].x + v[j].y * v[j].y) + (v[j].z * v[j].z + v[j].w * v[j].w); }
    const float rstd = rsqrtf(wave_sum(s2) * (1.f / D) + LN_EPS);
#pragma unroll
    for (int j = 0; j < 4; ++j) {
        const f32x4 gg = ((const f32x4*)g)[lane + 64 * j], bb = ((const f32x4*)b)[lane + 64 * j];
        const f32x4 y = v[j] * rstd * gg + bb;
        ((f32x4*)dstf)[lane + 64 * j] = y;
        v2u o; o.x = pk2(y.x, y.y); o.y = pk2(y.z, y.w);
        ((v2u*)dstb)[lane + 64 * j] = o;
    }
}

__device__ __forceinline__ void p0_prologue(LAS unsigned char* lds, int tid, int G, int bid) {
    LAS float* scr = (LAS float*)lds;
    KArgs ap = kargs();
    unsigned char* ws = ap->ws;
    for (int l = 0; l < 2; ++l) {
        const float* win = ap->in[I_WIN] + (size_t)l * D * WIN_N;
        bf16* WinT = (bf16*)(ws + WS_WIN) + (size_t)l * HN * D;
        tr_job(scr, win, D, WIN_N, 0, 512, WinT, D, H_A, 0, tid, G, bid);
        tr_job(scr, win, D, WIN_N, 1024, 448, WinT, D, H_CB, 0, tid, G, bid);
        tr_job(scr, win, D, WIN_N, 1476, 768, WinT, D, H_XC, 0, tid, G, bid);
        tr_job(scr, win, D, WIN_N, 1472, 4, WinT, D, H_S, 0, tid, G, bid);
        tr_job(scr, win, D, WIN_N, 2244, 8, WinT, D, H_S + 4, 0, tid, G, bid);
        for (int i = bid * 512 + tid; i < (HN - (H_S + 12)) * D; i += G * 512) WinT[(size_t)(H_S + 12) * D + i] = 0;
        const float* wout = ap->in[I_WOUT] + (size_t)l * D * D;
        bf16* WoutT = (bf16*)(ws + WS_WOUT) + (size_t)l * D * CATW;
        tr_job(scr, wout, 256, D, 0, D, WoutT, CATW, 0, CAT_A, tid, G, bid);
        tr_job(scr, wout + (size_t)768 * D, 256, D, 0, D, WoutT, CATW, 0, CAT_C, tid, G, bid);
        tr_job(scr, ap->in[I_WCQ] + (size_t)l * D * D, D, D, 0, D, (bf16*)(ws + WS_WCQ) + (size_t)l * D * D, D, 0, 0, tid, G, bid);
        tr_job(scr, ap->in[I_WCKV] + (size_t)l * D * 2048, D, 2048, 0, 2048, (bf16*)(ws + WS_WCKV) + (size_t)l * 2048 * D, D, 0, 0, tid, G, bid);
        tr_job(scr, ap->in[I_WCO] + (size_t)l * D * D, D, D, 0, D, (bf16*)(ws + WS_WCO) + (size_t)l * D * D, D, 0, 0, tid, G, bid);
        tr_job(scr, ap->in[I_WPQ] + (size_t)l * D * 2048, D, 2048, 0, 2048, (bf16*)(ws + WS_WPQ) + (size_t)l * 2048 * D, D, 0, 0, tid, G, bid);
    }
    {
        LAS float* sa = (LAS float*)lds;
        LAS float* sb = sa + 64 * 65;
        for (int it = bid; it < 2 * 2 * 128; it += G) {
            const int l = it >> 8, kind = (it >> 7) & 1, h = (it >> 4) & 7, tile = it & 15;
            if (kind == 0) {
                const float* win = ap->in[I_WIN] + (size_t)l * D * WIN_N;
                const float* wuk = ap->in[I_WUK] + (size_t)l * 8 * 64 * 128 + (size_t)h * 64 * 128;
                bf16* WinT = (bf16*)(ws + WS_WIN) + (size_t)l * HN * D;
                const int k0 = tile * 64;
                for (int i = tid; i < 4096; i += 512) { const int kk = i >> 6, d = i & 63; sa[kk * 65 + d] = win[(size_t)(k0 + kk) * WIN_N + 512 + h * 64 + d]; }
                for (int i = tid; i < 8192; i += 512) sb[i] = wuk[i];
                __syncthreads();
                for (int i = tid; i < 8192; i += 512) { const int r = i >> 6, kk = i & 63; float s = 0.f;
#pragma unroll 8
                    for (int d = 0; d < 64; ++d) s += sa[kk * 65 + d] * sb[d * 128 + r];
                    WinT[(size_t)(H_QL + h * 128 + r) * D + k0 + kk] = (bf16)f2bf(s); }
                __syncthreads();
            } else {
                const float* wout = ap->in[I_WOUT] + (size_t)l * D * D;
                const float* wuv = ap->in[I_WUV] + (size_t)l * 8 * 128 * 64 + (size_t)h * 128 * 64;
                bf16* WoutT = (bf16*)(ws + WS_WOUT) + (size_t)l * D * CATW;
                const int n0 = tile * 64;
                for (int i = tid; i < 4096; i += 512) { const int d = i >> 6, n = i & 63; sa[d * 65 + n] = wout[(size_t)(256 + h * 64 + d) * D + n0 + n]; }
                for (int i = tid; i < 8192; i += 512) { const int r = i >> 6, d = i & 63; sb[r * 65 + d] = wuv[i]; }
                __syncthreads();
                for (int i = tid; i < 8192; i += 512) { const int n = i >> 7, r = i & 127; float s = 0.f;
#pragma unroll 8
                    for (int d = 0; d < 64; ++d) s += sb[r * 65 + d] * sa[d * 65 + n];
                    WoutT[(size_t)(n0 + n) * CATW + CAT_B + h * 128 + r] = (bf16)f2bf(s); }
                __syncthreads();
            }
        }
    }
    {
        const size_t gt = (size_t)bid * 512 + tid, gs = (size_t)G * 512;
        const f32x4* pu = (const f32x4*)ap->in[I_PU]; const f32x4* pv = (const f32x4*)ap->in[I_PV]; const f32x4* pm = (const f32x4*)ap->in[I_MEM];
        v2u* du = (v2u*)(ws + WS_PU); v2u* dv = (v2u*)(ws + WS_PV); v2u* dm = (v2u*)(ws + WS_MEMB);
        const size_t n4 = (size_t)2 * 16384 * 1024 / 4;
        for (size_t i = gt; i < n4; i += gs) { const f32x4 x = pu[i]; v2u o; o.x = pk2(x.x, x.y); o.y = pk2(x.z, x.w); du[i] = o; }
        for (size_t i = gt; i < n4; i += gs) { const f32x4 x = pv[i]; v2u o; o.x = pk2(x.x, x.y); o.y = pk2(x.z, x.w); dv[i] = o; }
        for (size_t i = gt; i < (size_t)512 * 1024 / 4; i += gs) { const f32x4 x = pm[i]; v2u o; o.x = pk2(x.x, x.y); o.y = pk2(x.z, x.w); dm[i] = o; }
    }
    {
        const int gw = bid * 8 + (tid >> 6), NGW = G * 8, lane = tid & 63;
        for (int m = gw; m < T; m += NGW)
            ln_row(ap->in[I_X] + (size_t)m * D, ap->in[I_LNIN_G], ap->in[I_LNIN_B], ap->out + (size_t)m * D, (bf16*)(ws + WS_XB) + (size_t)m * D, lane);
    }
}

__device__ __forceinline__ void conv_unit(LAS unsigned char* lds, int tile, const bf16* Hb, const float* cw, const float* cb, const float* ng, const float* nb, bf16* CAT, int tid) {
    LAS float* u = (LAS float*)lds;
    LAS float* w = u + 94 * 256;
    const int t0 = tile * 64, pos0 = t0 & (L - 1);
    for (int i = tid; i < 94 * 256; i += 512) {
        const int r = i >> 8, c = i & 255, pos = pos0 - 30 + r; float val = 0.f;
        if (pos >= 0) { const bf16* hr = Hb + (size_t)(t0 - 30 + r) * HN + H_A; const float av = bf2f(hr[c]), gt = bf2f(hr[256 + c]); val = av * sigmoidf_(gt); }
        u[i] = val;
    }
    for (int i = tid; i < 31 * 256; i += 512) w[i] = cw[i];
    __syncthreads();
    const int wave = tid >> 6, lane = tid & 63;
    for (int tt = wave; tt < 64; tt += 8) {
        float acc[4];
#pragma unroll
        for (int i = 0; i < 4; ++i) { const int c = lane + 64 * i; float s = cb[c];
            asm volatile("" ::: "memory");
#pragma unroll 8
            for (int k = 0; k < 31; ++k) s += w[k * 256 + c] * u[(tt + k) * 256 + c];
            acc[i] = s; }
        const float mean = wave_sum((acc[0] + acc[1]) + (acc[2] + acc[3])) * (1.f / 256.f);
        float s2 = 0.f;
#pragma unroll
        for (int i = 0; i < 4; ++i) { acc[i] -= mean; s2 += acc[i] * acc[i]; }
        const float rstd = rsqrtf(wave_sum(s2) * (1.f / 256.f) + LN_EPS);
#pragma unroll
        for (int i = 0; i < 4; ++i) { const int c = lane + 64 * i; const float y = acc[i] * rstd * ng[c] + nb[c];
            CAT[(size_t)(t0 + tt) * CATW + CAT_A + c] = (bf16)f2bf(y * sigmoidf_(y)); }
    }
    __syncthreads();
}

__device__ __forceinline__ unsigned fkey(float f) { const unsigned u = __float_as_uint(f); return (u & 0x80000000u) ? ~u : (u | 0x80000000u); }

__device__ __forceinline__ int block_sum_i(int v, LAS int* red, int tid) {
    v = wave_sum_i(v);
    if ((tid & 63) == 0) red[tid >> 6] = v;
    __syncthreads();
    int s = 0;
#pragma unroll
    for (int i = 0; i < 8; ++i) s += red[i];
    __syncthreads();
    return s;
}
__device__ __forceinline__ int block_excl_scan_i(int v, LAS int* red, int tid, int& tot) {
    const int lane = tid & 63, wave = tid >> 6;
    int inc = v;
#pragma unroll
    for (int o = 1; o < 64; o <<= 1) { const int y = __shfl_up(inc, o); if (lane >= o) inc += y; }
    if (lane == 63) red[wave] = inc;
    __syncthreads();
    int base = 0, t = 0;
#pragma unroll
    for (int i = 0; i < 8; ++i) { const int r = red[i]; if (i < wave) base += r; t += r; }
    __syncthreads();
    tot = t;
    return base + inc - v;
}

__device__ __forceinline__ void indexer_query(LAS unsigned char* lds, int t, const bf16* Hb, const float* Hs, unsigned short* SEL, int* NSEL, int tid) {
    LAS unsigned* keys = (LAS unsigned*)lds;
    LAS float* qi = (LAS float*)(lds + 32768);
    LAS int* red = (LAS int*)(lds + 32768 + 1024);
    const int b = t >> 13, pos = t & (L - 1), n = pos + 1;
    if (tid < 256) qi[tid] = bf2f(Hb[(size_t)t * HN + H_QI + tid]);
    const float w0 = Hs[(size_t)t * 16 + 0] * 0.5f, w1 = Hs[(size_t)t * 16 + 1] * 0.5f, w2 = Hs[(size_t)t * 16 + 2] * 0.5f, w3 = Hs[(size_t)t * 16 + 3] * 0.5f;
    __syncthreads();
    for (int s = tid; s < n; s += 512) {
        const bf16* kr = Hb + (size_t)(b * L + s) * HN + H_KI;
        float d0 = 0.f, d1 = 0.f, d2 = 0.f, d3 = 0.f;
#pragma unroll 1
        for (int c = 0; c < 64; c += 8) {
            asm volatile("" ::: "memory");
            const v4u kk = *(const v4u*)(kr + c);
            float kf[8] = { lo16(kk.x), hi16(kk.x), lo16(kk.y), hi16(kk.y), lo16(kk.z), hi16(kk.z), lo16(kk.w), hi16(kk.w) };
#pragma unroll
            for (int j = 0; j < 8; ++j) { d0 += qi[c + j] * kf[j]; d1 += qi[64 + c + j] * kf[j]; d2 += qi[128 + c + j] * kf[j]; d3 += qi[192 + c + j] * kf[j]; }
        }
        float sc = 0.f;
        sc += w0 * fmaxf(d0 * 0.125f, 0.f); sc += w1 * fmaxf(d1 * 0.125f, 0.f); sc += w2 * fmaxf(d2 * 0.125f, 0.f); sc += w3 * fmaxf(d3 * 0.125f, 0.f);
        keys[s] = fkey(sc);
    }
    __syncthreads();
    if (n <= 256) {
        for (int s = tid; s < n; s += 512) SEL[(size_t)t * 256 + s] = (unsigned short)s;
        if (tid == 0) NSEL[t] = n;
        __syncthreads();
        return;
    }
    unsigned prefix = 0u;
    for (int bit = 31; bit >= 0; --bit) {
        const unsigned cand = prefix | (1u << bit);
        int c = 0;
        for (int s = tid; s < n; s += 512) c += (keys[s] >= cand) ? 1 : 0;
        c = block_sum_i(c, red, tid);
        if (c >= 256) prefix = cand;
    }
    int ng = 0, nt = 0;
#pragma unroll
    for (int j = 0; j < 16; ++j) { const int s = tid * 16 + j; if (s < n) { const unsigned k = keys[s]; ng += (k > prefix) ? 1 : 0; nt += (k == prefix) ? 1 : 0; } }
    int totg, tott;
    int eg = block_excl_scan_i(ng, red, tid, totg);
    int et = block_excl_scan_i(nt, red, tid, tott);
    const int quota = 256 - totg;
#pragma unroll
    for (int j = 0; j < 16; ++j) { const int s = tid * 16 + j; if (s < n) { const unsigned k = keys[s];
        if (k > prefix) { SEL[(size_t)t * 256 + eg] = (unsigned short)s; ++eg; }
        else if (k == prefix) { if (et < quota) SEL[(size_t)t * 256 + totg + et] = (unsigned short)s; ++et; } } }
    if (tid == 0) NSEL[t] = 256;
    __syncthreads();
}

__device__ __forceinline__ float logsigmoidf_(float x) { return fminf(x, 0.f) - log1pf(__expf(-fabsf(x))); }

__device__ __forceinline__ void mlstm_prep_unit(LAS unsigned char* lds, int cidx, const bf16* Hb, const float* Hs, const float* cmw, const float* cmb, const float* wqm, const float* wkm,
                                                const float* bi, const float* bfp, float* MQ, float* MK, float* MC, float* MN, float* SCL, float* BC, float* IG, int tid) {
    const int j = cidx & 127, h = (cidx >> 7) & 3, b = cidx >> 9, t0 = b * L + j * 64;
    LAS float* xc = (LAS float*)lds;
    LAS float* wq = xc + 64 * 65;
    LAS float* wk = wq + 4096;
    LAS float* kt = wk + 4096;
    LAS float* vt = kt + 64 * 65;
    LAS float* wg = vt + 64 * 65;
    for (int i = tid; i < 4096; i += 512) {
        const int s = i >> 6, d = i & 63, c = h * 64 + d; float av = cmb[c];
#pragma unroll
        for (int k = 0; k < 4; ++k) { const int pos = j * 64 + s - 3 + k; if (pos >= 0) av += cmw[k * 256 + c] * bf2f(Hb[(size_t)(b * L + pos) * HN + H_XC + c]); }
        xc[s * 65 + d] = av * sigmoidf_(av);
        wq[i] = wqm[h * 4096 + i]; wk[i] = wkm[h * 4096 + i];
        vt[s * 65 + d] = bf2f(Hb[(size_t)(t0 + s) * HN + H_V + c]);
    }
    __syncthreads();
    for (int i = tid; i < 4096; i += 512) {
        const int s = i >> 6, e = i & 63; float aq = 0.f, ak = 0.f;
#pragma unroll 8
        for (int d = 0; d < 64; ++d) { const float x = xc[s * 65 + d]; aq += x * wq[d * 64 + e]; ak += x * wk[d * 64 + e]; }
        MQ[(size_t)(t0 + s) * 256 + h * 64 + e] = aq * 0.125f; MK[(size_t)(t0 + s) * 256 + h * 64 + e] = ak; kt[s * 65 + e] = ak;
    }
    if (tid < 64) {
        const int s = tid, t = t0 + s;
        const float fl = logsigmoidf_(Hs[(size_t)t * 16 + 8 + h] + bfp[h]);
        const float ig = Hs[(size_t)t * 16 + 4 + h] + bi[h];
        float bs = fl;
#pragma unroll
        for (int o = 1; o < 64; o <<= 1) { const float y = __shfl_up(bs, o); if (s >= o) bs += y; }
        const float bL = __shfl(bs, 63);
        const float g = bL - bs + ig;
        const float mloc = wave_max(g);
        wg[s] = __expf(g - mloc);
        BC[(size_t)t * 4 + h] = bs; IG[(size_t)t * 4 + h] = ig;
        if (s == 0) { SCL[cidx * 4 + 0] = mloc; SCL[cidx * 4 + 1] = bL; }
    }
    __syncthreads();
    for (int i = tid; i < 4096; i += 512) {
        const int v = i >> 6, k = i & 63; float s2 = 0.f;
#pragma unroll 8
        for (int s = 0; s < 64; ++s) s2 += wg[s] * vt[s * 65 + v] * kt[s * 65 + k];
        MC[(size_t)cidx * 4096 + i] = s2;
    }
    if (tid < 64) { float s2 = 0.f;
        for (int s = 0; s < 64; ++s) s2 += wg[s] * kt[s * 65 + tid];
        MN[(size_t)cidx * 64 + tid] = s2; }
    __syncthreads();
}

__device__ __forceinline__ void mlstm_scan(int gtid, float* MC, float* MN, float* SCL) {
    const int stream = gtid / 4160, e = gtid - stream * 4160;
    if (stream >= 8) return;
    float* base = (e < 4096) ? (MC + e) : (MN + (e - 4096));
    const size_t stride = (e < 4096) ? 4096 : 64;
    float m = 0.f, C = 0.f;
    for (int j0 = 0; j0 < 128; j0 += 8) {
        float loc[8], ml[8], bl[8];
#pragma unroll
        for (int u = 0; u < 8; ++u) { const int cidx = stream * 128 + j0 + u; loc[u] = base[(size_t)cidx * stride]; ml[u] = SCL[cidx * 4 + 0]; bl[u] = SCL[cidx * 4 + 1]; }
#pragma unroll
        for (int u = 0; u < 8; ++u) {
            const int cidx = stream * 128 + j0 + u;
            const float mn = fmaxf(bl[u] + m, ml[u]);
            const float a = __expf(bl[u] + m - mn), c = __expf(ml[u] - mn);
            base[(size_t)cidx * stride] = C;
            if (e == 0) SCL[cidx * 4 + 2] = m;
            C = a * C + c * loc[u]; m = mn;
        }
    }
}

__device__ __forceinline__ int rel_bucket(int dist) {
    const int d = dist > 0 ? dist : 0;
    if (d < 16) return d;
    const int large = 16 + (int)(logf((float)d / 16.f) / 2.0794415416798357f * 16.f);
    return large < 31 ? large : 31;
}

__device__ __forceinline__ void dsa_attn_query(LAS unsigned char* wl, int t, const bf16* Hb, const bf16* CKV, const unsigned short* SEL, const int* NSEL, const float* relb, bf16* CAT, int lane) {
    LAS float* ql = (LAS float*)wl;
    LAS float* P = ql + 1024;
    LAS int* sl = (LAS int*)(P + 2048);
    const int b = t >> 13, pos = t & (L - 1), n = NSEL[t];
    for (int i = lane; i < 1024; i += 64) ql[i] = bf2f(Hb[(size_t)t * HN + H_QL + i]);
    for (int i = lane; i < 256; i += 64) sl[i] = (i < n) ? (int)SEL[(size_t)t * 256 + i] : 0;
    WAVE_LDS_SYNC();
    float lg[4][8];
#pragma unroll
    for (int i = 0; i < 4; ++i) {
        const int kk = lane + 64 * i;
        float acc[8];
#pragma unroll
        for (int h = 0; h < 8; ++h) acc[h] = 0.f;
        const int s = sl[kk];
        const bf16* cr = CKV + (size_t)(b * L + s) * 128;
        for (int c = 0; c < 128; c += 8) {
            const v4u cv = *(const v4u*)(cr + c);
            const float cf[8] = { lo16(cv.x), hi16(cv.x), lo16(cv.y), hi16(cv.y), lo16(cv.z), hi16(cv.z), lo16(cv.w), hi16(cv.w) };
#pragma unroll
            for (int h = 0; h < 8; ++h) {
#pragma unroll
                for (int jj = 0; jj < 8; ++jj) acc[h] += ql[h * 128 + c + jj] * cf[jj];
            }
        }
        const int bk = rel_bucket(pos - s);
#pragma unroll
        for (int h = 0; h < 8; ++h) lg[i][h] = (kk < n) ? (acc[h] * 0.125f + relb[bk * 8 + h]) : -INFINITY;
    }
#pragma unroll
    for (int h = 0; h < 8; ++h) {
        const float mx = wave_max(fmaxf(fmaxf(lg[0][h], lg[1][h]), fmaxf(lg[2][h], lg[3][h])));
        float e[4], sm = 0.f;
#pragma unroll
        for (int i = 0; i < 4; ++i) { e[i] = (lane + 64 * i < n) ? __expf(lg[i][h] - mx) : 0.f; sm += e[i]; }
        const float inv = 1.f / wave_sum(sm);
#pragma unroll
        for (int i = 0; i < 4; ++i) P[h * 256 + lane + 64 * i] = e[i] * inv;
    }
    WAVE_LDS_SYNC();
    float o[8][2];
#pragma unroll
    for (int h = 0; h < 8; ++h) { o[h][0] = 0.f; o[h][1] = 0.f; }
    for (int kk = 0; kk < n; ++kk) {
        const int s = sl[kk];
        const bf16* cr = CKV + (size_t)(b * L + s) * 128;
        const float c0 = bf2f(cr[lane]), c1 = bf2f(cr[64 + lane]);
#pragma unroll
        for (int h = 0; h < 8; ++h) { const float p = P[h * 256 + kk]; o[h][0] += p * c0; o[h][1] += p * c1; }
    }
#pragma unroll
    for (int h = 0; h < 8; ++h) {
        CAT[(size_t)t * CATW + CAT_B + h * 128 + lane] = (bf16)f2bf(o[h][0]);
        CAT[(size_t)t * CATW + CAT_B + h * 128 + 64 + lane] = (bf16)f2bf(o[h][1]);
    }
    WAVE_LDS_SYNC();
}

__device__ __forceinline__ void mlstm_out_unit(LAS unsigned char* lds, int cidx, const bf16* Hb, const float* MQ, const float* MK, const float* MC, const float* MN, const float* SCL,
                                               const float* BC, const float* IG, const float* nmg, bf16* CAT, int tid) {
    const int j = cidx & 127, h = (cidx >> 7) & 3, b = cidx >> 9, t0 = b * L + j * 64;
    LAS float* q = (LAS float*)lds;
    LAS float* k = q + 64 * 65;
    LAS float* v = k + 64 * 65;
    LAS float* C = v + 64 * 65;
    LAS float* S = C + 64 * 65;
    LAS float* hh = S + 64 * 65;
    LAS float* nn = hh + 64 * 65;
    LAS float* bb = nn + 64;
    LAS float* gi = bb + 64;
    LAS float* mrow = gi + 64;
    LAS float* den = mrow + 64;
    for (int i = tid; i < 4096; i += 512) {
        const int s = i >> 6, d = i & 63;
        q[s * 65 + d] = MQ[(size_t)(t0 + s) * 256 + h * 64 + d];
        k[s * 65 + d] = MK[(size_t)(t0 + s) * 256 + h * 64 + d];
        v[s * 65 + d] = bf2f(Hb[(size_t)(t0 + s) * HN + H_V + h * 64 + d]);
        C[s * 65 + d] = MC[(size_t)cidx * 4096 + i];
    }
    if (tid < 64) { nn[tid] = MN[(size_t)cidx * 64 + tid]; bb[tid] = BC[(size_t)(t0 + tid) * 4 + h]; gi[tid] = IG[(size_t)(t0 + tid) * 4 + h]; }
    const float m_in = SCL[cidx * 4 + 2];
    __syncthreads();
    if (tid < 64) {
        const int t = tid; const float bt = bb[t]; float rm = -INFINITY;
        for (int s = 0; s <= t; ++s) rm = fmaxf(rm, bt - bb[s] + gi[s]);
        mrow[t] = fmaxf(bt + m_in, rm);
    }
    __syncthreads();
    for (int i = tid; i < 4096; i += 512) {
        const int t = i >> 6, s = i & 63; float a = 0.f;
        if (s <= t) {
#pragma unroll 8
            for (int d = 0; d < 64; ++d) a += q[t * 65 + d] * k[s * 65 + d];
            a *= __expf(bb[t] - bb[s] + gi[s] - mrow[t]);
        }
        S[t * 65 + s] = a;
    }
    __syncthreads();
    if (tid < 64) {
        const int t = tid; float a = 0.f, nq = 0.f;
        for (int s = 0; s < 64; ++s) a += S[t * 65 + s];
        for (int d = 0; d < 64; ++d) nq += nn[d] * q[t * 65 + d];
        const float wi = __expf(bb[t] + m_in - mrow[t]);
        const float dn = a + wi * nq;
        den[t] = fmaxf(fabsf(dn), __expf(-mrow[t]));
    }
    __syncthreads();
    for (int i = tid; i < 4096; i += 512) {
        const int t = i >> 6, vv = i & 63; float a = 0.f, cq = 0.f;
#pragma unroll 8
        for (int s = 0; s < 64; ++s) a += S[t * 65 + s] * v[s * 65 + vv];
#pragma unroll 8
        for (int d = 0; d < 64; ++d) cq += C[vv * 65 + d] * q[t * 65 + d];
        const float wi = __expf(bb[t] + m_in - mrow[t]);
        hh[t * 65 + vv] = (a + wi * cq) / den[t];
    }
    __syncthreads();
    {
        const int wave = tid >> 6, lane = tid & 63;
        for (int t = wave; t < 64; t += 8) {
            const float x = hh[t * 65 + lane];
            const float mean = wave_sum(x) * (1.f / 64.f);
            const float dx = x - mean;
            const float var = wave_sum(dx * dx) * (1.f / 64.f);
            const float y = dx * rsqrtf(var + LN_EPS) * nmg[h * 64 + lane];
            const float og = bf2f(Hb[(size_t)(t0 + t) * HN + H_O + h * 64 + lane]);
            CAT[(size_t)(t0 + t) * CATW + CAT_C + h * 64 + lane] = (bf16)f2bf(sigmoidf_(og) * y);
        }
    }
    __syncthreads();
}

__device__ __forceinline__ void xattn_token(LAS unsigned char* wl, int t, const bf16* QX, const bf16* KV, bf16* OX, int lane) {
    LAS float* qs = (LAS float*)wl;
    LAS float* P = qs + 256;
    const int b = t >> 13;
    const bf16* kvb = KV + (size_t)b * 256 * 2048;
    for (int h = 0; h < 4; ++h) {
        for (int i = lane; i < 256; i += 64) qs[i] = bf2f(QX[(size_t)t * D + h * 256 + i]);
        WAVE_LDS_SYNC();
        float lg[4];
#pragma unroll
        for (int i = 0; i < 4; ++i) {
            const int m = lane + 64 * i;
            const bf16* kr = kvb + (size_t)m * 2048 + h * 256;
            float a = 0.f;
            for (int c = 0; c < 256; c += 8) {
                const v4u kk = *(const v4u*)(kr + c);
                a += lo16(kk.x) * qs[c] + hi16(kk.x) * qs[c + 1] + lo16(kk.y) * qs[c + 2] + hi16(kk.y) * qs[c + 3] + lo16(kk.z) * qs[c + 4] + hi16(kk.z) * qs[c + 5] + lo16(kk.w) * qs[c + 6] + hi16(kk.w) * qs[c + 7];
            }
            lg[i] = a * 0.0625f;
        }
        const float mx = wave_max(fmaxf(fmaxf(lg[0], lg[1]), fmaxf(lg[2], lg[3])));
        float e[4], sm = 0.f;
#pragma unroll
        for (int i = 0; i < 4; ++i) { e[i] = __expf(lg[i] - mx); sm += e[i]; }
        const float inv = 1.f / wave_sum(sm);
#pragma unroll
        for (int i = 0; i < 4; ++i) P[lane + 64 * i] = e[i] * inv;
        WAVE_LDS_SYNC();
        float o[4] = { 0.f, 0.f, 0.f, 0.f };
        for (int m = 0; m < 256; ++m) {
            const float p = P[m];
            const bf16* vr = kvb + (size_t)m * 2048 + 1024 + h * 256;
#pragma unroll
            for (int i = 0; i < 4; ++i) o[i] += p * bf2f(vr[lane + 64 * i]);
        }
#pragma unroll
        for (int i = 0; i < 4; ++i) OX[(size_t)t * D + h * 256 + lane + 64 * i] = (bf16)f2bf(o[i]);
        WAVE_LDS_SYNC();
    }
}

__device__ __forceinline__ void wave_top16_128(float v0, float v1, int lane, float& tv, int& ti) {
    tv = -INFINITY; ti = 0;
    for (int r = 0; r < 16; ++r) {
        const float m = wave_max(fmaxf(v0, v1));
        const unsigned long long b0 = __ballot(v0 == m);
        int idx;
        if (b0) idx = __ffsll((long long)b0) - 1;
        else { const unsigned long long b1 = __ballot(v1 == m); idx = 64 + __ffsll((long long)b1) - 1; }
        if (lane == r) { tv = m; ti = idx; }
        if (lane == (idx & 63)) { if (idx < 64) v0 = -INFINITY; else v1 = -INFINITY; }
    }
}
__device__ __forceinline__ float gelu_exact(float x) { return 0.5f * x * (1.f + erff(x * 0.70710678118654752f)); }

__device__ __forceinline__ void peer_token(LAS unsigned char* wl, const LAS bf16* sk1, const LAS bf16* sk2, int t, const bf16* QP, const bf16* PU, const bf16* PV,
                                           const float* g3, const float* b3, float* xio, bf16* XB, int lane) {
    LAS bf16* qs = (LAS bf16*)wl;
    LAS int* el = (LAS int*)(wl + 4096);
    LAS float* gl = (LAS float*)(wl + 4096 + 512);
    for (int i = lane; i < 256; i += 64) ((LAS v4u*)qs)[i] = ((const v4u*)(QP + (size_t)t * 2048))[i];
    WAVE_LDS_SYNC();
    for (int hh = 0; hh < 8; ++hh) {
        float s1a = 0.f, s1b = 0.f, s2a = 0.f, s2b = 0.f;
        for (int c = 0; c < 128; c += 8) {
            const v4u q1 = *(const LAS v4u*)(qs + hh * 256 + c), q2 = *(const LAS v4u*)(qs + hh * 256 + 128 + c);
            s1a += dot8bb(*(const LAS v4u*)(sk1 + lane * 136 + c), q1);
            s1b += dot8bb(*(const LAS v4u*)(sk1 + (lane + 64) * 136 + c), q1);
            s2a += dot8bb(*(const LAS v4u*)(sk2 + lane * 136 + c), q2);
            s2b += dot8bb(*(const LAS v4u*)(sk2 + (lane + 64) * 136 + c), q2);
        }
        float tv1, tv2; int ti1, ti2;
        wave_top16_128(s1a, s1b, lane, tv1, ti1);
        wave_top16_128(s2a, s2b, lane, tv2, ti2);
        float cd[4];
#pragma unroll
        for (int i = 0; i < 4; ++i) cd[i] = __shfl(tv1, (lane >> 4) + 4 * i) + __shfl(tv2, lane & 15);
        float tv = -INFINITY; int ti = 0;
        for (int r = 0; r < 16; ++r) {
            const float m = wave_max(fmaxf(fmaxf(cd[0], cd[1]), fmaxf(cd[2], cd[3])));
            int idx = -1;
#pragma unroll
            for (int i = 0; i < 4; ++i) { const unsigned long long bq = __ballot(cd[i] == m); if (idx < 0 && bq) idx = 64 * i + __ffsll((long long)bq) - 1; }
            if (lane == r) { tv = m; ti = idx; }
#pragma unroll
            for (int i = 0; i < 4; ++i) if (idx == lane + 64 * i) cd[i] = -INFINITY;
        }
        const float mx = __shfl(tv, 0);
        const float ex = (lane < 16) ? __expf(tv - mx) : 0.f;
        const float inv = 1.f / wave_sum(ex);
        const int e1 = __shfl(ti1, ti >> 4), e2 = __shfl(ti2, ti & 15);
        if (lane < 16) { el[hh * 16 + lane] = e1 * 128 + e2; gl[hh * 16 + lane] = ex * inv; }
    }
    WAVE_LDS_SYNC();
    float xa[8], xb[8];
    {
        const f32x4* xr = (const f32x4*)(xio + (size_t)t * D);
        const f32x4 a0 = xr[2 * lane], a1 = xr[2 * lane + 1], c0 = xr[128 + 2 * lane], c1 = xr[128 + 2 * lane + 1];
        xa[0] = a0.x; xa[1] = a0.y; xa[2] = a0.z; xa[3] = a0.w; xa[4] = a1.x; xa[5] = a1.y; xa[6] = a1.z; xa[7] = a1.w;
        xb[0] = c0.x; xb[1] = c0.y; xb[2] = c0.z; xb[3] = c0.w; xb[4] = c1.x; xb[5] = c1.y; xb[6] = c1.z; xb[7] = c1.w;
    }
    float oa[8], ob[8];
#pragma unroll
    for (int i = 0; i < 8; ++i) { oa[i] = 0.f; ob[i] = 0.f; }
    const bool b5 = (lane & 32) != 0, b4 = (lane & 16) != 0, b3b = (lane & 8) != 0;
    for (int e0 = 0; e0 < 128; e0 += 8) {
        float p[8];
#pragma unroll
        for (int r = 0; r < 8; ++r) {
            const int id = el[e0 + r];
            const bf16* row = PU + (size_t)id * D;
            const v4u ua = *(const v4u*)(row + 8 * lane), ub = *(const v4u*)(row + 512 + 8 * lane);
            p[r] = dot8(ua, xa) + dot8(ub, xb);
        }
        float q4[4], r2[2], s;
#pragma unroll
        for (int i = 0; i < 4; ++i) { const float send = b5 ? p[i] : p[i + 4]; const float recv = __shfl_xor(send, 32); q4[i] = (b5 ? p[i + 4] : p[i]) + recv; }
#pragma unroll
        for (int i = 0; i < 2; ++i) { const float send = b4 ? q4[i] : q4[i + 2]; const float recv = __shfl_xor(send, 16); r2[i] = (b4 ? q4[i + 2] : q4[i]) + recv; }
        { const float send = b3b ? r2[0] : r2[1]; const float recv = __shfl_xor(send, 8); s = (b3b ? r2[1] : r2[0]) + recv; }
        s += __shfl_xor(s, 4); s += __shfl_xor(s, 2); s += __shfl_xor(s, 1);
        const int mine = (lane >> 3) & 7;
        const float coef = gelu_exact(s) * gl[e0 + mine];
#pragma unroll
        for (int r = 0; r < 8; ++r) {
            const float cr = __shfl(coef, r * 8);
            const int id = el[e0 + r];
            const bf16* row = PV + (size_t)id * D;
            const v4u va = *(const v4u*)(row + 8 * lane), vb = *(const v4u*)(row + 512 + 8 * lane);
            oa[0] += cr * lo16(va.x); oa[1] += cr * hi16(va.x); oa[2] += cr * lo16(va.y); oa[3] += cr * hi16(va.y);
            oa[4] += cr * lo16(va.z); oa[5] += cr * hi16(va.z); oa[6] += cr * lo16(va.w); oa[7] += cr * hi16(va.w);
            ob[0] += cr * lo16(vb.x); ob[1] += cr * hi16(vb.x); ob[2] += cr * lo16(vb.y); ob[3] += cr * hi16(vb.y);
            ob[4] += cr * lo16(vb.z); ob[5] += cr * hi16(vb.z); ob[6] += cr * lo16(vb.w); ob[7] += cr * hi16(vb.w);
        }
    }
    float s1 = 0.f;
#pragma unroll
    for (int i = 0; i < 8; ++i) { oa[i] = ALPHA * xa[i] + oa[i]; ob[i] = ALPHA * xb[i] + ob[i]; s1 += oa[i] + ob[i]; }
    const float mean = wave_sum(s1) * (1.f / D);
    float s2 = 0.f;
#pragma unroll
    for (int i = 0; i < 8; ++i) { oa[i] -= mean; ob[i] -= mean; s2 += oa[i] * oa[i] + ob[i] * ob[i]; }
    const float rstd = rsqrtf(wave_sum(s2) * (1.f / D) + LN_EPS);
    {
        const f32x4* gr = (const f32x4*)g3; const f32x4* br = (const f32x4*)b3;
        f32x4* xo = (f32x4*)(xio + (size_t)t * D);
        v4u* xbo = (v4u*)(XB + (size_t)t * D);
        const f32x4 g0 = gr[2 * lane], g1 = gr[2 * lane + 1], g2 = gr[128 + 2 * lane], g3v = gr[128 + 2 * lane + 1];
        const f32x4 c0 = br[2 * lane], c1 = br[2 * lane + 1], c2 = br[128 + 2 * lane], c3 = br[128 + 2 * lane + 1];
        f32x4 y0, y1, y2, y3;
        y0.x = oa[0] * rstd * g0.x + c0.x; y0.y = oa[1] * rstd * g0.y + c0.y; y0.z = oa[2] * rstd * g0.z + c0.z; y0.w = oa[3] * rstd * g0.w + c0.w;
        y1.x = oa[4] * rstd * g1.x + c1.x; y1.y = oa[5] * rstd * g1.y + c1.y; y1.z = oa[6] * rstd * g1.z + c1.z; y1.w = oa[7] * rstd * g1.w + c1.w;
        y2.x = ob[0] * rstd * g2.x + c2.x; y2.y = ob[1] * rstd * g2.y + c2.y; y2.z = ob[2] * rstd * g2.z + c2.z; y2.w = ob[3] * rstd * g2.w + c2.w;
        y3.x = ob[4] * rstd * g3v.x + c3.x; y3.y = ob[5] * rstd * g3v.y + c3.y; y3.z = ob[6] * rstd * g3v.z + c3.z; y3.w = ob[7] * rstd * g3v.w + c3.w;
        xo[2 * lane] = y0; xo[2 * lane + 1] = y1; xo[128 + 2 * lane] = y2; xo[128 + 2 * lane + 1] = y3;
        v4u w0, w1;
        w0.x = pk2(y0.x, y0.y); w0.y = pk2(y0.z, y0.w); w0.z = pk2(y1.x, y1.y); w0.w = pk2(y1.z, y1.w);
        w1.x = pk2(y2.x, y2.y); w1.y = pk2(y2.z, y2.w); w1.z = pk2(y3.x, y3.y); w1.w = pk2(y3.z, y3.w);
        xbo[lane] = w0; xbo[64 + lane] = w1;
    }
    WAVE_LDS_SYNC();
}

constexpr int PH_PER_LAYER = 12, NPH = 1 + 2 * PH_PER_LAYER;

#define PHASE_ENV() KArgs ap = kargs(); unsigned char* const ws = ap->ws; const int tid = threadIdx.x, lane = tid & 63, wave = __builtin_amdgcn_readfirstlane(tid >> 6); \
    const int G = gridDim.x, bid = blockIdx.x; (void)ws; (void)lane; (void)wave; (void)G; (void)bid
#define P_XB   ((bf16*)(ws + WS_XB))
#define P_HB   ((bf16*)(ws + WS_HB))
#define P_HS   ((float*)(ws + WS_HS))
#define P_CAT  ((bf16*)(ws + WS_CAT))
#define P_CKV  ((bf16*)(ws + WS_CKV))
#define P_SEL  ((unsigned short*)(ws + WS_SEL))
#define P_NSEL ((int*)(ws + WS_NSEL))
#define P_MQ   ((float*)(ws + WS_MQ))
#define P_MK   ((float*)(ws + WS_MK))
#define P_MC   ((float*)(ws + WS_MC))
#define P_MN   ((float*)(ws + WS_MN))
#define P_SCL  ((float*)(ws + WS_SCL))
#define P_BC   ((float*)(ws + WS_BC))
#define P_IG   ((float*)(ws + WS_IG))
#define P_QX   ((bf16*)(ws + WS_QX))
#define P_OX   ((bf16*)(ws + WS_OX))
#define P_QP   ((bf16*)(ws + WS_QP))

#ifndef ONLYSITE
#define SITE(j) true
#else
#define SITE(j) ((j) == ONLYSITE)
#endif
#define IN(k) (lo <= (k) && (k) < hi)
#define SEAM(k) do { if (IN(k) && IN((k) + 1)) xcd_barrier(bar); } while (0)


template <int l>
__device__ __forceinline__ void run_layer(LAS unsigned char* lds, const int lo, const int hi, const XcdBarrier& bar) {
        const int pb = 1 + PH_PER_LAYER * l;
        if (IN(pb + 0) && SITE(1)) {
            PHASE_ENV();
            {
                pg8::Gemm g{P_XB, (const bf16*)(ws + WS_WIN) + (size_t)l * HN * D, T, HN, D}; pg8::StaticOrder S; S.init(T, HN, G, bid);
                EpiH E{P_HB, P_HS};
                pg8::gemm_phase<EpiH, pg8::StaticOrder, true, true>(lds, g, S, E);
            }
            if (l == 0) {
                for (int l2 = 0; l2 < 2; ++l2) {
                    __syncthreads();
                    pg8::Gemm g2{(const bf16*)(ws + WS_MEMB), (const bf16*)(ws + WS_WCKV) + (size_t)l2 * 2048 * D, 512, 2048, D}; pg8::StaticOrder S2; S2.init(512, 2048, G, bid);
                    EpiB16 E2{(bf16*)(ws + WS_KV) + (size_t)l2 * 512 * 2048, 2048};
                    pg8::gemm_phase<EpiB16, pg8::StaticOrder, true, true>(lds, g2, S2, E2);
                }
            }
        }
        SEAM(pb + 0);
        if (IN(pb + 1) && SITE(2)) {
            PHASE_ENV();
#ifndef SUBMASK
#define SUBMASK 15
#endif
            if (SUBMASK & 1) for (int tile = bid; tile < T / 64; tile += G)
                conv_unit(lds, tile, P_HB, ap->in[I_CAW] + (size_t)l * 31 * 256, ap->in[I_CAB] + l * 256, ap->in[I_NAG] + l * 256, ap->in[I_NAB] + l * 256, P_CAT, tid);
            if (SUBMASK & 2) {
                const float* kg = ap->in[I_KVG] + l * 128; const bf16* HB = P_HB; bf16* CKV = P_CKV;
                for (int t = bid * 8 + wave; t < T; t += G * 8) {
                    const float c0 = bf2f(HB[(size_t)t * HN + H_CB + lane]), c1 = bf2f(HB[(size_t)t * HN + H_CB + 64 + lane]);
                    const float r = rsqrtf(wave_sum(c0 * c0 + c1 * c1) * (1.f / 128.f) + LN_EPS);
                    CKV[(size_t)t * 128 + lane] = (bf16)f2bf(c0 * r * kg[lane]); CKV[(size_t)t * 128 + 64 + lane] = (bf16)f2bf(c1 * r * kg[64 + lane]);
                }
            }
            if (SUBMASK & 4) for (int cidx = bid; cidx < NCHUNK; cidx += G)
                mlstm_prep_unit(lds, cidx, P_HB, P_HS, ap->in[I_CMW] + (size_t)l * 4 * 256, ap->in[I_CMB] + l * 256, ap->in[I_WQM] + (size_t)l * 4 * 4096, ap->in[I_WKM] + (size_t)l * 4 * 4096,
                                ap->in[I_BI] + l * 4, ap->in[I_BF] + l * 4, P_MQ, P_MK, P_MC, P_MN, P_SCL, P_BC, P_IG, tid);
            if (SUBMASK & 8) for (int t = bid; t < T; t += G) indexer_query(lds, t, P_HB, P_HS, P_SEL, P_NSEL, tid);
        }
        SEAM(pb + 1);
        if (IN(pb + 2) && SITE(3)) {
            PHASE_ENV();
            if (bid < 65) mlstm_scan(bid * 512 + tid, P_MC, P_MN, P_SCL);
            for (int t = bid * 8 + wave; t < T; t += G * 8) dsa_attn_query(lds + wave * 16384, t, P_HB, P_CKV, P_SEL, P_NSEL, ap->in[I_RELB], P_CAT, lane);
        }
        SEAM(pb + 2);
        if (IN(pb + 3) && SITE(4)) {
            PHASE_ENV();
            for (int cidx = bid; cidx < NCHUNK; cidx += G)
                mlstm_out_unit(lds, cidx, P_HB, P_MQ, P_MK, P_MC, P_MN, P_SCL, P_BC, P_IG, ap->in[I_NMG] + l * 256, P_CAT, tid);
        }
        SEAM(pb + 3);
        if (IN(pb + 4) && SITE(5)) {
            PHASE_ENV();
            pg8::Gemm g{P_CAT, (const bf16*)(ws + WS_WOUT) + (size_t)l * D * CATW, T, D, CATW}; pg8::StaticOrder S; S.init(T, D, G, bid);
            EpiResid E{ap->out, D, ALPHA};
            pg8::gemm_phase<EpiResid, pg8::StaticOrder, true, true>(lds, g, S, E);
        }
        SEAM(pb + 4);
        if (IN(pb + 5) && SITE(6)) {
            PHASE_ENV();
            float* X = ap->out; bf16* XB = P_XB; const float* g1 = ap->in[I_LN1G] + l * D; const float* b1 = ap->in[I_LN1B] + l * D;
            for (int m = bid * 8 + wave; m < T; m += G * 8) ln_row(X + (size_t)m * D, g1, b1, X + (size_t)m * D, XB + (size_t)m * D, lane);
        }
        SEAM(pb + 5);
        if (IN(pb + 6) && SITE(7)) {
            PHASE_ENV();
            pg8::Gemm g{P_XB, (const bf16*)(ws + WS_WCQ) + (size_t)l * D * D, T, D, D}; pg8::StaticOrder S; S.init(T, D, G, bid);
            EpiB16 E{P_QX, D};
            pg8::gemm_phase<EpiB16, pg8::StaticOrder, true, true>(lds, g, S, E);
        }
        SEAM(pb + 6);
        if (IN(pb + 7) && SITE(8)) {
            PHASE_ENV();
            const bf16* KV = (const bf16*)(ws + WS_KV) + (size_t)l * 512 * 2048;
            for (int t = bid * 8 + wave; t < T; t += G * 8) xattn_token(lds + wave * 4096, t, P_QX, KV, P_OX, lane);
        }
        SEAM(pb + 7);
        if (IN(pb + 8) && SITE(9)) {
            PHASE_ENV();
            pg8::Gemm g{P_OX, (const bf16*)(ws + WS_WCO) + (size_t)l * D * D, T, D, D}; pg8::StaticOrder S; S.init(T, D, G, bid);
            EpiResid E{ap->out, D, ALPHA};
            pg8::gemm_phase<EpiResid, pg8::StaticOrder, true, true>(lds, g, S, E);
        }
        SEAM(pb + 8);
        if (IN(pb + 9) && SITE(10)) {
            PHASE_ENV();
            float* X = ap->out; bf16* XB = P_XB; const float* g2 = ap->in[I_LN2G] + l * D; const float* b2 = ap->in[I_LN2B] + l * D;
            for (int m = bid * 8 + wave; m < T; m += G * 8) ln_row(X + (size_t)m * D, g2, b2, X + (size_t)m * D, XB + (size_t)m * D, lane);
        }
        SEAM(pb + 9);
        if (IN(pb + 10) && SITE(11)) {
            PHASE_ENV();
            pg8::Gemm g{P_XB, (const bf16*)(ws + WS_WPQ) + (size_t)l * 2048 * D, T, 2048, D}; pg8::StaticOrder S; S.init(T, 2048, G, bid);
            EpiB16 E{P_QP, 2048};
            pg8::gemm_phase<EpiB16, pg8::StaticOrder, true, true>(lds, g, S, E);
        }
        SEAM(pb + 10);
        if (IN(pb + 11) && SITE(12)) {
            PHASE_ENV();
            LAS bf16* sk1 = (LAS bf16*)lds; LAS bf16* sk2 = sk1 + 128 * 136;
            const float* k1 = ap->in[I_SK1] + (size_t)l * 128 * 128; const float* k2 = ap->in[I_SK2] + (size_t)l * 128 * 128;
            for (int i = tid; i < 128 * 128; i += 512) { const int n = i >> 7, d = i & 127; sk1[n * 136 + d] = (bf16)f2bf(k1[i]); sk2[n * 136 + d] = (bf16)f2bf(k2[i]); }
            __syncthreads();
            const bf16* PU = (const bf16*)(ws + WS_PU) + (size_t)l * 16384 * D; const bf16* PV = (const bf16*)(ws + WS_PV) + (size_t)l * 16384 * D;
            for (int t = bid * 8 + wave; t < T; t += G * 8)
                peer_token(lds + 69632 + wave * 5120, sk1, sk2, t, P_QP, PU, PV, ap->in[I_LN3G] + l * D, ap->in[I_LN3B] + l * D, ap->out, P_XB, lane);
            __syncthreads();
        }
        SEAM(pb + 11);
}

__global__ void __launch_bounds__(512, 2) fwd(Args a_unused) {
    extern __shared__ __attribute__((aligned(16))) unsigned char lds_raw[];
    LAS unsigned char* lds = (LAS unsigned char*)lds_raw;
    volatile LAS unsigned* MISC = (volatile LAS unsigned*)(lds + MISC_OFF);
    if (threadIdx.x < 32) MISC[threadIdx.x] = 0u;
    __syncthreads();
    int lo, hi;
    XcdBarrier bar;
    { KArgs ap = kargs(); lo = ap->lo; hi = ap->hi; bar = xcd_barrier_post((unsigned*)(ap->ws + WS_CTL) + 4096 + ap->li * XCD_BAR_WORDS, MISC + 8); }
    if (IN(0) && SITE(0)) { p0_prologue(lds, threadIdx.x, gridDim.x, blockIdx.x); }
    SEAM(0);

    run_layer<0>(lds, lo, hi, bar);
    run_layer<1>(lds, lo, hi, bar);
#undef IN
#undef SEAM
}

extern "C" void kernel_launch(void* const* d_in, const int* in_sizes, int n_in, void* d_out, int out_size, void* d_ws, size_t ws_size, hipStream_t stream) {
    static int grid = 0;
    if (grid == 0) {
        if (n_in != 35 || out_size != T * D || ws_size < WS_END) { fprintf(stderr, "kernel_launch: unexpected shapes (n_in %d, out %d, ws %zu)\n", n_in, out_size, ws_size); grid = -1; return; }
        int dev = 0, cus = 0, per_cu = 0;
        if (hipGetDevice(&dev) != hipSuccess || hipDeviceGetAttribute(&cus, hipDeviceAttributeMultiprocessorCount, dev) != hipSuccess) { grid = -1; return; }
        if (hipFuncSetAttribute((const void*)fwd, hipFuncAttributeMaxDynamicSharedMemorySize, LDS_BYTES) != hipSuccess) { fprintf(stderr, "kernel_launch: hipFuncSetAttribute failed\n"); grid = -1; return; }
        if (hipOccupancyMaxActiveBlocksPerMultiprocessor(&per_cu, (const void*)fwd, 512, LDS_BYTES) != hipSuccess || per_cu < 1) fprintf(stderr, "kernel_launch: occupancy query reports %d\n", per_cu);
        (void)hipGetLastError();
        grid = cus;
    }
    if (grid < 0) return;
    (void)hipMemsetAsync((char*)d_ws + WS_CTL, 0, CTL_ZERO_BYTES, stream);
    Args a{};
    for (int i = 0; i < 35; ++i) a.in[i] = (const float*)d_in[i];
    a.out = (float*)d_out; a.ws = (unsigned char*)d_ws;
#if MK_SINGLE
    a.lo = 0; a.hi = NPH; a.li = 0; a.pad = 0;
    hipLaunchKernelGGL(fwd, dim3(grid), dim3(512), LDS_BYTES, stream, a);
#else
    for (int p = 0; p < NPH; ++p) { a.lo = p; a.hi = p + 1; a.li = 0; a.pad = 0; hipLaunchKernelGGL(fwd, dim3(grid), dim3(512), LDS_BYTES, stream, a); }
#endif
}
```

```cpp
#include <hip/hip_runtime.h>
#include <cstdio>
#include <cstdint>
namespace pg8 {
#define PG8_LAS __attribute__((address_space(3)))
typedef unsigned short bf16_t;
typedef short bf16x8 __attribute__((ext_vector_type(8)));
typedef float f32x4 __attribute__((ext_vector_type(4)));
typedef unsigned u32x4 __attribute__((ext_vector_type(4)));
constexpr int BM = 256, BK = 64, HALF = 128, HTB = HALF * BK * 2  , STAGE_BYTES = 8 * HTB, NXCD = 8, WGM = 8;

__host__ __device__ __forceinline__ int lds_byte(int r, int c) { const int st = (r >> 4) * 2 + (c >> 5), rr = r & 15, cc = c & 31, ob = rr * 64 + cc * 2; return st * 1024 + (ob ^ (((ob >> 9) & 1) << 5)); }
__host__ __device__ __forceinline__ void stage_rc(int b, int& R, int& C) { const int st = b / 1024, sb = b % 1024, swz = sb ^ (((sb >> 9) & 1) << 5); R = (st >> 1) * 16 + swz / 64; C = (st & 1) * 32 + (swz % 64) / 2; }
__host__ __device__ __forceinline__ int perm32(int rho) { const int n = rho >> 4, i = rho & 15; return 8 * (i >> 2) + 4 * n + (i & 3); }

struct Unit { int pm, pn; };
struct Gemm { const bf16_t* A; const bf16_t* Bt; int M, N, K; };

struct StaticOrder {
    int nM, nN, nwg, G, c;
    __host__ __device__ void init(int M, int N, int G_, int c_) { nM = M / BM; nN = N / BM; nwg = nM * nN; G = G_; c = c_; }
    __host__ __device__ bool next(int i, Unit& u) const {
        const long L = (long)i * G + c; if (L >= nwg) return false;
        int wgid = (int)L; { const int q = nwg / NXCD, r = nwg % NXCD, xcd = wgid % NXCD, off = wgid / NXCD; wgid = (xcd < r ? xcd * (q + 1) : r * (q + 1) + (xcd - r) * q) + off; }
        const int nig = WGM * nN, gid = wgid / nig, fm = gid * WGM, gsz = (nM - fm) < WGM ? (nM - fm) : WGM;
        u.pm = fm + ((wgid % nig) % gsz); u.pn = (wgid % nig) / gsz; return true;
    }
    __device__ __forceinline__ void a_ready(const Unit&) const {}
    __device__ __forceinline__ void done(const Unit&) const {}
};
__device__ __forceinline__ unsigned cvt_pk_bf16(float lo, float hi) { unsigned r; asm volatile("v_cvt_pk_bf16_f32 %0, %1, %2" : "=v"(r) : "v"(lo), "v"(hi)); return r; }
template <class Epi, class Sched, bool ALIGN_EPI = false, bool SP2 = false>
__device__ __forceinline__ void gemm_phase(PG8_LAS unsigned char* lds, const Gemm g, const Sched& S, const Epi& E) {
    const int tid = threadIdx.x, wid = __builtin_amdgcn_readfirstlane(tid >> 6), lane = tid & 63, wr = wid >> 2, wc = wid & 3, fr = lane & 15, fq = lane >> 4;
    const int K = g.K, nt = K / BK;
    unsigned voffA[2], voffB[2];
#pragma unroll
    for (int i = 0; i < 2; ++i) { int R, C; stage_rc(tid * 16 + i * 8192, R, C); const int Rb = Epi::PERM ? ((R & ~31) + perm32(R & 31)) : R;
        voffA[i] = (unsigned)(R * K + C) * 2u; voffB[i] = (unsigned)(Rb * K + C) * 2u; }
    const size_t kstep = (size_t)(BK * 2);
    const size_t hstep = (size_t)HALF * K * 2;
    const size_t tstep = 2 * hstep;
    const unsigned ldsw = (unsigned)wid * 1024u;
    const int aoff = lds_byte(wr * 64 + fr, fq * 8), boff = lds_byte(wc * 32 + fr, fq * 8);
#define PG8_SA(b, h) (((b) * 2 + (h)) * HTB)
#define PG8_SB(b, h) ((4 + (b) * 2 + (h)) * HTB)
#define PG8_STAGE(bufoff, gbase, voff) do { _Pragma("unroll") for (int _i = 0; _i < 2; ++_i) \
        __builtin_amdgcn_global_load_lds((const unsigned*)((const char*)(gbase) + (voff)[_i]), (PG8_LAS unsigned*)(lds + (bufoff) + ldsw + _i * 8192), 16, 0, 0); } while (0)
#define PG8_LDA(dst, b, h) do { _Pragma("unroll") for (int m = 0; m < 4; ++m) _Pragma("unroll") for (int k = 0; k < 2; ++k) dst[m][k] = *(const PG8_LAS bf16x8*)(lds + PG8_SA(b, h) + aoff + m * 2048 + k * 1024); } while (0)
#define PG8_LDB(dst, b, h) do { _Pragma("unroll") for (int n = 0; n < 2; ++n) _Pragma("unroll") for (int k = 0; k < 2; ++k) dst[n][k] = *(const PG8_LAS bf16x8*)(lds + PG8_SB(b, h) + boff + n * 2048 + k * 1024); } while (0)
#define PG8_MMA(ai, bj, At, Bt) do { __builtin_amdgcn_s_setprio(1); _Pragma("unroll") for (int m = 0; m < 4; ++m) _Pragma("unroll") for (int n = 0; n < 2; ++n) _Pragma("unroll") for (int k = 0; k < 2; ++k) \
        acc[ai][bj][m][n] = __builtin_amdgcn_mfma_f32_16x16x32_bf16(Bt[n][k], At[m][k], acc[ai][bj][m][n], 0, 0, 0); __builtin_amdgcn_s_setprio(0); } while (0)
#define PG8_WAIT_V(n) asm volatile("s_waitcnt vmcnt(" #n ")" ::: "memory")
#define PG8_WAIT_L(n) asm volatile("s_waitcnt lgkmcnt(" #n ")" ::: "memory")
#define PG8_BAR __builtin_amdgcn_s_barrier()
#define PG8_SCHED __builtin_amdgcn_sched_barrier(0)
    Unit cur, nxt; int ui = 0;
    if (!S.next(0, cur)) return;
    f32x4 acc[2][2][4][2];
#pragma unroll
    for (int a = 0; a < 2; ++a)
#pragma unroll
        for (int b = 0; b < 2; ++b)
#pragma unroll
            for (int m = 0; m < 4; ++m)
#pragma unroll
                for (int n = 0; n < 2; ++n) acc[a][b][m][n] = (f32x4){0.f, 0.f, 0.f, 0.f};
    bf16x8 At[4][2], B0[2][2], B1[2][2];
    const char* cA = (const char*)g.A + (size_t)cur.pm * tstep; const char* cB = (const char*)g.Bt + (size_t)cur.pn * tstep;
    S.a_ready(cur);
    if constexpr (SP2) {
        PG8_STAGE(PG8_SB(0, 0), cB, voffB); PG8_STAGE(PG8_SB(0, 1), cB + hstep, voffB); PG8_STAGE(PG8_SA(0, 0), cA, voffA); PG8_STAGE(PG8_SA(0, 1), cA + hstep, voffA);
        if (wr == 1) PG8_BAR;
        PG8_WAIT_V(2); PG8_BAR;
        PG8_STAGE(PG8_SB(1, 0), cB + kstep, voffB); PG8_STAGE(PG8_SA(1, 0), cA + kstep, voffA); PG8_STAGE(PG8_SB(1, 1), cB + hstep + kstep, voffB);
        PG8_WAIT_V(6); PG8_BAR;
    } else {
        PG8_STAGE(PG8_SB(0, 0), cB, voffB); PG8_STAGE(PG8_SA(0, 0), cA, voffA); PG8_STAGE(PG8_SB(0, 1), cB + hstep, voffB); PG8_STAGE(PG8_SA(0, 1), cA + hstep, voffA);
        if (wr == 1) PG8_BAR;
        PG8_WAIT_V(4); PG8_BAR;
        PG8_STAGE(PG8_SB(1, 0), cB + kstep, voffB); PG8_STAGE(PG8_SA(1, 0), cA + kstep, voffA); PG8_STAGE(PG8_SB(1, 1), cB + hstep + kstep, voffB);
        PG8_WAIT_V(6); PG8_BAR;
    }
    for (;;) {
        const bool has_next = S.next(ui + 1, nxt);
        const char* nA = has_next ? (const char*)g.A + (size_t)nxt.pm * tstep : cA; const char* nB = has_next ? (const char*)g.Bt + (size_t)nxt.pn * tstep : cB;
        for (int t = 0; t < nt; t += 2) {
            const bool last = (t == nt - 2);
            const char* a1 = cA + (size_t)(t + 1) * kstep;
            const char* a2 = last ? nA : cA + (size_t)(t + 2) * kstep; const char* b2 = last ? nB : cB + (size_t)(t + 2) * kstep;
            const char* a3 = a2 + kstep; const char* b3 = b2 + kstep;
            if (last && has_next) S.a_ready(nxt);
            if constexpr (SP2) {
            PG8_LDB(B0, 0, 0); PG8_LDB(B1, 0, 1); PG8_SCHED; PG8_LDA(At, 0, 0); PG8_STAGE(PG8_SA(1, 1), a1 + hstep, voffA);
            PG8_WAIT_V(8); PG8_WAIT_L(0); PG8_BAR; PG8_MMA(0, 0, At, B0); PG8_MMA(0, 1, At, B1); PG8_BAR; PG8_SCHED;
            PG8_LDA(At, 0, 1); PG8_STAGE(PG8_SB(0, 0), b2, voffB); PG8_STAGE(PG8_SB(0, 1), b2 + hstep, voffB); PG8_STAGE(PG8_SA(0, 0), a2, voffA);
            PG8_WAIT_V(8); PG8_WAIT_L(0); PG8_BAR; PG8_MMA(1, 0, At, B0); PG8_MMA(1, 1, At, B1); PG8_BAR; PG8_SCHED;
            PG8_LDB(B0, 1, 0); PG8_LDB(B1, 1, 1); PG8_SCHED; PG8_LDA(At, 1, 0); PG8_STAGE(PG8_SA(0, 1), a2 + hstep, voffA);
            PG8_WAIT_V(8); PG8_WAIT_L(0); PG8_BAR; PG8_MMA(0, 0, At, B0); PG8_MMA(0, 1, At, B1); PG8_BAR; PG8_SCHED;
            PG8_LDA(At, 1, 1); PG8_STAGE(PG8_SB(1, 0), b3, voffB); PG8_STAGE(PG8_SB(1, 1), b3 + hstep, voffB); PG8_STAGE(PG8_SA(1, 0), a3, voffA);
            PG8_WAIT_V(8); PG8_WAIT_L(0); PG8_BAR; PG8_MMA(1, 0, At, B0); PG8_MMA(1, 1, At, B1); PG8_BAR; PG8_SCHED;
            } else {
            PG8_LDB(B0, 0, 0); PG8_SCHED; PG8_LDA(At, 0, 0); PG8_STAGE(PG8_SA(1, 1), a1 + hstep, voffA);
            PG8_WAIT_L(8); PG8_BAR; PG8_WAIT_L(0); PG8_MMA(0, 0, At, B0); PG8_BAR; PG8_SCHED;
            PG8_LDB(B1, 0, 1); PG8_STAGE(PG8_SB(0, 0), b2, voffB);
            PG8_BAR; PG8_WAIT_L(0); PG8_MMA(0, 1, At, B1); PG8_BAR;
            PG8_LDA(At, 0, 1); PG8_STAGE(PG8_SA(0, 0), a2, voffA);
            PG8_BAR; PG8_WAIT_L(0); PG8_MMA(1, 0, At, B0); PG8_BAR; PG8_SCHED;
            PG8_STAGE(PG8_SB(0, 1), b2 + hstep, voffB);
            PG8_WAIT_V(6); PG8_BAR; PG8_MMA(1, 1, At, B1); PG8_BAR;
            PG8_LDB(B0, 1, 0); PG8_SCHED; PG8_LDA(At, 1, 0); PG8_STAGE(PG8_SA(0, 1), a2 + hstep, voffA);
            PG8_WAIT_L(8); PG8_BAR; PG8_WAIT_L(0); PG8_MMA(0, 0, At, B0); PG8_BAR; PG8_SCHED;
            PG8_LDB(B1, 1, 1); PG8_STAGE(PG8_SB(1, 0), b3, voffB);
            PG8_BAR; PG8_WAIT_L(0); PG8_MMA(0, 1, At, B1); PG8_BAR;
            PG8_LDA(At, 1, 1); PG8_STAGE(PG8_SA(1, 0), a3, voffA);
            PG8_BAR; PG8_WAIT_L(0); PG8_MMA(1, 0, At, B0); PG8_BAR; PG8_SCHED;
            PG8_STAGE(PG8_SB(1, 1), b3 + hstep, voffB);
            PG8_WAIT_V(6); PG8_BAR; PG8_MMA(1, 1, At, B1); PG8_BAR;
            }
        }
        if constexpr (ALIGN_EPI) { if (wr == 0) PG8_BAR; }
        if constexpr (!Epi::AFTER_DRAIN) { E(acc, cur, wr, wc, fr, fq); S.done(cur); }
        if (!has_next) break;
#pragma unroll
        for (int a = 0; a < 2; ++a)
#pragma unroll
            for (int b = 0; b < 2; ++b)
#pragma unroll
                for (int m = 0; m < 4; ++m)
#pragma unroll
                    for (int n = 0; n < 2; ++n) acc[a][b][m][n] = (f32x4){0.f, 0.f, 0.f, 0.f};
        cur = nxt; cA = nA; cB = nB; ++ui;
        if constexpr (ALIGN_EPI) { if (wr == 1) PG8_BAR; }
    }
    PG8_WAIT_V(0);
    if constexpr (!ALIGN_EPI) { if (wr == 0) PG8_BAR; }
    PG8_BAR;
    if constexpr (Epi::AFTER_DRAIN) { E.fused(acc, cur, wr, wc, fr, fq, lds, wid, lane); S.done(cur); }
#undef PG8_SA
#undef PG8_SB
#undef PG8_STAGE
#undef PG8_LDA
#undef PG8_LDB
#undef PG8_MMA
#undef PG8_WAIT_V
#undef PG8_WAIT_L
#undef PG8_BAR
#undef PG8_SCHED
}
}

#define LAS __attribute__((address_space(3)))
typedef unsigned short bf16;
typedef unsigned v4u __attribute__((ext_vector_type(4)));
typedef unsigned v2u __attribute__((ext_vector_type(2)));
typedef float f32x4 __attribute__((ext_vector_type(4)));

#ifndef MK_SINGLE
#define MK_SINGLE 1
#endif

constexpr int NB = 2, L = 8192, T = NB * L, D = 1024;
constexpr int HN = 2816;
constexpr int H_A = 0, H_QL = 512, H_CB = 1536, H_QI = 1664, H_KI = 1920, H_XC = 1984, H_V = 2240, H_O = 2496, H_S = 2752;
constexpr int CATW = 1536, CAT_A = 0, CAT_B = 256, CAT_C = 1280;
constexpr int WIN_N = 2252;
constexpr float ALPHA = 1.4142135623730951f;
constexpr float LN_EPS = 1e-5f;
constexpr int NCHUNK = 1024;

constexpr size_t MiB = 1u << 20;
constexpr size_t WS_CTL = 0, CTL_ZERO_BYTES = 1 * MiB;
constexpr size_t WS_WIN  = 1 * MiB;
constexpr size_t WS_WOUT = 12 * MiB;
constexpr size_t WS_WCQ  = 18 * MiB;
constexpr size_t WS_WCKV = 22 * MiB;
constexpr size_t WS_WCO  = 30 * MiB;
constexpr size_t WS_WPQ  = 34 * MiB;
constexpr size_t WS_MEMB = 42 * MiB;
constexpr size_t WS_KV   = 43 * MiB;
constexpr size_t WS_PU   = 48 * MiB;
constexpr size_t WS_PV   = 112 * MiB;
constexpr size_t WS_XB   = 176 * MiB;
constexpr size_t WS_HB   = 208 * MiB;
constexpr size_t WS_QX   = 208 * MiB;
constexpr size_t WS_OX   = 240 * MiB;
constexpr size_t WS_QP   = 208 * MiB;
constexpr size_t WS_HS   = 296 * MiB;
constexpr size_t WS_CAT  = 297 * MiB;
constexpr size_t WS_CKV  = 345 * MiB;
constexpr size_t WS_SEL  = 349 * MiB;
constexpr size_t WS_MQ   = 357 * MiB;
constexpr size_t WS_MK   = 373 * MiB;
constexpr size_t WS_MC   = 389 * MiB;
constexpr size_t WS_MN   = 405 * MiB;
constexpr size_t WS_SCL  = WS_MN + 512 * 1024;
constexpr size_t WS_BC   = 406 * MiB;
constexpr size_t WS_IG   = WS_BC + 512 * 1024;
constexpr size_t WS_NSEL = 407 * MiB;
constexpr size_t WS_END  = 408 * MiB;

constexpr int LDS_BYTES = 147456;
constexpr int MISC_OFF = 131072 + 320;

__device__ __forceinline__ float bf2f(unsigned h) { return __uint_as_float(h << 16); }
__device__ __forceinline__ unsigned f2bf(float f) { unsigned u = __float_as_uint(f); return (u + 0x7fffu + ((u >> 16) & 1u)) >> 16; }
__device__ __forceinline__ unsigned pk2(float lo, float hi) { return f2bf(lo) | (f2bf(hi) << 16); }
__device__ __forceinline__ float lo16(unsigned u) { return __uint_as_float(u << 16); }
__device__ __forceinline__ float hi16(unsigned u) { return __uint_as_float(u & 0xffff0000u); }
__device__ __forceinline__ float wave_sum(float v) {
#pragma unroll
    for (int o = 1; o < 64; o <<= 1) v += __shfl_xor(v, o);
    return v;
}
__device__ __forceinline__ float wave_max(float v) {
#pragma unroll
    for (int o = 1; o < 64; o <<= 1) v = fmaxf(v, __shfl_xor(v, o));
    return v;
}
__device__ __forceinline__ int wave_sum_i(int v) {
#pragma unroll
    for (int o = 1; o < 64; o <<= 1) v += __shfl_xor(v, o);
    return v;
}
#define WAVE_LDS_SYNC() asm volatile("s_waitcnt lgkmcnt(0)" ::: "memory")
__device__ __forceinline__ float sigmoidf_(float x) { return 1.f / (1.f + __expf(-x)); }
__device__ __forceinline__ float dot8(v4u a, const float (&x)[8]) {
    return lo16(a.x) * x[0] + hi16(a.x) * x[1] + lo16(a.y) * x[2] + hi16(a.y) * x[3] + lo16(a.z) * x[4] + hi16(a.z) * x[5] + lo16(a.w) * x[6] + hi16(a.w) * x[7];
}
__device__ __forceinline__ float dot8bb(v4u a, v4u b) {
    return lo16(a.x) * lo16(b.x) + hi16(a.x) * hi16(b.x) + lo16(a.y) * lo16(b.y) + hi16(a.y) * hi16(b.y) + lo16(a.z) * lo16(b.z) + hi16(a.z) * hi16(b.z) + lo16(a.w) * lo16(b.w) + hi16(a.w) * hi16(b.w);
}

#define XB_TMO      128
#define XB_XCNT(j)  (256  + 64 * (j))
#define XB_XSUB(j)  (1280 + 64 * (j))
#define XB_XGEN(j)  (2304 + 64 * (j))
#define XB_TOP      3328
#define XB_TOPGEN   3392
#define XCD_BAR_WORDS 3456
#define XB_SPIN_CAP (1u << 18)

__device__ __forceinline__ unsigned xb_ld(unsigned* p)              { return __hip_atomic_load(p, __ATOMIC_RELAXED, __HIP_MEMORY_SCOPE_AGENT); }
__device__ __forceinline__ unsigned xb_add(unsigned* p, unsigned v) { return __hip_atomic_fetch_add(p, v, __ATOMIC_RELAXED, __HIP_MEMORY_SCOPE_AGENT); }
__device__ __forceinline__ unsigned xb_xcc_id() { return (unsigned)__builtin_amdgcn_s_getreg((3 << 11) | 20) & 0xFu; }
#define XB_SPIN(cond, bar) do { unsigned _sp = 0; while (cond) { __builtin_amdgcn_s_sleep(1); \
    if ((++_sp & 255u) == 0u) { if (xb_ld(&(bar)[XB_TMO])) break; if (_sp > XB_SPIN_CAP) { atomicAdd(&(bar)[XB_TMO], 1u); break; } } } } while (0)

struct XcdBarrier { unsigned* bar; unsigned x; volatile LAS unsigned* st; };

__device__ __forceinline__ XcdBarrier xcd_barrier_post(unsigned* bar, volatile LAS unsigned* st) {
    XcdBarrier b; b.bar = bar; b.x = xb_xcc_id(); b.st = st;
    if (threadIdx.x == 0) (void)xb_add(&bar[XB_XCNT(b.x)], 1u);
    return b;
}
__device__ __forceinline__ void xcd_barrier_complete(unsigned* bar, unsigned x, unsigned& nloc, unsigned& nx) {
    const unsigned G = gridDim.x * gridDim.y * gridDim.z;
    unsigned sum, cnt, mine, sp = 0u;
    for (;;) {
        sum = 0u; cnt = 0u; mine = 0u;
#pragma unroll
        for (unsigned j = 0; j < 16; ++j) { const unsigned c = xb_ld(&bar[XB_XCNT(j)]); sum += c; cnt += (c > 0u) ? 1u : 0u; mine = (j == x) ? c : mine; }
        if (sum == G) break;
        __builtin_amdgcn_s_sleep(1);
        if ((++sp & 255u) == 0u) { if (xb_ld(&bar[XB_TMO])) break; if (sp > XB_SPIN_CAP) { atomicAdd(&bar[XB_TMO], 1u); break; } }
    }
    nloc = mine > 0u ? mine : 1u; nx = cnt > 0u ? cnt : 1u;
}
__device__ __forceinline__ void xcd_barrier(const XcdBarrier& b) {
    asm volatile("s_waitcnt vmcnt(0)" ::: "memory");
    __syncthreads();
    if (threadIdx.x == 0) {
        unsigned* bar = b.bar;
        __builtin_amdgcn_s_waitcnt(0);
        unsigned nloc = b.st[0], nx = b.st[1];
        if (nloc == 0u) { xcd_barrier_complete(bar, b.x, nloc, nx); b.st[0] = nloc; b.st[1] = nx; }
        const unsigned old = xb_add(&bar[XB_XSUB(b.x)], 1u);
        const unsigned gen = old / nloc;
        if (old + 1u == (gen + 1u) * nloc) {
            __builtin_amdgcn_fence(__ATOMIC_RELEASE, "agent");
            asm volatile("s_waitcnt vmcnt(0)" ::: "memory");
            const unsigned og = xb_add(&bar[XB_TOP], 1u);
            const unsigned tg = og / nx;
            if (og + 1u == (tg + 1u) * nx) xb_add(&bar[XB_TOPGEN], 1u);
            else XB_SPIN(xb_ld(&bar[XB_TOPGEN]) == tg, bar);
            __builtin_amdgcn_fence(__ATOMIC_ACQUIRE, "agent");
            xb_add(&bar[XB_XGEN(b.x)], 1u);
            asm volatile("s_waitcnt vmcnt(0)" ::: "memory");
        } else {
            XB_SPIN(xb_ld(&bar[XB_XGEN(b.x)]) == gen, bar);
            __builtin_amdgcn_fence(__ATOMIC_ACQUIRE, "agent");
            asm volatile("s_waitcnt vmcnt(0)" ::: "memory");
        }
    }
    __syncthreads();
}

struct EpiH {
    static constexpr bool PERM = true, AFTER_DRAIN = false;
    bf16* H; float* Hs;
    __device__ __forceinline__ void operator()(const pg8::f32x4 (&acc)[2][2][4][2], const pg8::Unit& u, int wr, int wc, int fr, int fq) const {
        const int row0 = u.pm * 256 + wr * 64 + fr, col0 = u.pn * 256 + wc * 32 + 8 * fq;
#pragma unroll
        for (int ai = 0; ai < 2; ++ai)
#pragma unroll
            for (int m = 0; m < 4; ++m) {
                const int row = row0 + ai * 128 + m * 16;
#pragma unroll
                for (int bj = 0; bj < 2; ++bj) {
                    const int c = col0 + bj * 128;
                    const pg8::f32x4 v0 = acc[ai][bj][m][0], v1 = acc[ai][bj][m][1];
                    v4u w; w.x = pk2(v0[0], v0[1]); w.y = pk2(v0[2], v0[3]); w.z = pk2(v1[0], v1[1]); w.w = pk2(v1[2], v1[3]);
                    *(v4u*)(H + (size_t)row * HN + c) = w;
                    if (c == H_S || c == H_S + 8) { float* s = Hs + (size_t)row * 16 + (c - H_S); *(pg8::f32x4*)s = v0; *(pg8::f32x4*)(s + 4) = v1; }
                }
            }
    }
};
struct EpiB16 {
    static constexpr bool PERM = true, AFTER_DRAIN = false;
    bf16* O; int ldc;
    __device__ __forceinline__ void operator()(const pg8::f32x4 (&acc)[2][2][4][2], const pg8::Unit& u, int wr, int wc, int fr, int fq) const {
        const int row0 = u.pm * 256 + wr * 64 + fr, col0 = u.pn * 256 + wc * 32 + 8 * fq;
#pragma unroll
        for (int ai = 0; ai < 2; ++ai)
#pragma unroll
            for (int m = 0; m < 4; ++m) {
                const int row = row0 + ai * 128 + m * 16;
#pragma unroll
                for (int bj = 0; bj < 2; ++bj) {
                    const int c = col0 + bj * 128;
                    const pg8::f32x4 v0 = acc[ai][bj][m][0], v1 = acc[ai][bj][m][1];
                    v4u w; w.x = pk2(v0[0], v0[1]); w.y = pk2(v0[2], v0[3]); w.z = pk2(v1[0], v1[1]); w.w = pk2(v1[2], v1[3]);
                    *(v4u*)(O + (size_t)row * ldc + c) = w;
                }
            }
    }
};
struct EpiResid {
    static constexpr bool PERM = false, AFTER_DRAIN = false;
    float* O; int ldc; float alpha;
    __device__ __forceinline__ void operator()(const pg8::f32x4 (&acc)[2][2][4][2], const pg8::Unit& u, int wr, int wc, int fr, int fq) const {
        const int row0 = u.pm * 256 + wr * 64 + fr, col0 = u.pn * 256 + wc * 32 + 4 * fq;
#pragma unroll
        for (int ai = 0; ai < 2; ++ai)
#pragma unroll
            for (int m = 0; m < 4; ++m) {
                float* rowp = O + (size_t)(row0 + ai * 128 + m * 16) * ldc + col0;
#pragma unroll
                for (int bj = 0; bj < 2; ++bj)
#pragma unroll
                    for (int n = 0; n < 2; ++n) {
                        pg8::f32x4* p = (pg8::f32x4*)(rowp + bj * 128 + n * 16);
                        const pg8::f32x4 x = *p;
                        *p = x * alpha + acc[ai][bj][m][n];
                    }
            }
    }
};

struct Args { const float* in[35]; float* out; unsigned char* ws; int lo, hi, li, pad; };
typedef const __attribute__((address_space(4))) Args* KArgs;
__device__ __forceinline__ KArgs kargs() { KArgs p = (KArgs)__builtin_amdgcn_kernarg_segment_ptr(); asm volatile("" : "+s"(p)); return p; }
enum { I_X = 0, I_MEM, I_LNIN_G, I_LNIN_B, I_RELB, I_WIN, I_CAW, I_CAB, I_NAG, I_NAB, I_KVG, I_WUK, I_WUV, I_CMW, I_CMB, I_WQM, I_WKM, I_BI, I_BF, I_NMG,
       I_WOUT, I_LN1G, I_LN1B, I_WCQ, I_WCKV, I_WCO, I_LN2G, I_LN2B, I_WPQ, I_SK1, I_SK2, I_PU, I_PV, I_LN3G, I_LN3B };

__device__ __forceinline__ void tr_item(LAS float* scr, const float* W, int ldw, int k0, int n0, int ncv, bf16* WT, int ldk, int dr0, int kofs, int tid) {
    const int c = tid & 63, r0 = tid >> 6;
#pragma unroll
    for (int i = 0; i < 8; ++i) { const int r = r0 + 8 * i; scr[r * 65 + c] = (c < ncv) ? W[(size_t)(k0 + r) * ldw + n0 + c] : 0.f; }
    __syncthreads();
#pragma unroll
    for (int i = 0; i < 8; ++i) { const int n = r0 + 8 * i; if (n < ncv) WT[(size_t)(dr0 + n) * ldk + kofs + k0 + c] = (bf16)f2bf(scr[c * 65 + n]); }
    __syncthreads();
}
__device__ __forceinline__ void tr_job(LAS float* scr, const float* W, int K, int ldw, int n0, int nc, bf16* WT, int ldk, int dr0, int kofs, int tid, int G, int bid) {
    const int nnt = (nc + 63) / 64, nitems = (K / 64) * nnt;
    for (int it = bid; it < nitems; it += G) {
        const int kt = it / nnt, nt = it % nnt;
        const int ncv = (nc - nt * 64) < 64 ? (nc - nt * 64) : 64;
        tr_item(scr, W, ldw, kt * 64, n0 + nt * 64, ncv, WT, ldk, dr0 + nt * 64, kofs, tid);
    }
}
__device__ __forceinline__ void ln_row(const float* src, const float* g, const float* b, float* dstf, bf16* dstb, int lane) {
    const f32x4* xr = (const f32x4*)src + lane;
    f32x4 v[4]; float s = 0.f;
#pragma unroll
    for (int j = 0; j < 4; ++j) { v[j] = xr[64 * j]; s += (v[j].x + v[j].y) + (v[j].z + v[j].w); }
    const float mean = wave_sum(s) * (1.f / D); float s2 = 0.f;
#pragma unroll
    for (int j = 0; j < 4; ++j) { v[j] = v[j] - mean; s2 += (v[j].x * v[j].x + v[j].y * v[j].y) + (v[j].z * v[j].z + v[j].w * v[j].w); }
    const float rstd = rsqrtf(wave_sum(s2) * (1.f / D) + LN_EPS);
#pragma unroll
    for (int j = 0; j < 4; ++j) {
        const f32x4 gg = ((const f32x4*)g)[lane + 64 * j], bb = ((const f32x4*)b)[lane + 64 * j];
        const f32x4 y = v[j] * rstd * gg + bb;
        ((f32x4*)dstf)[lane + 64 * j] = y;
        v2u o; o.x = pk2(y.x, y.y); o.y = pk2(y.z, y.w);
        ((v2u*)dstb)[lane + 64 * j] = o;
    }
}

__device__ __forceinline__ void p0_prologue(LAS unsigned char* lds, int tid, int G, int bid) {
    LAS float* scr = (LAS float*)lds;
    KArgs ap = kargs();
    unsigned char* ws = ap->ws;
    for (int l = 0; l < 2; ++l) {
        const float* win = ap->in[I_WIN] + (size_t)l * D * WIN_N;
        bf16* WinT = (bf16*)(ws + WS_WIN) + (size_t)l * HN * D;
        tr_job(scr, win, D, WIN_N, 0, 512, WinT, D, H_A, 0, tid, G, bid);
        tr_job(scr, win, D, WIN_N, 1024, 448, WinT, D, H_CB, 0, tid, G, bid);
        tr_job(scr, win, D, WIN_N, 1476, 768, WinT, D, H_XC, 0, tid, G, bid);
        tr_job(scr, win, D, WIN_N, 1472, 4, WinT, D, H_S, 0, tid, G, bid);
        tr_job(scr, win, D, WIN_N, 2244, 8, WinT, D, H_S + 4, 0, tid, G, bid);
        for (int i = bid * 512 + tid; i < (HN - (H_S + 12)) * D; i += G * 512) WinT[(size_t)(H_S + 12) * D + i] = 0;
        const float* wout = ap->in[I_WOUT] + (size_t)l * D * D;
        bf16* WoutT = (bf16*)(ws + WS_WOUT) + (size_t)l * D * CATW;
        tr_job(scr, wout, 256, D, 0, D, WoutT, CATW, 0, CAT_A, tid, G, bid);
        tr_job(scr, wout + (size_t)768 * D, 256, D, 0, D, WoutT, CATW, 0, CAT_C, tid, G, bid);
        tr_job(scr, ap->in[I_WCQ] + (size_t)l * D * D, D, D, 0, D, (bf16*)(ws + WS_WCQ) + (size_t)l * D * D, D, 0, 0, tid, G, bid);
        tr_job(scr, ap->in[I_WCKV] + (size_t)l * D * 2048, D, 2048, 0, 2048, (bf16*)(ws + WS_WCKV) + (size_t)l * 2048 * D, D, 0, 0, tid, G, bid);
        tr_job(scr, ap->in[I_WCO] + (size_t)l * D * D, D, D, 0, D, (bf16*)(ws + WS_WCO) + (size_t)l * D * D, D, 0, 0, tid, G, bid);
        tr_job(scr, ap->in[I_WPQ] + (size_t)l * D * 2048, D, 2048, 0, 2048, (bf16*)(ws + WS_WPQ) + (size_t)l * 2048 * D, D, 0, 0, tid, G, bid);
    }
    {
        LAS float* sa = (LAS float*)lds;
        LAS float* sb = sa + 64 * 65;
        for (int it = bid; it < 2 * 2 * 128; it += G) {
            const int l = it >> 8, kind = (it >> 7) & 1, h = (it >> 4) & 7, tile = it & 15;
            if (kind == 0) {
                const float* win = ap->in[I_WIN] + (size_t)l * D * WIN_N;
                const float* wuk = ap->in[I_WUK] + (size_t)l * 8 * 64 * 128 + (size_t)h * 64 * 128;
                bf16* WinT = (bf16*)(ws + WS_WIN) + (size_t)l * HN * D;
                const int k0 = tile * 64;
                for (int i = tid; i < 4096; i += 512) { const int kk = i >> 6, d = i & 63; sa[kk * 65 + d] = win[(size_t)(k0 + kk) * WIN_N + 512 + h * 64 + d]; }
                for (int i = tid; i < 8192; i += 512) sb[i] = wuk[i];
                __syncthreads();
                for (int i = tid; i < 8192; i += 512) { const int r = i >> 6, kk = i & 63; float s = 0.f;
#pragma unroll 8
                    for (int d = 0; d < 64; ++d) s += sa[kk * 65 + d] * sb[d * 128 + r];
                    WinT[(size_t)(H_QL + h * 128 + r) * D + k0 + kk] = (bf16)f2bf(s); }
                __syncthreads();
            } else {
                const float* wout = ap->in[I_WOUT] + (size_t)l * D * D;
                const float* wuv = ap->in[I_WUV] + (size_t)l * 8 * 128 * 64 + (size_t)h * 128 * 64;
                bf16* WoutT = (bf16*)(ws + WS_WOUT) + (size_t)l * D * CATW;
                const int n0 = tile * 64;
                for (int i = tid; i < 4096; i += 512) { const int d = i >> 6, n = i & 63; sa[d * 65 + n] = wout[(size_t)(256 + h * 64 + d) * D + n0 + n]; }
                for (int i = tid; i < 8192; i += 512) { const int r = i >> 6, d = i & 63; sb[r * 65 + d] = wuv[i]; }
                __syncthreads();
                for (int i = tid; i < 8192; i += 512) { const int n = i >> 7, r = i & 127; float s = 0.f;
#pragma unroll 8
                    for (int d = 0; d < 64; ++d) s += sb[r * 65 + d] * sa[d * 65 + n];
                    WoutT[(size_t)(n0 + n) * CATW + CAT_B + h * 128 + r] = (bf16)f2bf(s); }
                __syncthreads();
            }
        }
    }
    {
        const size_t gt = (size_t)bid * 512 + tid, gs = (size_t)G * 512;
        const f32x4* pu = (const f32x4*)ap->in[I_PU]; const f32x4* pv = (const f32x4*)ap->in[I_PV]; const f32x4* pm = (const f32x4*)ap->in[I_MEM];
        v2u* du = (v2u*)(ws + WS_PU); v2u* dv = (v2u*)(ws + WS_PV); v2u* dm = (v2u*)(ws + WS_MEMB);
        const size_t n4 = (size_t)2 * 16384 * 1024 / 4;
        for (size_t i = gt; i < n4; i += gs) { const f32x4 x = pu[i]; v2u o; o.x = pk2(x.x, x.y); o.y = pk2(x.z, x.w); du[i] = o; }
        for (size_t i = gt; i < n4; i += gs) { const f32x4 x = pv[i]; v2u o; o.x = pk2(x.x, x.y); o.y = pk2(x.z, x.w); dv[i] = o; }
        for (size_t i = gt; i < (size_t)512 * 1024 / 4; i += gs) { const f32x4 x = pm[i]; v2u o; o.x = pk2(x.x, x.y); o.y = pk2(x.z, x.w); dm[i] = o; }
    }
    {
        const int gw = bid * 8 + (tid >> 6), NGW = G * 8, lane = tid & 63;
        for (int m = gw; m < T; m += NGW)
            ln_row(ap->in[I_X] + (size_t)m * D, ap->in[I_LNIN_G], ap->in[I_LNIN_B], ap->out + (size_t)m * D, (bf16*)(ws + WS_XB) + (size_t)m * D, lane);
    }
}

__device__ __forceinline__ void conv_unit(LAS unsigned char* lds, int tile, const bf16* Hb, const float* cw, const float* cb, const float* ng, const float* nb, bf16* CAT, int tid) {
    LAS float* u = (LAS float*)lds;
    LAS float* w = u + 94 * 256;
    const int t0 = tile * 64, pos0 = t0 & (L - 1);
    for (int i = tid; i < 94 * 256; i += 512) {
        const int r = i >> 8, c = i & 255, pos = pos0 - 30 + r; float val = 0.f;
        if (pos >= 0) { const bf16* hr = Hb + (size_t)(t0 - 30 + r) * HN + H_A; const float av = bf2f(hr[c]), gt = bf2f(hr[256 + c]); val = av * sigmoidf_(gt); }
        u[i] = val;
    }
    for (int i = tid; i < 31 * 256; i += 512) w[i] = cw[i];
    __syncthreads();
    const int wave = tid >> 6, lane = tid & 63;
    for (int tt = wave; tt < 64; tt += 8) {
        float acc[4];
#pragma unroll
        for (int i = 0; i < 4; ++i) { const int c = lane + 64 * i; float s = cb[c];
            asm volatile("" ::: "memory");
#pragma unroll 8
            for (int k = 0; k < 31; ++k) s += w[k * 256 + c] * u[(tt + k) * 256 + c];
            acc[i] = s; }
        const float mean = wave_sum((acc[0] + acc[1]) + (acc[2] + acc[3])) * (1.f / 256.f);
        float s2 = 0.f;
#pragma unroll
        for (int i = 0; i < 4; ++i) { acc[i] -= mean; s2 += acc[i] * acc[i]; }
        const float rstd = rsqrtf(wave_sum(s2) * (1.f / 256.f) + LN_EPS);
#pragma unroll
        for (int i = 0; i < 4; ++i) { const int c = lane + 64 * i; const float y = acc[i] * rstd * ng[c] + nb[c];
            CAT[(size_t)(t0 + tt) * CATW + CAT_A + c] = (bf16)f2bf(y * sigmoidf_(y)); }
    }
    __syncthreads();
}

__device__ __forceinline__ unsigned fkey(float f) { const unsigned u = __float_as_uint(f); return (u & 0x80000000u) ? ~u : (u | 0x80000000u); }

__device__ __forceinline__ int block_sum_i(int v, LAS int* red, int tid) {
    v = wave_sum_i(v);
    if ((tid & 63) == 0) red[tid >> 6] = v;
    __syncthreads();
    int s = 0;
#pragma unroll
    for (int i = 0; i < 8; ++i) s += red[i];
    __syncthreads();
    return s;
}
__device__ __forceinline__ int block_excl_scan_i(int v, LAS int* red, int tid, int& tot) {
    const int lane = tid & 63, wave = tid >> 6;
    int inc = v;
#pragma unroll
    for (int o = 1; o < 64; o <<= 1) { const int y = __shfl_up(inc, o); if (lane >= o) inc += y; }
    if (lane == 63) red[wave] = inc;
    __syncthreads();
    int base = 0, t = 0;
#pragma unroll
    for (int i = 0; i < 8; ++i) { const int r = red[i]; if (i < wave) base += r; t += r; }
    __syncthreads();
    tot = t;
    return base + inc - v;
}

__device__ __forceinline__ void indexer_query(LAS unsigned char* lds, int t, const bf16* Hb, const float* Hs, unsigned short* SEL, int* NSEL, int tid) {
    LAS unsigned* keys = (LAS unsigned*)lds;
    LAS float* qi = (LAS float*)(lds + 32768);
    LAS int* red = (LAS int*)(lds + 32768 + 1024);
    const int b = t >> 13, pos = t & (L - 1), n = pos + 1;
    if (tid < 256) qi[tid] = bf2f(Hb[(size_t)t * HN + H_QI + tid]);
    const float w0 = Hs[(size_t)t * 16 + 0] * 0.5f, w1 = Hs[(size_t)t * 16 + 1] * 0.5f, w2 = Hs[(size_t)t * 16 + 2] * 0.5f, w3 = Hs[(size_t)t * 16 + 3] * 0.5f;
    __syncthreads();
    for (int s = tid; s < n; s += 512) {
        const bf16* kr = Hb + (size_t)(b * L + s) * HN + H_KI;
        float d0 = 0.f, d1 = 0.f, d2 = 0.f, d3 = 0.f;
#pragma unroll 1
        for (int c = 0; c < 64; c += 8) {
            asm volatile("" ::: "memory");
            const v4u kk = *(const v4u*)(kr + c);
            float kf[8] = { lo16(kk.x), hi16(kk.x), lo16(kk.y), hi16(kk.y), lo16(kk.z), hi16(kk.z), lo16(kk.w), hi16(kk.w) };
#pragma unroll
            for (int j = 0; j < 8; ++j) { d0 += qi[c + j] * kf[j]; d1 += qi[64 + c + j] * kf[j]; d2 += qi[128 + c + j] * kf[j]; d3 += qi[192 + c + j] * kf[j]; }
        }
        float sc = 0.f;
        sc += w0 * fmaxf(d0 * 0.125f, 0.f); sc += w1 * fmaxf(d1 * 0.125f, 0.f); sc += w2 * fmaxf(d2 * 0.125f, 0.f); sc += w3 * fmaxf(d3 * 0.125f, 0.f);
        keys[s] = fkey(sc);
    }
    __syncthreads();
    if (n <= 256) {
        for (int s = tid; s < n; s += 512) SEL[(size_t)t * 256 + s] = (unsigned short)s;
        if (tid == 0) NSEL[t] = n;
        __syncthreads();
        return;
    }
    unsigned prefix = 0u;
    for (int bit = 31; bit >= 0; --bit) {
        const unsigned cand = prefix | (1u << bit);
        int c = 0;
        for (int s = tid; s < n; s += 512) c += (keys[s] >= cand) ? 1 : 0;
        c = block_sum_i(c, red, tid);
        if (c >= 256) prefix = cand;
    }
    int ng = 0, nt = 0;
#pragma unroll
    for (int j = 0; j < 16; ++j) { const int s = tid * 16 + j; if (s < n) { const unsigned k = keys[s]; ng += (k > prefix) ? 1 : 0; nt += (k == prefix) ? 1 : 0; } }
    int totg, tott;
    int eg = block_excl_scan_i(ng, red, tid, totg);
    int et = block_excl_scan_i(nt, red, tid, tott);
    const int quota = 256 - totg;
#pragma unroll
    for (int j = 0; j < 16; ++j) { const int s = tid * 16 + j; if (s < n) { const unsigned k = keys[s];
        if (k > prefix) { SEL[(size_t)t * 256 + eg] = (unsigned short)s; ++eg; }
        else if (k == prefix) { if (et < quota) SEL[(size_t)t * 256 + totg + et] = (unsigned short)s; ++et; } } }
    if (tid == 0) NSEL[t] = 256;
    __syncthreads();
}

__device__ __forceinline__ float logsigmoidf_(float x) { return fminf(x, 0.f) - log1pf(__expf(-fabsf(x))); }

__device__ __forceinline__ void mlstm_prep_unit(LAS unsigned char* lds, int cidx, const bf16* Hb, const float* Hs, const float* cmw, const float* cmb, const float* wqm, const float* wkm,
                                                const float* bi, const float* bfp, float* MQ, float* MK, float* MC, float* MN, float* SCL, float* BC, float* IG, int tid) {
    const int j = cidx & 127, h = (cidx >> 7) & 3, b = cidx >> 9, t0 = b * L + j * 64;
    LAS float* xc = (LAS float*)lds;
    LAS float* wq = xc + 64 * 65;
    LAS float* wk = wq + 4096;
    LAS float* kt = wk + 4096;
    LAS float* vt = kt + 64 * 65;
    LAS float* wg = vt + 64 * 65;
    for (int i = tid; i < 4096; i += 512) {
        const int s = i >> 6, d = i & 63, c = h * 64 + d; float av = cmb[c];
#pragma unroll
        for (int k = 0; k < 4; ++k) { const int pos = j * 64 + s - 3 + k; if (pos >= 0) av += cmw[k * 256 + c] * bf2f(Hb[(size_t)(b * L + pos) * HN + H_XC + c]); }
        xc[s * 65 + d] = av * sigmoidf_(av);
        wq[i] = wqm[h * 4096 + i]; wk[i] = wkm[h * 4096 + i];
        vt[s * 65 + d] = bf2f(Hb[(size_t)(t0 + s) * HN + H_V + c]);
    }
    __syncthreads();
    for (int i = tid; i < 4096; i += 512) {
        const int s = i >> 6, e = i & 63; float aq = 0.f, ak = 0.f;
#pragma unroll 8
        for (int d = 0; d < 64; ++d) { const float x = xc[s * 65 + d]; aq += x * wq[d * 64 + e]; ak += x * wk[d * 64 + e]; }
        MQ[(size_t)(t0 + s) * 256 + h * 64 + e] = aq * 0.125f; MK[(size_t)(t0 + s) * 256 + h * 64 + e] = ak; kt[s * 65 + e] = ak;
    }
    if (tid < 64) {
        const int s = tid, t = t0 + s;
        const float fl = logsigmoidf_(Hs[(size_t)t * 16 + 8 + h] + bfp[h]);
        const float ig = Hs[(size_t)t * 16 + 4 + h] + bi[h];
        float bs = fl;
#pragma unroll
        for (int o = 1; o < 64; o <<= 1) { const float y = __shfl_up(bs, o); if (s >= o) bs += y; }
        const float bL = __shfl(bs, 63);
        const float g = bL - bs + ig;
        const float mloc = wave_max(g);
        wg[s] = __expf(g - mloc);
        BC[(size_t)t * 4 + h] = bs; IG[(size_t)t * 4 + h] = ig;
        if (s == 0) { SCL[cidx * 4 + 0] = mloc; SCL[cidx * 4 + 1] = bL; }
    }
    __syncthreads();
    for (int i = tid; i < 4096; i += 512) {
        const int v = i >> 6, k = i & 63; float s2 = 0.f;
#pragma unroll 8
        for (int s = 0; s < 64; ++s) s2 += wg[s] * vt[s * 65 + v] * kt[s * 65 + k];
        MC[(size_t)cidx * 4096 + i] = s2;
    }
    if (tid < 64) { float s2 = 0.f;
        for (int s = 0; s < 64; ++s) s2 += wg[s] * kt[s * 65 + tid];
        MN[(size_t)cidx * 64 + tid] = s2; }
    __syncthreads();
}

__device__ __forceinline__ void mlstm_scan(int gtid, float* MC, float* MN, float* SCL) {
    const int stream = gtid / 4160, e = gtid - stream * 4160;
    if (stream >= 8) return;
    float* base = (e < 4096) ? (MC + e) : (MN + (e - 4096));
    const size_t stride = (e < 4096) ? 4096 : 64;
    float m = 0.f, C = 0.f;
    for (int j0 = 0; j0 < 128; j0 += 8) {
        float loc[8], ml[8], bl[8];
#pragma unroll
        for (int u = 0; u < 8; ++u) { const int cidx = stream * 128 + j0 + u; loc[u] = base[(size_t)cidx * stride]; ml[u] = SCL[cidx * 4 + 0]; bl[u] = SCL[cidx * 4 + 1]; }
#pragma unroll
        for (int u = 0; u < 8; ++u) {
            const int cidx = stream * 128 + j0 + u;
            const float mn = fmaxf(bl[u] + m, ml[u]);
            const float a = __expf(bl[u] + m - mn), c = __expf(ml[u] - mn);
            base[(size_t)cidx * stride] = C;
            if (e == 0) SCL[cidx * 4 + 2] = m;
            C = a * C + c * loc[u]; m = mn;
        }
    }
}

__device__ __forceinline__ int rel_bucket(int dist) {
    const int d = dist > 0 ? dist : 0;
    if (d < 16) return d;
    const int large = 16 + (int)(logf((float)d / 16.f) / 2.0794415416798357f * 16.f);
    return large < 31 ? large : 31;
}

__device__ __forceinline__ void dsa_attn_query(LAS unsigned char* wl, int t, const bf16* Hb, const bf16* CKV, const unsigned short* SEL, const int* NSEL, const float* relb, bf16* CAT, int lane) {
    LAS float* ql = (LAS float*)wl;
    LAS float* P = ql + 1024;
    LAS int* sl = (LAS int*)(P + 2048);
    const int b = t >> 13, pos = t & (L - 1), n = NSEL[t];
    for (int i = lane; i < 1024; i += 64) ql[i] = bf2f(Hb[(size_t)t * HN + H_QL + i]);
    for (int i = lane; i < 256; i += 64) sl[i] = (i < n) ? (int)SEL[(size_t)t * 256 + i] : 0;
    WAVE_LDS_SYNC();
    float lg[4][8];
#pragma unroll
    for (int i = 0; i < 4; ++i) {
        const int kk = lane + 64 * i;
        float acc[8];
#pragma unroll
        for (int h = 0; h < 8; ++h) acc[h] = 0.f;
        const int s = sl[kk];
        const bf16* cr = CKV + (size_t)(b * L + s) * 128;
        for (int c = 0; c < 128; c += 8) {
            const v4u cv = *(const v4u*)(cr + c);
            const float cf[8] = { lo16(cv.x), hi16(cv.x), lo16(cv.y), hi16(cv.y), lo16(cv.z), hi16(cv.z), lo16(cv.w), hi16(cv.w) };
#pragma unroll
            for (int h = 0; h < 8; ++h) {
#pragma unroll
                for (int jj = 0; jj < 8; ++jj) acc[h] += ql[h * 128 + c + jj] * cf[jj];
            }
        }
        const int bk = rel_bucket(pos - s);
#pragma unroll
        for (int h = 0; h < 8; ++h) lg[i][h] = (kk < n) ? (acc[h] * 0.125f + relb[bk * 8 + h]) : -INFINITY;
    }
#pragma unroll
    for (int h = 0; h < 8; ++h) {
        const float mx = wave_max(fmaxf(fmaxf(lg[0][h], lg[1][h]), fmaxf(lg[2][h], lg[3][h])));
        float e[4], sm = 0.f;
#pragma unroll
        for (int i = 0; i < 4; ++i) { e[i] = (lane + 64 * i < n) ? __expf(lg[i][h] - mx) : 0.f; sm += e[i]; }
        const float inv = 1.f / wave_sum(sm);
#pragma unroll
        for (int i = 0; i < 4; ++i) P[h * 256 + lane + 64 * i] = e[i] * inv;
    }
    WAVE_LDS_SYNC();
    float o[8][2];
#pragma unroll
    for (int h = 0; h < 8; ++h) { o[h][0] = 0.f; o[h][1] = 0.f; }
    for (int kk = 0; kk < n; ++kk) {
        const int s = sl[kk];
        const bf16* cr = CKV + (size_t)(b * L + s) * 128;
        const float c0 = bf2f(cr[lane]), c1 = bf2f(cr[64 + lane]);
#pragma unroll
        for (int h = 0; h < 8; ++h) { const float p = P[h * 256 + kk]; o[h][0] += p * c0; o[h][1] += p * c1; }
    }
#pragma unroll
    for (int h = 0; h < 8; ++h) {
        CAT[(size_t)t * CATW + CAT_B + h * 128 + lane] = (bf16)f2bf(o[h][0]);
        CAT[(size_t)t * CATW + CAT_B + h * 128 + 64 + lane] = (bf16)f2bf(o[h][1]);
    }
    WAVE_LDS_SYNC();
}

__device__ __forceinline__ void mlstm_out_unit(LAS unsigned char* lds, int cidx, const bf16* Hb, const float* MQ, const float* MK, const float* MC, const float* MN, const float* SCL,
                                               const float* BC, const float* IG, const float* nmg, bf16* CAT, int tid) {
    const int j = cidx & 127, h = (cidx >> 7) & 3, b = cidx >> 9, t0 = b * L + j * 64;
    LAS float* q = (LAS float*)lds;
    LAS float* k = q + 64 * 65;
    LAS float* v = k + 64 * 65;
    LAS float* C = v + 64 * 65;
    LAS float* S = C + 64 * 65;
    LAS float* hh = S + 64 * 65;
    LAS float* nn = hh + 64 * 65;
    LAS float* bb = nn + 64;
    LAS float* gi = bb + 64;
    LAS float* mrow = gi + 64;
    LAS float* den = mrow + 64;
    for (int i = tid; i < 4096; i += 512) {
        const int s = i >> 6, d = i & 63;
        q[s * 65 + d] = MQ[(size_t)(t0 + s) * 256 + h * 64 + d];
        k[s * 65 + d] = MK[(size_t)(t0 + s) * 256 + h * 64 + d];
        v[s * 65 + d] = bf2f(Hb[(size_t)(t0 + s) * HN + H_V + h * 64 + d]);
        C[s * 65 + d] = MC[(size_t)cidx * 4096 + i];
    }
    if (tid < 64) { nn[tid] = MN[(size_t)cidx * 64 + tid]; bb[tid] = BC[(size_t)(t0 + tid) * 4 + h]; gi[tid] = IG[(size_t)(t0 + tid) * 4 + h]; }
    const float m_in = SCL[cidx * 4 + 2];
    __syncthreads();
    if (tid < 64) {
        const int t = tid; const float bt = bb[t]; float rm = -INFINITY;
        for (int s = 0; s <= t; ++s) rm = fmaxf(rm, bt - bb[s] + gi[s]);
        mrow[t] = fmaxf(bt + m_in, rm);
    }
    __syncthreads();
    for (int i = tid; i < 4096; i += 512) {
        const int t = i >> 6, s = i & 63; float a = 0.f;
        if (s <= t) {
#pragma unroll 8
            for (int d = 0; d < 64; ++d) a += q[t * 65 + d] * k[s * 65 + d];
            a *= __expf(bb[t] - bb[s] + gi[s] - mrow[t]);
        }
        S[t * 65 + s] = a;
    }
    __syncthreads();
    if (tid < 64) {
        const int t = tid; float a = 0.f, nq = 0.f;
        for (int s = 0; s < 64; ++s) a += S[t * 65 + s];
        for (int d = 0; d < 64; ++d) nq += nn[d] * q[t * 65 + d];
        const float wi = __expf(bb[t] + m_in - mrow[t]);
        const float dn = a + wi * nq;
        den[t] = fmaxf(fabsf(dn), __expf(-mrow[t]));
    }
    __syncthreads();
    for (int i = tid; i < 4096; i += 512) {
        const int t = i >> 6, vv = i & 63; float a = 0.f, cq = 0.f;
#pragma unroll 8
        for (int s = 0; s < 64; ++s) a += S[t * 65 + s] * v[s * 65 + vv];
#pragma unroll 8
        for (int d = 0; d < 64; ++d) cq += C[vv * 65 + d] * q[t * 65 + d];
        const float wi = __expf(bb[t] + m_in - mrow[t]);
        hh[t * 65 + vv] = (a + wi * cq) / den[t];
    }
    __syncthreads();
    {
        const int wave = tid >> 6, lane = tid & 63;
        for (int t = wave; t < 64; t += 8) {
            const float x = hh[t * 65 + lane];
            const float mean = wave_sum(x) * (1.f / 64.f);
            const float dx = x - mean;
            const float var = wave_sum(dx * dx) * (1.f / 64.f);
            const float y = dx * rsqrtf(var + LN_EPS) * nmg[h * 64 + lane];
            const float og = bf2f(Hb[(size_t)(t0 + t) * HN + H_O + h * 64 + lane]);
            CAT[(size_t)(t0 + t) * CATW + CAT_C + h * 64 + lane] = (bf16)f2bf(sigmoidf_(og) * y);
        }
    }
    __syncthreads();
}

__device__ __forceinline__ void xattn_token(LAS unsigned char* wl, int t, const bf16* QX, const bf16* KV, bf16* OX, int lane) {
    LAS float* qs = (LAS float*)wl;
    LAS float* P = qs + 256;
    const int b = t >> 13;
    const bf16* kvb = KV + (size_t)b * 256 * 2048;
    for (int h = 0; h < 4; ++h) {
        for (int i = lane; i < 256; i += 64) qs[i] = bf2f(QX[(size_t)t * D + h * 256 + i]);
        WAVE_LDS_SYNC();
        float lg[4];
#pragma unroll
        for (int i = 0; i < 4; ++i) {
            const int m = lane + 64 * i;
            const bf16* kr = kvb + (size_t)m * 2048 + h * 256;
            float a = 0.f;
            for (int c = 0; c < 256; c += 8) {
                const v4u kk = *(const v4u*)(kr + c);
                a += lo16(kk.x) * qs[c] + hi16(kk.x) * qs[c + 1] + lo16(kk.y) * qs[c + 2] + hi16(kk.y) * qs[c + 3] + lo16(kk.z) * qs[c + 4] + hi16(kk.z) * qs[c + 5] + lo16(kk.w) * qs[c + 6] + hi16(kk.w) * qs[c + 7];
            }
            lg[i] = a * 0.0625f;
        }
        const float mx = wave_max(fmaxf(fmaxf(lg[0], lg[1]), fmaxf(lg[2], lg[3])));
        float e[4], sm = 0.f;
#pragma unroll
        for (int i = 0; i < 4; ++i) { e[i] = __expf(lg[i] - mx); sm += e[i]; }
        const float inv = 1.f / wave_sum(sm);
#pragma unroll
        for (int i = 0; i < 4; ++i) P[lane + 64 * i] = e[i] * inv;
        WAVE_LDS_SYNC();
        float o[4] = { 0.f, 0.f, 0.f, 0.f };
        for (int m = 0; m < 256; ++m) {
            const float p = P[m];
            const bf16* vr = kvb + (size_t)m * 2048 + 1024 + h * 256;
#pragma unroll
            for (int i = 0; i < 4; ++i) o[i] += p * bf2f(vr[lane + 64 * i]);
        }
#pragma unroll
        for (int i = 0; i < 4; ++i) OX[(size_t)t * D + h * 256 + lane + 64 * i] = (bf16)f2bf(o[i]);
        WAVE_LDS_SYNC();
    }
}

__device__ __forceinline__ void wave_top16_128(float v0, float v1, int lane, float& tv, int& ti) {
    tv = -INFINITY; ti = 0;
    for (int r = 0; r < 16; ++r) {
        const float m = wave_max(fmaxf(v0, v1));
        const unsigned long long b0 = __ballot(v0 == m);
        int idx;
        if (b0) idx = __ffsll((long long)b0) - 1;
        else { const unsigned long long b1 = __ballot(v1 == m); idx = 64 + __ffsll((long long)b1) - 1; }
        if (lane == r) { tv = m; ti = idx; }
        if (lane == (idx & 63)) { if (idx < 64) v0 = -INFINITY; else v1 = -INFINITY; }
    }
}
__device__ __forceinline__ float gelu_exact(float x) { return 0.5f * x * (1.f + erff(x * 0.70710678118654752f)); }

__device__ __forceinline__ void peer_token(LAS unsigned char* wl, const LAS bf16* sk1, const LAS bf16* sk2, int t, const bf16* QP, const bf16* PU, const bf16* PV,
                                           const float* g3, const float* b3, float* xio, bf16* XB, int lane) {
    LAS bf16* qs = (LAS bf16*)wl;
    LAS int* el = (LAS int*)(wl + 4096);
    LAS float* gl = (LAS float*)(wl + 4096 + 512);
    for (int i = lane; i < 256; i += 64) ((LAS v4u*)qs)[i] = ((const v4u*)(QP + (size_t)t * 2048))[i];
    WAVE_LDS_SYNC();
    for (int hh = 0; hh < 8; ++hh) {
        float s1a = 0.f, s1b = 0.f, s2a = 0.f, s2b = 0.f;
        for (int c = 0; c < 128; c += 8) {
            const v4u q1 = *(const LAS v4u*)(qs + hh * 256 + c), q2 = *(const LAS v4u*)(qs + hh * 256 + 128 + c);
            s1a += dot8bb(*(const LAS v4u*)(sk1 + lane * 136 + c), q1);
            s1b += dot8bb(*(const LAS v4u*)(sk1 + (lane + 64) * 136 + c), q1);
            s2a += dot8bb(*(const LAS v4u*)(sk2 + lane * 136 + c), q2);
            s2b += dot8bb(*(const LAS v4u*)(sk2 + (lane + 64) * 136 + c), q2);
        }
        float tv1, tv2; int ti1, ti2;
        wave_top16_128(s1a, s1b, lane, tv1, ti1);
        wave_top16_128(s2a, s2b, lane, tv2, ti2);
        float cd[4];
#pragma unroll
        for (int i = 0; i < 4; ++i) cd[i] = __shfl(tv1, (lane >> 4) + 4 * i) + __shfl(tv2, lane & 15);
        float tv = -INFINITY; int ti = 0;
        for (int r = 0; r < 16; ++r) {
            const float m = wave_max(fmaxf(fmaxf(cd[0], cd[1]), fmaxf(cd[2], cd[3])));
            int idx = -1;
#pragma unroll
            for (int i = 0; i < 4; ++i) { const unsigned long long bq = __ballot(cd[i] == m); if (idx < 0 && bq) idx = 64 * i + __ffsll((long long)bq) - 1; }
            if (lane == r) { tv = m; ti = idx; }
#pragma unroll
            for (int i = 0; i < 4; ++i) if (idx == lane + 64 * i) cd[i] = -INFINITY;
        }
        const float mx = __shfl(tv, 0);
        const float ex = (lane < 16) ? __expf(tv - mx) : 0.f;
        const float inv = 1.f / wave_sum(ex);
        const int e1 = __shfl(ti1, ti >> 4), e2 = __shfl(ti2, ti & 15);
        if (lane < 16) { el[hh * 16 + lane] = e1 * 128 + e2; gl[hh * 16 + lane] = ex * inv; }
    }
    WAVE_LDS_SYNC();
    float xa[8], xb[8];
    {
        const f32x4* xr = (const f32x4*)(xio + (size_t)t * D);
        const f32x4 a0 = xr[2 * lane], a1 = xr[2 * lane + 1], c0 = xr[128 + 2 * lane], c1 = xr[128 + 2 * lane + 1];
        xa[0] = a0.x; xa[1] = a0.y; xa[2] = a0.z; xa[3] = a0.w; xa[4] = a1.x; xa[5] = a1.y; xa[6] = a1.z; xa[7] = a1.w;
        xb[0] = c0.x; xb[1] = c0.y; xb[2] = c0.z; xb[3] = c0.w; xb[4] = c1.x; xb[5] = c1.y; xb[6] = c1.z; xb[7] = c1.w;
    }
    float oa[8], ob[8];
#pragma unroll
    for (int i = 0; i < 8; ++i) { oa[i] = 0.f; ob[i] = 0.f; }
    const bool b5 = (lane & 32) != 0, b4 = (lane & 16) != 0, b3b = (lane & 8) != 0;
    for (int e0 = 0; e0 < 128; e0 += 8) {
        float p[8];
#pragma unroll
        for (int r = 0; r < 8; ++r) {
            const int id = el[e0 + r];
            const bf16* row = PU + (size_t)id * D;
            const v4u ua = *(const v4u*)(row + 8 * lane), ub = *(const v4u*)(row + 512 + 8 * lane);
            p[r] = dot8(ua, xa) + dot8(ub, xb);
        }
        float q4[4], r2[2], s;
#pragma unroll
        for (int i = 0; i < 4; ++i) { const float send = b5 ? p[i] : p[i + 4]; const float recv = __shfl_xor(send, 32); q4[i] = (b5 ? p[i + 4] : p[i]) + recv; }
#pragma unroll
        for (int i = 0; i < 2; ++i) { const float send = b4 ? q4[i] : q4[i + 2]; const float recv = __shfl_xor(send, 16); r2[i] = (b4 ? q4[i + 2] : q4[i]) + recv; }
        { const float send = b3b ? r2[0] : r2[1]; const float recv = __shfl_xor(send, 8); s = (b3b ? r2[1] : r2[0]) + recv; }
        s += __shfl_xor(s, 4); s += __shfl_xor(s, 2); s += __shfl_xor(s, 1);
        const int mine = (lane >> 3) & 7;
        const float coef = gelu_exact(s) * gl[e0 + mine];
#pragma unroll
        for (int r = 0; r < 8; ++r) {
            const float cr = __shfl(coef, r * 8);
            const int id = el[e0 + r];
            const bf16* row = PV + (size_t)id * D;
            const v4u va = *(const v4u*)(row + 8 * lane), vb = *(const v4u*)(row + 512 + 8 * lane);
            oa[0] += cr * lo16(va.x); oa[1] += cr * hi16(va.x); oa[2] += cr * lo16(va.y); oa[3] += cr * hi16(va.y);
            oa[4] += cr * lo16(va.z); oa[5] += cr * hi16(va.z); oa[6] += cr * lo16(va.w); oa[7] += cr * hi16(va.w);
            ob[0] += cr * lo16(vb.x); ob[1] += cr * hi16(vb.x); ob[2] += cr * lo16(vb.y); ob[3] += cr * hi16(vb.y);
            ob[4] += cr * lo16(vb.z); ob[5] += cr * hi16(vb.z); ob[6] += cr * lo16(vb.w); ob[7] += cr * hi16(vb.w);
        }
    }
    float s1 = 0.f;
#pragma unroll
    for (int i = 0; i < 8; ++i) { oa[i] = ALPHA * xa[i] + oa[i]; ob[i] = ALPHA * xb[i] + ob[i]; s1 += oa[i] + ob[i]; }
    const float mean = wave_sum(s1) * (1.f / D);
    float s2 = 0.f;
#pragma unroll
    for (int i = 0; i < 8; ++i) { oa[i] -= mean; ob[i] -= mean; s2 += oa[i] * oa[i] + ob[i] * ob[i]; }
    const float rstd = rsqrtf(wave_sum(s2) * (1.f / D) + LN_EPS);
    {
        const f32x4* gr = (const f32x4*)g3; const f32x4* br = (const f32x4*)b3;
        f32x4* xo = (f32x4*)(xio + (size_t)t * D);
        v4u* xbo = (v4u*)(XB + (size_t)t * D);
        const f32x4 g0 = gr[2 * lane], g1 = gr[2 * lane + 1], g2 = gr[128 + 2 * lane], g3v = gr[128 + 2 * lane + 1];
        const f32x4 c0 = br[2 * lane], c1 = br[2 * lane + 1], c2 = br[128 + 2 * lane], c3 = br[128 + 2 * lane + 1];
        f32x4 y0, y1, y2, y3;
        y0.x = oa[0] * rstd * g0.x + c0.x; y0.y = oa[1] * rstd * g0.y + c0.y; y0.z = oa[2] * rstd * g0.z + c0.z; y0.w = oa[3] * rstd * g0.w + c0.w;
        y1.x = oa[4] * rstd * g1.x + c1.x; y1.y = oa[5] * rstd * g1.y + c1.y; y1.z = oa[6] * rstd * g1.z + c1.z; y1.w = oa[7] * rstd * g1.w + c1.w;
        y2.x = ob[0] * rstd * g2.x + c2.x; y2.y = ob[1] * rstd * g2.y + c2.y; y2.z = ob[2] * rstd * g2.z + c2.z; y2.w = ob[3] * rstd * g2.w + c2.w;
        y3.x = ob[4] * rstd * g3v.x + c3.x; y3.y = ob[5] * rstd * g3v.y + c3.y; y3.z = ob[6] * rstd * g3v.z + c3.z; y3.w = ob[7] * rstd * g3v.w + c3.w;
        xo[2 * lane] = y0; xo[2 * lane + 1] = y1; xo[128 + 2 * lane] = y2; xo[128 + 2 * lane + 1] = y3;
        v4u w0, w1;
        w0.x = pk2(y0.x, y0.y); w0.y = pk2(y0.z, y0.w); w0.z = pk2(y1.x, y1.y); w0.w = pk2(y1.z, y1.w);
        w1.x = pk2(y2.x, y2.y); w1.y = pk2(y2.z, y2.w); w1.z = pk2(y3.x, y3.y); w1.w = pk2(y3.z, y3.w);
        xbo[lane] = w0; xbo[64 + lane] = w1;
    }
    WAVE_LDS_SYNC();
}

constexpr int PH_PER_LAYER = 12, NPH = 1 + 2 * PH_PER_LAYER;

#define PHASE_ENV() KArgs ap = kargs(); unsigned char* const ws = ap->ws; const int tid = threadIdx.x, lane = tid & 63, wave = __builtin_amdgcn_readfirstlane(tid >> 6); \
    const int G = gridDim.x, bid = blockIdx.x; (void)ws; (void)lane; (void)wave; (void)G; (void)bid
#define P_XB   ((bf16*)(ws + WS_XB))
#define P_HB   ((bf16*)(ws + WS_HB))
#define P_HS   ((float*)(ws + WS_HS))
#define P_CAT  ((bf16*)(ws + WS_CAT))
#define P_CKV  ((bf16*)(ws + WS_CKV))
#define P_SEL  ((unsigned short*)(ws + WS_SEL))
#define P_NSEL ((int*)(ws + WS_NSEL))
#define P_MQ   ((float*)(ws + WS_MQ))
#define P_MK   ((float*)(ws + WS_MK))
#define P_MC   ((float*)(ws + WS_MC))
#define P_MN   ((float*)(ws + WS_MN))
#define P_SCL  ((float*)(ws + WS_SCL))
#define P_BC   ((float*)(ws + WS_BC))
#define P_IG   ((float*)(ws + WS_IG))
#define P_QX   ((bf16*)(ws + WS_QX))
#define P_OX   ((bf16*)(ws + WS_OX))
#define P_QP   ((bf16*)(ws + WS_QP))

#ifndef ONLYSITE
#define SITE(j) true
#else
#define SITE(j) ((j) == ONLYSITE)
#endif
#define IN(k) (lo <= (k) && (k) < hi)
#define SEAM(k) do { if (IN(k) && IN((k) + 1)) xcd_barrier(bar); } while (0)


template <int l>
__device__ __forceinline__ void run_layer(LAS unsigned char* lds, const int lo, const int hi, const XcdBarrier& bar) {
        const int pb = 1 + PH_PER_LAYER * l;
        if (IN(pb + 0) && SITE(1)) {
            PHASE_ENV();
            {
                pg8::Gemm g{P_XB, (const bf16*)(ws + WS_WIN) + (size_t)l * HN * D, T, HN, D}; pg8::StaticOrder S; S.init(T, HN, G, bid);
                EpiH E{P_HB, P_HS};
                pg8::gemm_phase<EpiH, pg8::StaticOrder, true, true>(lds, g, S, E);
            }
            if (l == 0) {
                for (int l2 = 0; l2 < 2; ++l2) {
                    __syncthreads();
                    pg8::Gemm g2{(const bf16*)(ws + WS_MEMB), (const bf16*)(ws + WS_WCKV) + (size_t)l2 * 2048 * D, 512, 2048, D}; pg8::StaticOrder S2; S2.init(512, 2048, G, bid);
                    EpiB16 E2{(bf16*)(ws + WS_KV) + (size_t)l2 * 512 * 2048, 2048};
                    pg8::gemm_phase<EpiB16, pg8::StaticOrder, true, true>(lds, g2, S2, E2);
                }
            }
        }
        SEAM(pb + 0);
        if (IN(pb + 1) && SITE(2)) {
            PHASE_ENV();
#ifndef SUBMASK
#define SUBMASK 15
#endif
            if (SUBMASK & 1) for (int tile = bid; tile < T / 64; tile += G)
                conv_unit(lds, tile, P_HB, ap->in[I_CAW] + (size_t)l * 31 * 256, ap->in[I_CAB] + l * 256, ap->in[I_NAG] + l * 256, ap->in[I_NAB] + l * 256, P_CAT, tid);
            if (SUBMASK & 2) {
                const float* kg = ap->in[I_KVG] + l * 128; const bf16* HB = P_HB; bf16* CKV = P_CKV;
                for (int t = bid * 8 + wave; t < T; t += G * 8) {
                    const float c0 = bf2f(HB[(size_t)t * HN + H_CB + lane]), c1 = bf2f(HB[(size_t)t * HN + H_CB + 64 + lane]);
                    const float r = rsqrtf(wave_sum(c0 * c0 + c1 * c1) * (1.f / 128.f) + LN_EPS);
                    CKV[(size_t)t * 128 + lane] = (bf16)f2bf(c0 * r * kg[lane]); CKV[(size_t)t * 128 + 64 + lane] = (bf16)f2bf(c1 * r * kg[64 + lane]);
                }
            }
            if (SUBMASK & 4) for (int cidx = bid; cidx < NCHUNK; cidx += G)
                mlstm_prep_unit(lds, cidx, P_HB, P_HS, ap->in[I_CMW] + (size_t)l * 4 * 256, ap->in[I_CMB] + l * 256, ap->in[I_WQM] + (size_t)l * 4 * 4096, ap->in[I_WKM] + (size_t)l * 4 * 4096,
                                ap->in[I_BI] + l * 4, ap->in[I_BF] + l * 4, P_MQ, P_MK, P_MC, P_MN, P_SCL, P_BC, P_IG, tid);
            if (SUBMASK & 8) for (int t = bid; t < T; t += G) indexer_query(lds, t, P_HB, P_HS, P_SEL, P_NSEL, tid);
        }
        SEAM(pb + 1);
        if (IN(pb + 2) && SITE(3)) {
            PHASE_ENV();
            if (bid < 65) mlstm_scan(bid * 512 + tid, P_MC, P_MN, P_SCL);
            for (int t = bid * 8 + wave; t < T; t += G * 8) dsa_attn_query(lds + wave * 16384, t, P_HB, P_CKV, P_SEL, P_NSEL, ap->in[I_RELB], P_CAT, lane);
        }
        SEAM(pb + 2);
        if (IN(pb + 3) && SITE(4)) {
            PHASE_ENV();
            for (int cidx = bid; cidx < NCHUNK; cidx += G)
                mlstm_out_unit(lds, cidx, P_HB, P_MQ, P_MK, P_MC, P_MN, P_SCL, P_BC, P_IG, ap->in[I_NMG] + l * 256, P_CAT, tid);
        }
        SEAM(pb + 3);
        if (IN(pb + 4) && SITE(5)) {
            PHASE_ENV();
            pg8::Gemm g{P_CAT, (const bf16*)(ws + WS_WOUT) + (size_t)l * D * CATW, T, D, CATW}; pg8::StaticOrder S; S.init(T, D, G, bid);
            EpiResid E{ap->out, D, ALPHA};
            pg8::gemm_phase<EpiResid, pg8::StaticOrder, true, true>(lds, g, S, E);
        }
        SEAM(pb + 4);
        if (IN(pb + 5) && SITE(6)) {
            PHASE_ENV();
            float* X = ap->out; bf16* XB = P_XB; const float* g1 = ap->in[I_LN1G] + l * D; const float* b1 = ap->in[I_LN1B] + l * D;
            for (int m = bid * 8 + wave; m < T; m += G * 8) ln_row(X + (size_t)m * D, g1, b1, X + (size_t)m * D, XB + (size_t)m * D, lane);
        }
        SEAM(pb + 5);
        if (IN(pb + 6) && SITE(7)) {
            PHASE_ENV();
            pg8::Gemm g{P_XB, (const bf16*)(ws + WS_WCQ) + (size_t)l * D * D, T, D, D}; pg8::StaticOrder S; S.init(T, D, G, bid);
            EpiB16 E{P_QX, D};
            pg8::gemm_phase<EpiB16, pg8::StaticOrder, true, true>(lds, g, S, E);
        }
        SEAM(pb + 6);
        if (IN(pb + 7) && SITE(8)) {
            PHASE_ENV();
            const bf16* KV = (const bf16*)(ws + WS_KV) + (size_t)l * 512 * 2048;
            for (int t = bid * 8 + wave; t < T; t += G * 8) xattn_token(lds + wave * 4096, t, P_QX, KV, P_OX, lane);
        }
        SEAM(pb + 7);
        if (IN(pb + 8) && SITE(9)) {
            PHASE_ENV();
            pg8::Gemm g{P_OX, (const bf16*)(ws + WS_WCO) + (size_t)l * D * D, T, D, D}; pg8::StaticOrder S; S.init(T, D, G, bid);
            EpiResid E{ap->out, D, ALPHA};
            pg8::gemm_phase<EpiResid, pg8::StaticOrder, true, true>(lds, g, S, E);
        }
        SEAM(pb + 8);
        if (IN(pb + 9) && SITE(10)) {
            PHASE_ENV();
            float* X = ap->out; bf16* XB = P_XB; const float* g2 = ap->in[I_LN2G] + l * D; const float* b2 = ap->in[I_LN2B] + l * D;
            for (int m = bid * 8 + wave; m < T; m += G * 8) ln_row(X + (size_t)m * D, g2, b2, X + (size_t)m * D, XB + (size_t)m * D, lane);
        }
        SEAM(pb + 9);
        if (IN(pb + 10) && SITE(11)) {
            PHASE_ENV();
            pg8::Gemm g{P_XB, (const bf16*)(ws + WS_WPQ) + (size_t)l * 2048 * D, T, 2048, D}; pg8::StaticOrder S; S.init(T, 2048, G, bid);
            EpiB16 E{P_QP, 2048};
            pg8::gemm_phase<EpiB16, pg8::StaticOrder, true, true>(lds, g, S, E);
        }
        SEAM(pb + 10);
        if (IN(pb + 11) && SITE(12)) {
            PHASE_ENV();
            LAS bf16* sk1 = (LAS bf16*)lds; LAS bf16* sk2 = sk1 + 128 * 136;
            const float* k1 = ap->in[I_SK1] + (size_t)l * 128 * 128; const float* k2 = ap->in[I_SK2] + (size_t)l * 128 * 128;
            for (int i = tid; i < 128 * 128; i += 512) { const int n = i >> 7, d = i & 127; sk1[n * 136 + d] = (bf16)f2bf(k1[i]); sk2[n * 136 + d] = (bf16)f2bf(k2[i]); }
            __syncthreads();
            const bf16* PU = (const bf16*)(ws + WS_PU) + (size_t)l * 16384 * D; const bf16* PV = (const bf16*)(ws + WS_PV) + (size_t)l * 16384 * D;
            for (int t = bid * 8 + wave; t < T; t += G * 8)
                peer_token(lds + 69632 + wave * 5120, sk1, sk2, t, P_QP, PU, PV, ap->in[I_LN3G] + l * D, ap->in[I_LN3B] + l * D, ap->out, P_XB, lane);
            __syncthreads();
        }
        SEAM(pb + 11);
}

__global__ void __launch_bounds__(512, 2) fwd(Args a_unused) {
    extern __shared__ __attribute__((aligned(16))) unsigned char lds_raw[];
    LAS unsigned char* lds = (LAS unsigned char*)lds_raw;
    volatile LAS unsigned* MISC = (volatile LAS unsigned*)(lds + MISC_OFF);
    if (threadIdx.x < 32) MISC[threadIdx.x] = 0u;
    __syncthreads();
    int lo, hi;
    XcdBarrier bar;
    { KArgs ap = kargs(); lo = ap->lo; hi = ap->hi; bar = xcd_barrier_post((unsigned*)(ap->ws + WS_CTL) + 4096 + ap->li * XCD_BAR_WORDS, MISC + 8); }
    if (IN(0) && SITE(0)) { p0_prologue(lds, threadIdx.x, gridDim.x, blockIdx.x); }
    SEAM(0);

    run_layer<0>(lds, lo, hi, bar);
    run_layer<1>(lds, lo, hi, bar);
#undef IN
#undef SEAM
}

extern "C" void kernel_launch(void* const* d_in, const int* in_sizes, int n_in, void* d_out, int out_size, void* d_ws, size_t ws_size, hipStream_t stream) {
    static int grid = 0;
    if (grid == 0) {
        if (n_in != 35 || out_size != T * D || ws_size < WS_END) { fprintf(stderr, "kernel_launch: unexpected shapes (n_in %d, out %d, ws %zu)\n", n_in, out_size, ws_size); grid = -1; return; }
        int dev = 0, cus = 0, per_cu = 0;
        if (hipGetDevice(&dev) != hipSuccess || hipDeviceGetAttribute(&cus, hipDeviceAttributeMultiprocessorCount, dev) != hipSuccess) { grid = -1; return; }
        if (hipFuncSetAttribute((const void*)fwd, hipFuncAttributeMaxDynamicSharedMemorySize, LDS_BYTES) != hipSuccess) { fprintf(stderr, "kernel_launch: hipFuncSetAttribute failed\n"); grid = -1; return; }
        if (hipOccupancyMaxActiveBlocksPerMultiprocessor(&per_cu, (const void*)fwd, 512, LDS_BYTES) != hipSuccess || per_cu < 1) fprintf(stderr, "kernel_launch: occupancy query reports %d\n", per_cu);
        (void)hipGetLastError();
        grid = cus;
    }
    if (grid < 0) return;
    (void)hipMemsetAsync((char*)d_ws + WS_CTL, 0, CTL_ZERO_BYTES, stream);
    Args a{};
    for (int i = 0; i < 35; ++i) a.in[i] = (const float*)d_in[i];
    a.out = (float*)d_out; a.ws = (unsigned char*)d_ws;
#if MK_SINGLE
    a.lo = 0; a.hi = NPH; a.li = 0; a.pad = 0;
    hipLaunchKernelGGL(fwd, dim3(grid), dim3(512), LDS_BYTES, stream, a);
#else
    for (int p = 0; p < NPH; ++p) { a.lo = p; a.hi = p + 1; a.li = 0; a.pad = 0; hipLaunchKernelGGL(fwd, dim3(grid), dim3(512), LDS_BYTES, stream, a); }
#endif
}
```

```cpp
#include <hip/hip_runtime.h>
#include <cstdio>
#include <cstdint>
namespace pg8 {
#define PG8_LAS __attribute__((address_space(3)))
typedef unsigned short bf16_t;
typedef short bf16x8 __attribute__((ext_vector_type(8)));
typedef float f32x4 __attribute__((ext_vector_type(4)));
typedef unsigned u32x4 __attribute__((ext_vector_type(4)));
constexpr int BM = 256, BK = 64, HALF = 128, HTB = HALF * BK * 2  , STAGE_BYTES = 8 * HTB, NXCD = 8, WGM = 8;

__host__ __device__ __forceinline__ int lds_byte(int r, int c) { const int st = (r >> 4) * 2 + (c >> 5), rr = r & 15, cc = c & 31, ob = rr * 64 + cc * 2; return st * 1024 + (ob ^ (((ob >> 9) & 1) << 5)); }
__host__ __device__ __forceinline__ void stage_rc(int b, int& R, int& C) { const int st = b / 1024, sb = b % 1024, swz = sb ^ (((sb >> 9) & 1) << 5); R = (st >> 1) * 16 + swz / 64; C = (st & 1) * 32 + (swz % 64) / 2; }
__host__ __device__ __forceinline__ int perm32(int rho) { const int n = rho >> 4, i = rho & 15; return 8 * (i >> 2) + 4 * n + (i & 3); }

struct Unit { int pm, pn; };
struct Gemm { const bf16_t* A; const bf16_t* Bt; int M, N, K; };

struct StaticOrder {
    int nM, nN, nwg, G, c;
    __host__ __device__ void init(int M, int N, int G_, int c_) { nM = M / BM; nN = N / BM; nwg = nM * nN; G = G_; c = c_; }
    __host__ __device__ bool next(int i, Unit& u) const {
        const long L = (long)i * G + c; if (L >= nwg) return false;
        int wgid = (int)L; { const int q = nwg / NXCD, r = nwg % NXCD, xcd = wgid % NXCD, off = wgid / NXCD; wgid = (xcd < r ? xcd * (q + 1) : r * (q + 1) + (xcd - r) * q) + off; }
        const int nig = WGM * nN, gid = wgid / nig, fm = gid * WGM, gsz = (nM - fm) < WGM ? (nM - fm) : WGM;
        u.pm = fm + ((wgid % nig) % gsz); u.pn = (wgid % nig) / gsz; return true;
    }
    __device__ __forceinline__ void a_ready(const Unit&) const {}
    __device__ __forceinline__ void done(const Unit&) const {}
};
__device__ __forceinline__ unsigned cvt_pk_bf16(float lo, float hi) { unsigned r; asm volatile("v_cvt_pk_bf16_f32 %0, %1, %2" : "=v"(r) : "v"(lo), "v"(hi)); return r; }
template <class Epi, class Sched, bool ALIGN_EPI = false, bool SP2 = false>
__device__ __forceinline__ void gemm_phase(PG8_LAS unsigned char* lds, const Gemm g, const Sched& S, const Epi& E) {
    const int tid = threadIdx.x, wid = __builtin_amdgcn_readfirstlane(tid >> 6), lane = tid & 63, wr = wid >> 2, wc = wid & 3, fr = lane & 15, fq = lane >> 4;
    const int K = g.K, nt = K / BK;
    unsigned voffA[2], voffB[2];
#pragma unroll
    for (int i = 0; i < 2; ++i) { int R, C; stage_rc(tid * 16 + i * 8192, R, C); const int Rb = Epi::PERM ? ((R & ~31) + perm32(R & 31)) : R;
        voffA[i] = (unsigned)(R * K + C) * 2u; voffB[i] = (unsigned)(Rb * K + C) * 2u; }
    const size_t kstep = (size_t)(BK * 2);
    const size_t hstep = (size_t)HALF * K * 2;
    const size_t tstep = 2 * hstep;
    const unsigned ldsw = (unsigned)wid * 1024u;
    const int aoff = lds_byte(wr * 64 + fr, fq * 8), boff = lds_byte(wc * 32 + fr, fq * 8);
#define PG8_SA(b, h) (((b) * 2 + (h)) * HTB)
#define PG8_SB(b, h) ((4 + (b) * 2 + (h)) * HTB)
#define PG8_STAGE(bufoff, gbase, voff) do { _Pragma("unroll") for (int _i = 0; _i < 2; ++_i) \
        __builtin_amdgcn_global_load_lds((const unsigned*)((const char*)(gbase) + (voff)[_i]), (PG8_LAS unsigned*)(lds + (bufoff) + ldsw + _i * 8192), 16, 0, 0); } while (0)
#define PG8_LDA(dst, b, h) do { _Pragma("unroll") for (int m = 0; m < 4; ++m) _Pragma("unroll") for (int k = 0; k < 2; ++k) dst[m][k] = *(const PG8_LAS bf16x8*)(lds + PG8_SA(b, h) + aoff + m * 2048 + k * 1024); } while (0)
#define PG8_LDB(dst, b, h) do { _Pragma("unroll") for (int n = 0; n < 2; ++n) _Pragma("unroll") for (int k = 0; k < 2; ++k) dst[n][k] = *(const PG8_LAS bf16x8*)(lds + PG8_SB(b, h) + boff + n * 2048 + k * 1024); } while (0)
#define PG8_MMA(ai, bj, At, Bt) do { __builtin_amdgcn_s_setprio(1); _Pragma("unroll") for (int m = 0; m < 4; ++m) _Pragma("unroll") for (int n = 0; n < 2; ++n) _Pragma("unroll") for (int k = 0; k < 2; ++k) \
        acc[ai][bj][m][n] = __builtin_amdgcn_mfma_f32_16x16x32_bf16(Bt[n][k], At[m][k], acc[ai][bj][m][n], 0, 0, 0); __builtin_amdgcn_s_setprio(0); } while (0)
#define PG8_WAIT_V(n) asm volatile("s_waitcnt vmcnt(" #n ")" ::: "memory")
#define PG8_WAIT_L(n) asm volatile("s_waitcnt lgkmcnt(" #n ")" ::: "memory")
#define PG8_BAR __builtin_amdgcn_s_barrier()
#define PG8_SCHED __builtin_amdgcn_sched_barrier(0)
    Unit cur, nxt; int ui = 0;
    if (!S.next(0, cur)) return;
    f32x4 acc[2][2][4][2];
#pragma unroll
    for (int a = 0; a < 2; ++a)
#pragma unroll
        for (int b = 0; b < 2; ++b)
#pragma unroll
            for (int m = 0; m < 4; ++m)
#pragma unroll
                for (int n = 0; n < 2; ++n) acc[a][b][m][n] = (f32x4){0.f, 0.f, 0.f, 0.f};
    bf16x8 At[4][2], B0[2][2], B1[2][2];
    const char* cA = (const char*)g.A + (size_t)cur.pm * tstep; const char* cB = (const char*)g.Bt + (size_t)cur.pn * tstep;
    S.a_ready(cur);
    if constexpr (SP2) {
        PG8_STAGE(PG8_SB(0, 0), cB, voffB); PG8_STAGE(PG8_SB(0, 1), cB + hstep, voffB); PG8_STAGE(PG8_SA(0, 0), cA, voffA); PG8_STAGE(PG8_SA(0, 1), cA + hstep, voffA);
        if (wr == 1) PG8_BAR;
        PG8_WAIT_V(2); PG8_BAR;
        PG8_STAGE(PG8_SB(1, 0), cB + kstep, voffB); PG8_STAGE(PG8_SA(1, 0), cA + kstep, voffA); PG8_STAGE(PG8_SB(1, 1), cB + hstep + kstep, voffB);
        PG8_WAIT_V(6); PG8_BAR;
    } else {
        PG8_STAGE(PG8_SB(0, 0), cB, voffB); PG8_STAGE(PG8_SA(0, 0), cA, voffA); PG8_STAGE(PG8_SB(0, 1), cB + hstep, voffB); PG8_STAGE(PG8_SA(0, 1), cA + hstep, voffA);
        if (wr == 1) PG8_BAR;
        PG8_WAIT_V(4); PG8_BAR;
        PG8_STAGE(PG8_SB(1, 0), cB + kstep, voffB); PG8_STAGE(PG8_SA(1, 0), cA + kstep, voffA); PG8_STAGE(PG8_SB(1, 1), cB + hstep + kstep, voffB);
        PG8_WAIT_V(6); PG8_BAR;
    }
    for (;;) {
        const bool has_next = S.next(ui + 1, nxt);
        const char* nA = has_next ? (const char*)g.A + (size_t)nxt.pm * tstep : cA; const char* nB = has_next ? (const char*)g.Bt + (size_t)nxt.pn * tstep : cB;
        for (int t = 0; t < nt; t += 2) {
            const bool last = (t == nt - 2);
            const char* a1 = cA + (size_t)(t + 1) * kstep;
            const char* a2 = last ? nA : cA + (size_t)(t + 2) * kstep; const char* b2 = last ? nB : cB + (size_t)(t + 2) * kstep;
            const char* a3 = a2 + kstep; const char* b3 = b2 + kstep;
            if (last && has_next) S.a_ready(nxt);
            if constexpr (SP2) {
            PG8_LDB(B0, 0, 0); PG8_LDB(B1, 0, 1); PG8_SCHED; PG8_LDA(At, 0, 0); PG8_STAGE(PG8_SA(1, 1), a1 + hstep, voffA);
            PG8_WAIT_V(8); PG8_WAIT_L(0); PG8_BAR; PG8_MMA(0, 0, At, B0); PG8_MMA(0, 1, At, B1); PG8_BAR; PG8_SCHED;
            PG8_LDA(At, 0, 1); PG8_STAGE(PG8_SB(0, 0), b2, voffB); PG8_STAGE(PG8_SB(0, 1), b2 + hstep, voffB); PG8_STAGE(PG8_SA(0, 0), a2, voffA);
            PG8_WAIT_V(8); PG8_WAIT_L(0); PG8_BAR; PG8_MMA(1, 0, At, B0); PG8_MMA(1, 1, At, B1); PG8_BAR; PG8_SCHED;
            PG8_LDB(B0, 1, 0); PG8_LDB(B1, 1, 1); PG8_SCHED; PG8_LDA(At, 1, 0); PG8_STAGE(PG8_SA(0, 1), a2 + hstep, voffA);
            PG8_WAIT_V(8); PG8_WAIT_L(0); PG8_BAR; PG8_MMA(0, 0, At, B0); PG8_MMA(0, 1, At, B1); PG8_BAR; PG8_SCHED;
            PG8_LDA(At, 1, 1); PG8_STAGE(PG8_SB(1, 0), b3, voffB); PG8_STAGE(PG8_SB(1, 1), b3 + hstep, voffB); PG8_STAGE(PG8_SA(1, 0), a3, voffA);
            PG8_WAIT_V(8); PG8_WAIT_L(0); PG8_BAR; PG8_MMA(1, 0, At, B0); PG8_MMA(1, 1, At, B1); PG8_BAR; PG8_SCHED;
            } else {
            PG8_LDB(B0, 0, 0); PG8_SCHED; PG8_LDA(At, 0, 0); PG8_STAGE(PG8_SA(1, 1), a1 + hstep, voffA);
            PG8_WAIT_L(8); PG8_BAR; PG8_WAIT_L(0); PG8_MMA(0, 0, At, B0); PG8_BAR; PG8_SCHED;
            PG8_LDB(B1, 0, 1); PG8_STAGE(PG8_SB(0, 0), b2, voffB);
            PG8_BAR; PG8_WAIT_L(0); PG8_MMA(0, 1, At, B1); PG8_BAR;
            PG8_LDA(At, 0, 1); PG8_STAGE(PG8_SA(0, 0), a2, voffA);
            PG8_BAR; PG8_WAIT_L(0); PG8_MMA(1, 0, At, B0); PG8_BAR; PG8_SCHED;
            PG8_STAGE(PG8_SB(0, 1), b2 + hstep, voffB);
            PG8_WAIT_V(6); PG8_BAR; PG8_MMA(1, 1, At, B1); PG8_BAR;
            PG8_LDB(B0, 1, 0); PG8_SCHED; PG8_LDA(At, 1, 0); PG8_STAGE(PG8_SA(0, 1), a2 + hstep, voffA);
            PG8_WAIT_L(8); PG8_BAR; PG8_WAIT_L(0); PG8_MMA(0, 0, At, B0); PG8_BAR; PG8_SCHED;
            PG8_LDB(B1, 1, 1); PG8_STAGE(PG8_SB(1, 0), b3, voffB);
            PG8_BAR; PG8_WAIT_L(0); PG8_MMA(0, 1, At, B1); PG8_BAR;
            PG8_LDA(At, 1, 1); PG8_STAGE(PG8_SA(1, 0), a3, voffA);
            PG8_BAR; PG8_WAIT_L(0); PG8_MMA(1, 0, At, B0); PG8_BAR; PG8_SCHED;
            PG8_STAGE(PG8_SB(1, 1), b3 + hstep, voffB);
            PG8_WAIT_V(6); PG8_BAR; PG8_MMA(1, 1, At, B1); PG8_BAR;
            }
        }
        if constexpr (ALIGN_EPI) { if (wr == 0) PG8_BAR; }
        if constexpr (!Epi::AFTER_DRAIN) { E(acc, cur, wr, wc, fr, fq); S.done(cur); }
        if (!has_next) break;
#pragma unroll
        for (int a = 0; a < 2; ++a)
#pragma unroll
            for (int b = 0; b < 2; ++b)
#pragma unroll
                for (int m = 0; m < 4; ++m)
#pragma unroll
                    for (int n = 0; n < 2; ++n) acc[a][b][m][n] = (f32x4){0.f, 0.f, 0.f, 0.f};
        cur = nxt; cA = nA; cB = nB; ++ui;
        if constexpr (ALIGN_EPI) { if (wr == 1) PG8_BAR; }
    }
    PG8_WAIT_V(0);
    if constexpr (!ALIGN_EPI) { if (wr == 0) PG8_BAR; }
    PG8_BAR;
    if constexpr (Epi::AFTER_DRAIN) { E.fused(acc, cur, wr, wc, fr, fq, lds, wid, lane); S.done(cur); }
#undef PG8_SA
#undef PG8_SB
#undef PG8_STAGE
#undef PG8_LDA
#undef PG8_LDB
#undef PG8_MMA
#undef PG8_WAIT_V
#undef PG8_WAIT_L
#undef PG8_BAR
#undef PG8_SCHED
}
}

#define LAS __attribute__((address_space(3)))
typedef unsigned short bf16;
typedef unsigned v4u __attribute__((ext_vector_type(4)));
typedef unsigned v2u __attribute__((ext_vector_type(2)));
typedef float f32x4 __attribute__((ext_vector_type(4)));

#ifndef MK_SINGLE
#define MK_SINGLE 1
#endif

constexpr int NB = 2, L = 8192, T = NB * L, D = 1024;
constexpr int HN = 2816;
constexpr int H_A = 0, H_QL = 512, H_CB = 1536, H_QI = 1664, H_KI = 1920, H_XC = 1984, H_V = 2240, H_O = 2496, H_S = 2752;
constexpr int CATW = 1536, CAT_A = 0, CAT_B = 256, CAT_C = 1280;
constexpr int WIN_N = 2252;
constexpr float ALPHA = 1.4142135623730951f;
constexpr float LN_EPS = 1e-5f;
constexpr int NCHUNK = 1024;

constexpr size_t MiB = 1u << 20;
constexpr size_t WS_CTL = 0, CTL_ZERO_BYTES = 1 * MiB;
constexpr size_t WS_WIN  = 1 * MiB;
constexpr size_t WS_WOUT = 12 * MiB;
constexpr size_t WS_WCQ  = 18 * MiB;
constexpr size_t WS_WCKV = 22 * MiB;
constexpr size_t WS_WCO  = 30 * MiB;
constexpr size_t WS_WPQ  = 34 * MiB;
constexpr size_t WS_MEMB = 42 * MiB;
constexpr size_t WS_KV   = 43 * MiB;
constexpr size_t WS_PU   = 48 * MiB;
constexpr size_t WS_PV   = 112 * MiB;
constexpr size_t WS_XB   = 176 * MiB;
constexpr size_t WS_HB   = 208 * MiB;
constexpr size_t WS_QX   = 208 * MiB;
constexpr size_t WS_OX   = 240 * MiB;
constexpr size_t WS_QP   = 208 * MiB;
constexpr size_t WS_HS   = 296 * MiB;
constexpr size_t WS_CAT  = 297 * MiB;
constexpr size_t WS_CKV  = 345 * MiB;
constexpr size_t WS_SEL  = 349 * MiB;
constexpr size_t WS_MQ   = 357 * MiB;
constexpr size_t WS_MK   = 373 * MiB;
constexpr size_t WS_MC   = 389 * MiB;
constexpr size_t WS_MN   = 405 * MiB;
constexpr size_t WS_SCL  = WS_MN + 512 * 1024;
constexpr size_t WS_BC   = 406 * MiB;
constexpr size_t WS_IG   = WS_BC + 512 * 1024;
constexpr size_t WS_NSEL = 407 * MiB;
constexpr size_t WS_END  = 408 * MiB;

constexpr int LDS_BYTES = 147456;
constexpr int MISC_OFF = 131072 + 320;

__device__ __forceinline__ float bf2f(unsigned h) { return __uint_as_float(h << 16); }
__device__ __forceinline__ unsigned f2bf(float f) { unsigned u = __float_as_uint(f); return (u + 0x7fffu + ((u >> 16) & 1u)) >> 16; }
__device__ __forceinline__ unsigned pk2(float lo, float hi) { return f2bf(lo) | (f2bf(hi) << 16); }
__device__ __forceinline__ float lo16(unsigned u) { return __uint_as_float(u << 16); }
__device__ __forceinline__ float hi16(unsigned u) { return __uint_as_float(u & 0xffff0000u); }
__device__ __forceinline__ float wave_sum(float v) {
#pragma unroll
    for (int o = 1; o < 64; o <<= 1) v += __shfl_xor(v, o);
    return v;
}
__device__ __forceinline__ float wave_max(float v) {
#pragma unroll
    for (int o = 1; o < 64; o <<= 1) v = fmaxf(v, __shfl_xor(v, o));
    return v;
}
__device__ __forceinline__ int wave_sum_i(int v) {
#pragma unroll
    for (int o = 1; o < 64; o <<= 1) v += __shfl_xor(v, o);
    return v;
}
#define WAVE_LDS_SYNC() asm volatile("s_waitcnt lgkmcnt(0)" ::: "memory")
__device__ __forceinline__ float sigmoidf_(float x) { return 1.f / (1.f + __expf(-x)); }
__device__ __forceinline__ float dot8(v4u a, const float (&x)[8]) {
    return lo16(a.x) * x[0] + hi16(a.x) * x[1] + lo16(a.y) * x[2] + hi16(a.y) * x[3] + lo16(a.z) * x[4] + hi16(a.z) * x[5] + lo16(a.w) * x[6] + hi16(a.w) * x[7];
}
__device__ __forceinline__ float dot8bb(v4u a, v4u b) {
    return lo16(a.x) * lo16(b.x) + hi16(a.x) * hi16(b.x) + lo16(a.y) * lo16(b.y) + hi16(a.y) * hi16(b.y) + lo16(a.z) * lo16(b.z) + hi16(a.z) * hi16(b.z) + lo16(a.w) * lo16(b.w) + hi16(a.w) * hi16(b.w);
}

#define XB_TMO      128
#define XB_XCNT(j)  (256  + 64 * (j))
#define XB_XSUB(j)  (1280 + 64 * (j))
#define XB_XGEN(j)  (2304 + 64 * (j))
#define XB_TOP      3328
#define XB_TOPGEN   3392
#define XCD_BAR_WORDS 3456
#define XB_SPIN_CAP (1u << 18)

__device__ __forceinline__ unsigned xb_ld(unsigned* p)              { return __hip_atomic_load(p, __ATOMIC_RELAXED, __HIP_MEMORY_SCOPE_AGENT); }
__device__ __forceinline__ unsigned xb_add(unsigned* p, unsigned v) { return __hip_atomic_fetch_add(p, v, __ATOMIC_RELAXED, __HIP_MEMORY_SCOPE_AGENT); }
__device__ __forceinline__ unsigned xb_xcc_id() { return (unsigned)__builtin_amdgcn_s_getreg((3 << 11) | 20) & 0xFu; }
#define XB_SPIN(cond, bar) do { unsigned _sp = 0; while (cond) { __builtin_amdgcn_s_sleep(1); \
    if ((++_sp & 255u) == 0u) { if (xb_ld(&(bar)[XB_TMO])) break; if (_sp > XB_SPIN_CAP) { atomicAdd(&(bar)[XB_TMO], 1u); break; } } } } while (0)

struct XcdBarrier { unsigned* bar; unsigned x; volatile LAS unsigned* st; };

__device__ __forceinline__ XcdBarrier xcd_barrier_post(unsigned* bar, volatile LAS unsigned* st) {
    XcdBarrier b; b.bar = bar; b.x = xb_xcc_id(); b.st = st;
    if (threadIdx.x == 0) (void)xb_add(&bar[XB_XCNT(b.x)], 1u);
    return b;
}
__device__ __forceinline__ void xcd_barrier_complete(unsigned* bar, unsigned x, unsigned& nloc, unsigned& nx) {
    const unsigned G = gridDim.x * gridDim.y * gridDim.z;
    unsigned sum, cnt, mine, sp = 0u;
    for (;;) {
        sum = 0u; cnt = 0u; mine = 0u;
#pragma unroll
        for (unsigned j = 0; j < 16; ++j) { const unsigned c = xb_ld(&bar[XB_XCNT(j)]); sum += c; cnt += (c > 0u) ? 1u : 0u; mine = (j == x) ? c : mine; }
        if (sum == G) break;
        __builtin_amdgcn_s_sleep(1);
        if ((++sp & 255u) == 0u) { if (xb_ld(&bar[XB_TMO])) break; if (sp > XB_SPIN_CAP) { atomicAdd(&bar[XB_TMO], 1u); break; } }
    }
    nloc = mine > 0u ? mine : 1u; nx = cnt > 0u ? cnt : 1u;
}
__device__ __forceinline__ void xcd_barrier(const XcdBarrier& b) {
    asm volatile("s_waitcnt vmcnt(0)" ::: "memory");
    __syncthreads();
    if (threadIdx.x == 0) {
        unsigned* bar = b.bar;
        __builtin_amdgcn_s_waitcnt(0);
        unsigned nloc = b.st[0], nx = b.st[1];
        if (nloc == 0u) { xcd_barrier_complete(bar, b.x, nloc, nx); b.st[0] = nloc; b.st[1] = nx; }
        const unsigned old = xb_add(&bar[XB_XSUB(b.x)], 1u);
        const unsigned gen = old / nloc;
        if (old + 1u == (gen + 1u) * nloc) {
            __builtin_amdgcn_fence(__ATOMIC_RELEASE, "agent");
            asm volatile("s_waitcnt vmcnt(0)" ::: "memory");
            const unsigned og = xb_add(&bar[XB_TOP], 1u);
            const unsigned tg = og / nx;
            if (og + 1u == (tg + 1u) * nx) xb_add(&bar[XB_TOPGEN], 1u);
            else XB_SPIN(xb_ld(&bar[XB_TOPGEN]) == tg, bar);
            __builtin_amdgcn_fence(__ATOMIC_ACQUIRE, "agent");
            xb_add(&bar[XB_XGEN(b.x)], 1u);
            asm volatile("s_waitcnt vmcnt(0)" ::: "memory");
        } else {
            XB_SPIN(xb_ld(&bar[XB_XGEN(b.x)]) == gen, bar);
            __builtin_amdgcn_fence(__ATOMIC_ACQUIRE, "agent");
            asm volatile("s_waitcnt vmcnt(0)" ::: "memory");
        }
    }
    __syncthreads();
}

struct EpiH {
    static constexpr bool PERM = true, AFTER_DRAIN = false;
    bf16* H; float* Hs;
    __device__ __forceinline__ void operator()(const pg8::f32x4 (&acc)[2][2][4][2], const pg8::Unit& u, int wr, int wc, int fr, int fq) const {
        const int row0 = u.pm * 256 + wr * 64 + fr, col0 = u.pn * 256 + wc * 32 + 8 * fq;
#pragma unroll
        for (int ai = 0; ai < 2; ++ai)
#pragma unroll
            for (int m = 0; m < 4; ++m) {
                const int row = row0 + ai * 128 + m * 16;
#pragma unroll
                for (int bj = 0; bj < 2; ++bj) {
                    const int c = col0 + bj * 128;
                    const pg8::f32x4 v0 = acc[ai][bj][m][0], v1 = acc[ai][bj][m][1];
                    v4u w; w.x = pk2(v0[0], v0[1]); w.y = pk2(v0[2], v0[3]); w.z = pk2(v1[0], v1[1]); w.w = pk2(v1[2], v1[3]);
                    *(v4u*)(H + (size_t)row * HN + c) = w;
                    if (c == H_S || c == H_S + 8) { float* s = Hs + (size_t)row * 16 + (c - H_S); *(pg8::f32x4*)s = v0; *(pg8::f32x4*)(s + 4) = v1; }
                }
            }
    }
};
struct EpiB16 {
    static constexpr bool PERM = true, AFTER_DRAIN = false;
    bf16* O; int ldc;
    __device__ __forceinline__ void operator()(const pg8::f32x4 (&acc)[2][2][4][2], const pg8::Unit& u, int wr, int wc, int fr, int fq) const {
        const int row0 = u.pm * 256 + wr * 64 + fr, col0 = u.pn * 256 + wc * 32 + 8 * fq;
#pragma unroll
        for (int ai = 0; ai < 2; ++ai)
#pragma unroll
            for (int m = 0; m < 4; ++m) {
                const int row = row0 + ai * 128 + m * 16;
#pragma unroll
                for (int bj = 0; bj < 2; ++bj) {
                    const int c = col0 + bj * 128;
                    const pg8::f32x4 v0 = acc[ai][bj][m][0], v1 = acc[ai][bj][m][1];
                    v4u w; w.x = pk2(v0[0], v0[1]); w.y = pk2(v0[2], v0[3]); w.z = pk2(v1[0], v1[1]); w.w = pk2(v1[2], v1[3]);
                    *(v4u*)(O + (size_t)row * ldc + c) = w;
                }
            }
    }
};
struct EpiResid {
    static constexpr bool PERM = false, AFTER_DRAIN = false;
    float* O; int ldc; float alpha;
    __device__ __forceinline__ void operator()(const pg8::f32x4 (&acc)[2][2][4][2], const pg8::Unit& u, int wr, int wc, int fr, int fq) const {
        const int row0 = u.pm * 256 + wr * 64 + fr, col0 = u.pn * 256 + wc * 32 + 4 * fq;
#pragma unroll
        for (int ai = 0; ai < 2; ++ai)
#pragma unroll
            for (int m = 0; m < 4; ++m) {
                float* rowp = O + (size_t)(row0 + ai * 128 + m * 16) * ldc + col0;
#pragma unroll
                for (int bj = 0; bj < 2; ++bj)
#pragma unroll
                    for (int n = 0; n < 2; ++n) {
                        pg8::f32x4* p = (pg8::f32x4*)(rowp + bj * 128 + n * 16);
                        const pg8::f32x4 x = *p;
                        *p = x * alpha + acc[ai][bj][m][n];
                    }
            }
    }
};

struct Args { const float* in[35]; float* out; unsigned char* ws; int lo, hi, li, pad; };
typedef const __attribute__((address_space(4))) Args* KArgs;
__device__ __forceinline__ KArgs kargs() { KArgs p = (KArgs)__builtin_amdgcn_kernarg_segment_ptr(); asm volatile("" : "+s"(p)); return p; }
enum { I_X = 0, I_MEM, I_LNIN_G, I_LNIN_B, I_RELB, I_WIN, I_CAW, I_CAB, I_NAG, I_NAB, I_KVG, I_WUK, I_WUV, I_CMW, I_CMB, I_WQM, I_WKM, I_BI, I_BF, I_NMG,
       I_WOUT, I_LN1G, I_LN1B, I_WCQ, I_WCKV, I_WCO, I_LN2G, I_LN2B, I_WPQ, I_SK1, I_SK2, I_PU, I_PV, I_LN3G, I_LN3B };

__device__ __forceinline__ void tr_item(LAS float* scr, const float* W, int ldw, int k0, int n0, int ncv, bf16* WT, int ldk, int dr0, int kofs, int tid) {
    const int c = tid & 63, r0 = tid >> 6;
#pragma unroll
    for (int i = 0; i < 8; ++i) { const int r = r0 + 8 * i; scr[r * 65 + c] = (c < ncv) ? W[(size_t)(k0 + r) * ldw + n0 + c] : 0.f; }
    __syncthreads();
#pragma unroll
    for (int i = 0; i < 8; ++i) { const int n = r0 + 8 * i; if (n < ncv) WT[(size_t)(dr0 + n) * ldk + kofs + k0 + c] = (bf16)f2bf(scr[c * 65 + n]); }
    __syncthreads();
}
__device__ __forceinline__ void tr_job(LAS float* scr, const float* W, int K, int ldw, int n0, int nc, bf16* WT, int ldk, int dr0, int kofs, int tid, int G, int bid) {
    const int nnt = (nc + 63) / 64, nitems = (K / 64) * nnt;
    for (int it = bid; it < nitems; it += G) {
        const int kt = it / nnt, nt = it % nnt;
        const int ncv = (nc - nt * 64) < 64 ? (nc - nt * 64) : 64;
        tr_item(scr, W, ldw, kt * 64, n0 + nt * 64, ncv, WT, ldk, dr0 + nt * 64, kofs, tid);
    }
}
__device__ __forceinline__ void ln_row(const float* src, const float* g, const float* b, float* dstf, bf16* dstb, int lane) {
    const f32x4* xr = (const f32x4*)src + lane;
    f32x4 v[4]; float s = 0.f;
#pragma unroll
    for (int j = 0; j < 4; ++j) { v[j] = xr[64 * j]; s += (v[j].x + v[j].y) + (v[j].z + v[j].w); }
    const float mean = wave_sum(s) * (1.f / D); float s2 = 0.f;
#pragma unroll
    for (int j = 0; j < 4; ++j) { v[j] = v[j] - mean; s2 += (v[j].x * v[j].x + v[j].y * v[j].y) + (v[j].z * v[j].z + v[j].w * v[j].w); }
    const float rstd = rsqrtf(wave_sum(s2) * (1.f / D) + LN_EPS);
#pragma unroll
    for (int j = 0; j < 4; ++j) {
        const f32x4 gg = ((const f32x4*)g)[lane + 64 * j], bb = ((const f32x4*)b)[lane + 64 * j];
        const f32x4 y = v[j] * rstd * gg + bb;
        ((f32x4*)dstf)[lane + 64 * j] = y;
        v2u o; o.x = pk2(y.x, y.y); o.y = pk2(y.z, y.w);
        ((v2u*)dstb)[lane + 64 * j] = o;
    }
}

__device__ __forceinline__ void p0_prologue(LAS unsigned char* lds, int tid, int G, int bid) {
    LAS float* scr = (LAS float*)lds;
    KArgs ap = kargs();
    unsigned char* ws = ap->ws;
    for (int l = 0; l < 2; ++l) {
        const float* win = ap->in[I_WIN] + (size_t)l * D * WIN_N;
        bf16* WinT = (bf16*)(ws + WS_WIN) + (size_t)l * HN * D;
        tr_job(scr, win, D, WIN_N, 0, 512, WinT, D, H_A, 0, tid, G, bid);
        tr_job(scr, win, D, WIN_N, 1024, 448, WinT, D, H_CB, 0, tid, G, bid);
        tr_job(scr, win, D, WIN_N, 1476, 768, WinT, D, H_XC, 0, tid, G, bid);
        tr_job(scr, win, D, WIN_N, 1472, 4, WinT, D, H_S, 0, tid, G, bid);
        tr_job(scr, win, D, WIN_N, 2244, 8, WinT, D, H_S + 4, 0, tid, G, bid);
        for (int i = bid * 512 + tid; i < (HN - (H_S + 12)) * D; i += G * 512) WinT[(size_t)(H_S + 12) * D + i] = 0;
        const float* wout = ap->in[I_WOUT] + (size_t)l * D * D;
        bf16* WoutT = (bf16*)(ws + WS_WOUT) + (size_t)l * D * CATW;
        tr_job(scr, wout, 256, D, 0, D, WoutT, CATW, 0, CAT_A, tid, G, bid);
        tr_job(scr, wout + (size_t)768 * D, 256, D, 0, D, WoutT, CATW, 0, CAT_C, tid, G, bid);
        tr_job(scr, ap->in[I_WCQ] + (size_t)l * D * D, D, D, 0, D, (bf16*)(ws + WS_WCQ) + (size_t)l * D * D, D, 0, 0, tid, G, bid);
        tr_job(scr, ap->in[I_WCKV] + (size_t)l * D * 2048, D, 2048, 0, 2048, (bf16*)(ws + WS_WCKV) + (size_t)l * 2048 * D, D, 0, 0, tid, G, bid);
        tr_job(scr, ap->in[I_WCO] + (size_t)l * D * D, D, D, 0, D, (bf16*)(ws + WS_WCO) + (size_t)l * D * D, D, 0, 0, tid, G, bid);
        tr_job(scr, ap->in[I_WPQ] + (size_t)l * D * 2048, D, 2048, 0, 2048, (bf16*)(ws + WS_WPQ) + (size_t)l * 2048 * D, D, 0, 0, tid, G, bid);
    }
    {
        LAS float* sa = (LAS float*)lds;
        LAS float* sb = sa + 64 * 65;
        for (int it = bid; it < 2 * 2 * 128; it += G) {
            const int l = it >> 8, kind = (it >> 7) & 1, h = (it >> 4) & 7, tile = it & 15;
            if (kind == 0) {
                const float* win = ap->in[I_WIN] + (size_t)l * D * WIN_N;
                const float* wuk = ap->in[I_WUK] + (size_t)l * 8 * 64 * 128 + (size_t)h * 64 * 128;
                bf16* WinT = (bf16*)(ws + WS_WIN) + (size_t)l * HN * D;
                const int k0 = tile * 64;
                for (int i = tid; i < 4096; i += 512) { const int kk = i >> 6, d = i & 63; sa[kk * 65 + d] = win[(size_t)(k0 + kk) * WIN_N + 512 + h * 64 + d]; }
                for (int i = tid; i < 8192; i += 512) sb[i] = wuk[i];
                __syncthreads();
                for (int i = tid; i < 8192; i += 512) { const int r = i >> 6, kk = i & 63; float s = 0.f;
#pragma unroll 8
                    for (int d = 0; d < 64; ++d) s += sa[kk * 65 + d] * sb[d * 128 + r];
                    WinT[(size_t)(H_QL + h * 128 + r) * D + k0 + kk] = (bf16)f2bf(s); }
                __syncthreads();
            } else {
                const float* wout = ap->in[I_WOUT] + (size_t)l * D * D;
                const float* wuv = ap->in[I_WUV] + (size_t)l * 8 * 128 * 64 + (size_t)h * 128 * 64;
                bf16* WoutT = (bf16*)(ws + WS_WOUT) + (size_t)l * D * CATW;
                const int n0 = tile * 64;
                for (int i = tid; i < 4096; i += 512) { const int d = i >> 6, n = i & 63; sa[d * 65 + n] = wout[(size_t)(256 + h * 64 + d) * D + n0 + n]; }
                for (int i = tid; i < 8192; i += 512) { const int r = i >> 6, d = i & 63; sb[r * 65 + d] = wuv[i]; }
                __syncthreads();
                for (int i = tid; i < 8192; i += 512) { const int n = i >> 7, r = i & 127; float s = 0.f;
#pragma unroll 8
                    for (int d = 0; d < 64; ++d) s += sb[r * 65 + d] * sa[d * 65 + n];
                    WoutT[(size_t)(n0 + n) * CATW + CAT_B + h * 128 + r] = (bf16)f2bf(s); }
                __syncthreads();
            }
        }
    }
    {
        const size_t gt = (size_t)bid * 512 + tid, gs = (size_t)G * 512;
        const f32x4* pu = (const f32x4*)ap->in[I_PU]; const f32x4* pv = (const f32x4*)ap->in[I_PV]; const f32x4* pm = (const f32x4*)ap->in[I_MEM];
        v2u* du = (v2u*)(ws + WS_PU); v2u* dv = (v2u*)(ws + WS_PV); v2u* dm = (v2u*)(ws + WS_MEMB);
        const size_t n4 = (size_t)2 * 16384 * 1024 / 4;
        for (size_t i = gt; i < n4; i += gs) { const f32x4 x = pu[i]; v2u o; o.x = pk2(x.x, x.y); o.y = pk2(x.z, x.w); du[i] = o; }
        for (size_t i = gt; i < n4; i += gs) { const f32x4 x = pv[i]; v2u o; o.x = pk2(x.x, x.y); o.y = pk2(x.z, x.w); dv[i] = o; }
        for (size_t i = gt; i < (size_t)512 * 1024 / 4; i += gs) { const f32x4 x = pm[i]; v2u o; o.x = pk2(x.x, x.y); o.y = pk2(x.z, x.w); dm[i] = o; }
    }
    {
        const int gw = bid * 8 + (tid >> 6), NGW = G * 8, lane = tid & 63;
        for (int m = gw; m < T; m += NGW)
            ln_row(ap->in[I_X] + (size_t)m * D, ap->in[I_LNIN_G], ap->in[I_LNIN_B], ap->out + (size_t)m * D, (bf16*)(ws + WS_XB) + (size_t)m * D, lane);
    }
}

__device__ __forceinline__ void conv_unit(LAS unsigned char* lds, int tile, const bf16* Hb, const float* cw, const float* cb, const float* ng, const float* nb, bf16* CAT, int tid) {
    LAS float* u = (LAS float*)lds;
    LAS float* w = u + 94 * 256;
    const int t0 = tile * 64, pos0 = t0 & (L - 1);
    for (int i = tid; i < 94 * 256; i += 512) {
        const int r = i >> 8, c = i & 255, pos = pos0 - 30 + r; float val = 0.f;
        if (pos >= 0) { const bf16* hr = Hb + (size_t)(t0 - 30 + r) * HN + H_A; const float av = bf2f(hr[c]), gt = bf2f(hr[256 + c]); val = av * sigmoidf_(gt); }
        u[i] = val;
    }
    for (int i = tid; i < 31 * 256; i += 512) w[i] = cw[i];
    __syncthreads();
    const int wave = tid >> 6, lane = tid & 63;
    for (int tt = wave; tt < 64; tt += 8) {
        float acc[4];
#pragma unroll
        for (int i = 0; i < 4; ++i) { const int c = lane + 64 * i; float s = cb[c];
            asm volatile("" ::: "memory");
#pragma unroll 8
            for (int k = 0; k < 31; ++k) s += w[k * 256 + c] * u[(tt + k) * 256 + c];
            acc[i] = s; }
        const float mean = wave_sum((acc[0] + acc[1]) + (acc[2] + acc[3])) * (1.f / 256.f);
        float s2 = 0.f;
#pragma unroll
        for (int i = 0; i < 4; ++i) { acc[i] -= mean; s2 += acc[i] * acc[i]; }
        const float rstd = rsqrtf(wave_sum(s2) * (1.f / 256.f) + LN_EPS);
#pragma unroll
        for (int i = 0; i < 4; ++i) { const int c = lane + 64 * i; const float y = acc[i] * rstd * ng[c] + nb[c];
            CAT[(size_t)(t0 + tt) * CATW + CAT_A + c] = (bf16)f2bf(y * sigmoidf_(y)); }
    }
    __syncthreads();
}

__device__ __forceinline__ unsigned fkey(float f) { const unsigned u = __float_as_uint(f); return (u & 0x80000000u) ? ~u : (u | 0x80000000u); }

__device__ __forceinline__ int block_sum_i(int v, LAS int* red, int tid) {
    v = wave_sum_i(v);
    if ((tid & 63) == 0) red[tid >> 6] = v;
    __syncthreads();
    int s = 0;
#pragma unroll
    for (int i = 0; i < 8; ++i) s += red[i];
    __syncthreads();
    return s;
}
__device__ __forceinline__ int block_excl_scan_i(int v, LAS int* red, int tid, int& tot) {
    const int lane = tid & 63, wave = tid >> 6;
    int inc = v;
#pragma unroll
    for (int o = 1; o < 64; o <<= 1) { const int y = __shfl_up(inc, o); if (lane >= o) inc += y; }
    if (lane == 63) red[wave] = inc;
    __syncthreads();
    int base = 0, t = 0;
#pragma unroll
    for (int i = 0; i < 8; ++i) { const int r = red[i]; if (i < wave) base += r; t += r; }
    __syncthreads();
    tot = t;
    return base + inc - v;
}

__device__ __forceinline__ void indexer_query(LAS unsigned char* lds, int t, const bf16* Hb, const float* Hs, unsigned short* SEL, int* NSEL, int tid) {
    LAS unsigned* keys = (LAS unsigned*)lds;
    LAS float* qi = (LAS float*)(lds + 32768);
    LAS int* red = (LAS int*)(lds + 32768 + 1024);
    const int b = t >> 13, pos = t & (L - 1), n = pos + 1;
    if (tid < 256) qi[tid] = bf2f(Hb[(size_t)t * HN + H_QI + tid]);
    const float w0 = Hs[(size_t)t * 16 + 0] * 0.5f, w1 = Hs[(size_t)t * 16 + 1] * 0.5f, w2 = Hs[(size_t)t * 16 + 2] * 0.5f, w3 = Hs[(size_t)t * 16 + 3] * 0.5f;
    __syncthreads();
    for (int s = tid; s < n; s += 512) {
        const bf16* kr = Hb + (size_t)(b * L + s) * HN + H_KI;
        float d0 = 0.f, d1 = 0.f, d2 = 0.f, d3 = 0.f;
#pragma unroll 1
        for (int c = 0; c < 64; c += 8) {
            asm volatile("" ::: "memory");
            const v4u kk = *(const v4u*)(kr + c);
            float kf[8] = { lo16(kk.x), hi16(kk.x), lo16(kk.y), hi16(kk.y), lo16(kk.z), hi16(kk.z), lo16(kk.w), hi16(kk.w) };
#pragma unroll
            for (int j = 0; j < 8; ++j) { d0 += qi[c + j] * kf[j]; d1 += qi[64 + c + j] * kf[j]; d2 += qi[128 + c + j] * kf[j]; d3 += qi[192 + c + j] * kf[j]; }
        }
        float sc = 0.f;
        sc += w0 * fmaxf(d0 * 0.125f, 0.f); sc += w1 * fmaxf(d1 * 0.125f, 0.f); sc += w2 * fmaxf(d2 * 0.125f, 0.f); sc += w3 * fmaxf(d3 * 0.125f, 0.f);
        keys[s] = fkey(sc);
    }
    __syncthreads();
    if (n <= 256) {
        for (int s = tid; s < n; s += 512) SEL[(size_t)t * 256 + s] = (unsigned short)s;
        if (tid == 0) NSEL[t] = n;
        __syncthreads();
        return;
    }
    unsigned prefix = 0u;
    for (int bit = 31; bit >= 0; --bit) {
        const unsigned cand = prefix | (1u << bit);
        int c = 0;
        for (int s = tid; s < n; s += 512) c += (keys[s] >= cand) ? 1 : 0;
        c = block_sum_i(c, red, tid);
        if (c >= 256) prefix = cand;
    }
    int ng = 0, nt = 0;
#pragma unroll
    for (int j = 0; j < 16; ++j) { const int s = tid * 16 + j; if (s < n) { const unsigned k = keys[s]; ng += (k > prefix) ? 1 : 0; nt += (k == prefix) ? 1 : 0; } }
    int totg, tott;
    int eg = block_excl_scan_i(ng, red, tid, totg);
    int et = block_excl_scan_i(nt, red, tid, tott);
    const int quota = 256 - totg;
#pragma unroll
    for (int j = 0; j < 16; ++j) { const int s = tid * 16 + j; if (s < n) { const unsigned k = keys[s];
        if (k > prefix) { SEL[(size_t)t * 256 + eg] = (unsigned short)s; ++eg; }
        else if (k == prefix) { if (et < quota) SEL[(size_t)t * 256 + totg + et] = (unsigned short)s; ++et; } } }
    if (tid == 0) NSEL[t] = 256;
    __syncthreads();
}

typedef short bf16x8s __attribute__((ext_vector_type(8)));
typedef float f32x16 __attribute__((ext_vector_type(16)));
constexpr int IDX_ROWW = 1025;
constexpr int IDX_CTL = 131072 + 512;

template <int PASS>
__device__ __forceinline__ void idx_pass(LAS unsigned char* lds, const bf16* Hb, int b, int si, int wave, int lane,
                                         const bf16x8s (&Qb)[4][4], const float (&wq)[4], unsigned short* SEL) {
    LAS unsigned* hist = (LAS unsigned*)lds;
    LAS unsigned* cB1 = (LAS unsigned*)(lds + IDX_CTL);
    LAS unsigned* cT22 = cB1 + 64;
    LAS unsigned* cCnt = cB1 + 128;
    const int r = lane & 31, h = lane >> 5;
    const int qpos = si * 32 + r;
    const unsigned myB1 = (PASS >= 2) ? cB1[r] : 0u;
    const unsigned myT = (PASS == 3) ? cT22[r] : 0u;
    bf16x8s ka[4];
    {
        const bf16* kp = Hb + (size_t)(b * L + wave * 32 + r) * HN + H_KI + 8 * h;
        if (wave <= si) {
#pragma unroll
            for (int s = 0; s < 4; ++s) ka[s] = *(const bf16x8s*)(kp + 16 * s);
        }
    }
    for (int kt = wave; kt <= si; kt += 8) {
        bf16x8s kn[4];
        const bool more = (kt + 8 <= si);
        if (more) {
            const bf16* kp = Hb + (size_t)(b * L + (kt + 8) * 32 + r) * HN + H_KI + 8 * h;
#pragma unroll
            for (int s = 0; s < 4; ++s) kn[s] = *(const bf16x8s*)(kp + 16 * s);
        }
        float sc[16];
#pragma unroll
        for (int i = 0; i < 16; ++i) sc[i] = 0.f;
#pragma unroll
        for (int hh = 0; hh < 4; ++hh) {
            f32x16 acc;
#pragma unroll
            for (int i = 0; i < 16; ++i) acc[i] = 0.f;
#pragma unroll
            for (int s = 0; s < 4; ++s) acc = __builtin_amdgcn_mfma_f32_32x32x16_bf16(ka[s], Qb[hh][s], acc, 0, 0, 0);
#pragma unroll
            for (int i = 0; i < 16; ++i) sc[i] += wq[hh] * fmaxf(acc[i], 0.f);
        }
        const bool diag = (kt == si);
#pragma unroll
        for (int i = 0; i < 16; ++i) {
            const int ko = (i & 3) + 8 * (i >> 2) + 4 * h;
            const bool valid = !diag || (ko <= r);
            const unsigned key = fkey(sc[i]);
            if (PASS == 1) {
                if (valid) { const unsigned bin = key >> 21; __hip_atomic_fetch_add(hist + r * IDX_ROWW + (bin >> 1), (bin & 1u) ? 65536u : 1u, __ATOMIC_RELAXED, __HIP_MEMORY_SCOPE_WORKGROUP); }
            } else if (PASS == 2) {
                if (valid && (key >> 21) == myB1) { const unsigned bin = (key >> 10) & 2047u; __hip_atomic_fetch_add(hist + r * IDX_ROWW + (bin >> 1), (bin & 1u) ? 65536u : 1u, __ATOMIC_RELAXED, __HIP_MEMORY_SCOPE_WORKGROUP); }
            } else {
                const unsigned k22 = key >> 10;
                const int kpos = kt * 32 + ko;
                if (valid) {
                    if (myB1 == 0xffffffffu || k22 > myT) {
                        __hip_atomic_fetch_or(hist + r * 256 + (kpos >> 5), 1u << (kpos & 31), __ATOMIC_RELAXED, __HIP_MEMORY_SCOPE_WORKGROUP);
                    } else if (k22 == myT) {
                        __hip_atomic_fetch_or(hist + 8192 + r * 256 + (kpos >> 5), 1u << (kpos & 31), __ATOMIC_RELAXED, __HIP_MEMORY_SCOPE_WORKGROUP);
                    }
                }
            }
        }
        if (more) {
#pragma unroll
            for (int s = 0; s < 4; ++s) ka[s] = kn[s];
        }
    }
}

__device__ __forceinline__ void idx_find(LAS unsigned* hist, int q, int need, int lane, unsigned& Bout, int& aboveOut, bool& found) {
    const LAS unsigned* row = hist + q * IDX_ROWW + 16 * lane;
    unsigned wv[16]; int own = 0;
#pragma unroll
    for (int i = 0; i < 16; ++i) { wv[i] = row[i]; own += (int)(wv[i] & 0xffffu) + (int)(wv[i] >> 16); }
    int suf = own;
#pragma unroll
    for (int o = 1; o < 64; o <<= 1) { const int y = __shfl_down(suf, o); if (lane + o < 64) suf += y; }
    const int above = suf - own;
    const bool here = (above < need) && (suf >= need);
    unsigned B = 0u; int ab = 0; bool f = false; int a = above;
#pragma unroll
    for (int i = 15; i >= 0; --i) {
        const int hi = (int)(wv[i] >> 16), lo = (int)(wv[i] & 0xffffu);
        if (!f && a + hi >= need) { B = 32u * lane + 2u * i + 1u; ab = a; f = true; }
        a += hi;
        if (!f && a + lo >= need) { B = 32u * lane + 2u * i; ab = a; f = true; }
        a += lo;
    }
    const unsigned long long m = __ballot(here);
    found = (m != 0ull);
    const int src = found ? (__ffsll((long long)m) - 1) : 0;
    Bout = (unsigned)__shfl((int)B, src); aboveOut = __shfl(ab, src);
}

__device__ __forceinline__ void indexer_strip(LAS unsigned char* lds, int b, int si, const bf16* Hb, const float* Hs, unsigned short* SEL, int* NSEL, int tid) {
    LAS unsigned* hist = (LAS unsigned*)lds;
    LAS unsigned* cB1 = (LAS unsigned*)(lds + IDX_CTL);
    LAS unsigned* cT22 = cB1 + 64;
    LAS unsigned* cCnt = cB1 + 128;
    LAS unsigned* cAb = cB1 + 192;
    const int lane = tid & 63, wave = __builtin_amdgcn_readfirstlane(tid >> 6);
    const int r = lane & 31, h = lane >> 5;
    const int t = b * L + si * 32 + r;
    bf16x8s Qb[4][4]; float wq[4];
#pragma unroll
    for (int hh = 0; hh < 4; ++hh) {
        wq[hh] = Hs[(size_t)t * 16 + hh] * 0.0625f;
#pragma unroll
        for (int s = 0; s < 4; ++s) Qb[hh][s] = *(const bf16x8s*)(Hb + (size_t)t * HN + H_QI + hh * 64 + 16 * s + 8 * h);
    }
    for (int i = tid; i < 32 * IDX_ROWW; i += 512) hist[i] = 0u;
    __syncthreads();
    idx_pass<1>(lds, Hb, b, si, wave, lane, Qb, wq, SEL);
    __syncthreads();
    for (int qq = 0; qq < 4; ++qq) {
        const int q = wave * 4 + qq; unsigned B; int ab; bool f;
        idx_find(hist, q, 256, lane, B, ab, f);
        if (lane == 0) { cB1[q] = f ? B : 0xffffffffu; cAb[q] = f ? (unsigned)ab : 0u; cCnt[q] = 0u; }
    }
    __syncthreads();
    for (int i = tid; i < 32 * IDX_ROWW; i += 512) hist[i] = 0u;
    __syncthreads();
    idx_pass<2>(lds, Hb, b, si, wave, lane, Qb, wq, SEL);
    __syncthreads();
    for (int qq = 0; qq < 4; ++qq) {
        const int q = wave * 4 + qq; unsigned B; int ab; bool f;
        const unsigned b1 = cB1[q]; const int ab1 = (int)cAb[q];
        idx_find(hist, q, 256 - ab1, lane, B, ab, f);
        if (lane == 0 && b1 != 0xffffffffu) { cT22[q] = (b1 << 11) | B; cAb[q] = (unsigned)(ab1 + ab); }
    }
    __syncthreads();
    for (int i = tid; i < 2 * 32 * 256; i += 512) hist[i] = 0u;
    __syncthreads();
    idx_pass<3>(lds, Hb, b, si, wave, lane, Qb, wq, SEL);
    __syncthreads();
    for (int qq = 0; qq < 4; ++qq) {
        const int q = wave * 4 + qq;
        const int tq = b * L + si * 32 + q;
        const bool takeall = (cB1[q] == 0xffffffffu);
        int base = 0;
#pragma unroll 1
        for (int part = 0; part < 2; ++part) {
            unsigned w4[4]; int own = 0;
#pragma unroll
            for (int i = 0; i < 4; ++i) { w4[i] = hist[part * 8192 + q * 256 + 4 * lane + i]; own += __popc(w4[i]); }
            int inc = own;
#pragma unroll
            for (int o = 1; o < 64; o <<= 1) { const int y = __shfl_up(inc, o); if (lane >= o) inc += y; }
            int rank = base + inc - own;
#pragma unroll
            for (int i = 0; i < 4; ++i) {
                unsigned w = w4[i];
                while (w) { const int bit = __ffs((int)w) - 1; w &= w - 1u;
                    if (rank < 256) SEL[(size_t)tq * 256 + rank] = (unsigned short)(128 * lane + 32 * i + bit);
                    ++rank; }
            }
            base += __shfl(inc, 63);
            if (takeall) break;
        }
        if (lane == 0) NSEL[tq] = takeall ? (si * 32 + q + 1) : 256;
    }
    __syncthreads();
}

__device__ __forceinline__ float logsigmoidf_(float x) { return fminf(x, 0.f) - log1pf(__expf(-fabsf(x))); }

__device__ __forceinline__ void mlstm_prep_unit(LAS unsigned char* lds, int cidx, const bf16* Hb, const float* Hs, const float* cmw, const float* cmb, const float* wqm, const float* wkm,
                                                const float* bi, const float* bfp, float* MQ, float* MK, float* MC, float* MN, float* SCL, float* BC, float* IG, int tid) {
    const int j = cidx & 127, h = (cidx >> 7) & 3, b = cidx >> 9, t0 = b * L + j * 64;
    LAS float* xc = (LAS float*)lds;
    LAS float* wq = xc + 64 * 65;
    LAS float* wk = wq + 4096;
    LAS float* kt = wk + 4096;
    LAS float* vt = kt + 64 * 65;
    LAS float* wg = vt + 64 * 65;
    for (int i = tid; i < 4096; i += 512) {
        const int s = i >> 6, d = i & 63, c = h * 64 + d; float av = cmb[c];
#pragma unroll
        for (int k = 0; k < 4; ++k) { const int pos = j * 64 + s - 3 + k; if (pos >= 0) av += cmw[k * 256 + c] * bf2f(Hb[(size_t)(b * L + pos) * HN + H_XC + c]); }
        xc[s * 65 + d] = av * sigmoidf_(av);
        wq[i] = wqm[h * 4096 + i]; wk[i] = wkm[h * 4096 + i];
        vt[s * 65 + d] = bf2f(Hb[(size_t)(t0 + s) * HN + H_V + c]);
    }
    __syncthreads();
    for (int i = tid; i < 4096; i += 512) {
        const int s = i >> 6, e = i & 63; float aq = 0.f, ak = 0.f;
#pragma unroll 8
        for (int d = 0; d < 64; ++d) { const float x = xc[s * 65 + d]; aq += x * wq[d * 64 + e]; ak += x * wk[d * 64 + e]; }
        MQ[(size_t)(t0 + s) * 256 + h * 64 + e] = aq * 0.125f; MK[(size_t)(t0 + s) * 256 + h * 64 + e] = ak; kt[s * 65 + e] = ak;
    }
    if (tid < 64) {
        const int s = tid, t = t0 + s;
        const float fl = logsigmoidf_(Hs[(size_t)t * 16 + 8 + h] + bfp[h]);
        const float ig = Hs[(size_t)t * 16 + 4 + h] + bi[h];
        float bs = fl;
#pragma unroll
        for (int o = 1; o < 64; o <<= 1) { const float y = __shfl_up(bs, o); if (s >= o) bs += y; }
        const float bL = __shfl(bs, 63);
        const float g = bL - bs + ig;
        const float mloc = wave_max(g);
        wg[s] = __expf(g - mloc);
        BC[(size_t)t * 4 + h] = bs; IG[(size_t)t * 4 + h] = ig;
        if (s == 0) { SCL[cidx * 4 + 0] = mloc; SCL[cidx * 4 + 1] = bL; }
    }
    __syncthreads();
    for (int i = tid; i < 4096; i += 512) {
        const int v = i >> 6, k = i & 63; float s2 = 0.f;
#pragma unroll 8
        for (int s = 0; s < 64; ++s) s2 += wg[s] * vt[s * 65 + v] * kt[s * 65 + k];
        MC[(size_t)cidx * 4096 + i] = s2;
    }
    if (tid < 64) { float s2 = 0.f;
        for (int s = 0; s < 64; ++s) s2 += wg[s] * kt[s * 65 + tid];
        MN[(size_t)cidx * 64 + tid] = s2; }
    __syncthreads();
}

__device__ __forceinline__ void mlstm_scan(int gtid, float* MC, float* MN, float* SCL) {
    const int stream = gtid / 4160, e = gtid - stream * 4160;
    if (stream >= 8) return;
    float* base = (e < 4096) ? (MC + e) : (MN + (e - 4096));
    const size_t stride = (e < 4096) ? 4096 : 64;
    float m = 0.f, C = 0.f;
    for (int j0 = 0; j0 < 128; j0 += 8) {
        float loc[8], ml[8], bl[8];
#pragma unroll
        for (int u = 0; u < 8; ++u) { const int cidx = stream * 128 + j0 + u; loc[u] = base[(size_t)cidx * stride]; ml[u] = SCL[cidx * 4 + 0]; bl[u] = SCL[cidx * 4 + 1]; }
#pragma unroll
        for (int u = 0; u < 8; ++u) {
            const int cidx = stream * 128 + j0 + u;
            const float mn = fmaxf(bl[u] + m, ml[u]);
            const float a = __expf(bl[u] + m - mn), c = __expf(ml[u] - mn);
            base[(size_t)cidx * stride] = C;
            if (e == 0) SCL[cidx * 4 + 2] = m;
            C = a * C + c * loc[u]; m = mn;
        }
    }
}

__device__ __forceinline__ int rel_bucket(int dist) {
    const int d = dist > 0 ? dist : 0;
    if (d < 16) return d;
    const int large = 16 + (int)(logf((float)d / 16.f) / 2.0794415416798357f * 16.f);
    return large < 31 ? large : 31;
}

__device__ __forceinline__ void dsa_attn_query(LAS unsigned char* wl, int t, const bf16* Hb, const bf16* CKV, const unsigned short* SEL, const int* NSEL, const float* relb, bf16* CAT, int lane) {
    LAS float* ql = (LAS float*)wl;
    LAS float* P = ql + 1024;
    LAS int* sl = (LAS int*)(P + 2048);
    const int b = t >> 13, pos = t & (L - 1), n = NSEL[t];
    for (int i = lane; i < 1024; i += 64) ql[i] = bf2f(Hb[(size_t)t * HN + H_QL + i]);
    for (int i = lane; i < 256; i += 64) sl[i] = (i < n) ? (int)SEL[(size_t)t * 256 + i] : 0;
    WAVE_LDS_SYNC();
    float lg[4][8];
#pragma unroll
    for (int i = 0; i < 4; ++i) {
        const int kk = lane + 64 * i;
        float acc[8];
#pragma unroll
        for (int h = 0; h < 8; ++h) acc[h] = 0.f;
        const int s = sl[kk];
        const bf16* cr = CKV + (size_t)(b * L + s) * 128;
        for (int c = 0; c < 128; c += 8) {
            const v4u cv = *(const v4u*)(cr + c);
            const float cf[8] = { lo16(cv.x), hi16(cv.x), lo16(cv.y), hi16(cv.y), lo16(cv.z), hi16(cv.z), lo16(cv.w), hi16(cv.w) };
#pragma unroll
            for (int h = 0; h < 8; ++h) {
#pragma unroll
                for (int jj = 0; jj < 8; ++jj) acc[h] += ql[h * 128 + c + jj] * cf[jj];
            }
        }
        const int bk = rel_bucket(pos - s);
#pragma unroll
        for (int h = 0; h < 8; ++h) lg[i][h] = (kk < n) ? (acc[h] * 0.125f + relb[bk * 8 + h]) : -INFINITY;
    }
#pragma unroll
    for (int h = 0; h < 8; ++h) {
        const float mx = wave_max(fmaxf(fmaxf(lg[0][h], lg[1][h]), fmaxf(lg[2][h], lg[3][h])));
        float e[4], sm = 0.f;
#pragma unroll
        for (int i = 0; i < 4; ++i) { e[i] = (lane + 64 * i < n) ? __expf(lg[i][h] - mx) : 0.f; sm += e[i]; }
        const float inv = 1.f / wave_sum(sm);
#pragma unroll
        for (int i = 0; i < 4; ++i) P[h * 256 + lane + 64 * i] = e[i] * inv;
    }
    WAVE_LDS_SYNC();
    float o[8][2];
#pragma unroll
    for (int h = 0; h < 8; ++h) { o[h][0] = 0.f; o[h][1] = 0.f; }
    for (int kk = 0; kk < n; ++kk) {
        const int s = sl[kk];
        const bf16* cr = CKV + (size_t)(b * L + s) * 128;
        const float c0 = bf2f(cr[lane]), c1 = bf2f(cr[64 + lane]);
#pragma unroll
        for (int h = 0; h < 8; ++h) { const float p = P[h * 256 + kk]; o[h][0] += p * c0; o[h][1] += p * c1; }
    }
#pragma unroll
    for (int h = 0; h < 8; ++h) {
        CAT[(size_t)t * CATW + CAT_B + h * 128 + lane] = (bf16)f2bf(o[h][0]);
        CAT[(size_t)t * CATW + CAT_B + h * 128 + 64 + lane] = (bf16)f2bf(o[h][1]);
    }
    WAVE_LDS_SYNC();
}

__device__ __forceinline__ void mlstm_out_unit(LAS unsigned char* lds, int cidx, const bf16* Hb, const float* MQ, const float* MK, const float* MC, const float* MN, const float* SCL,
                                               const float* BC, const float* IG, const float* nmg, bf16* CAT, int tid) {
    const int j = cidx & 127, h = (cidx >> 7) & 3, b = cidx >> 9, t0 = b * L + j * 64;
    LAS float* q = (LAS float*)lds;
    LAS float* k = q + 64 * 65;
    LAS float* v = k + 64 * 65;
    LAS float* C = v + 64 * 65;
    LAS float* S = C + 64 * 65;
    LAS float* hh = S + 64 * 65;
    LAS float* nn = hh + 64 * 65;
    LAS float* bb = nn + 64;
    LAS float* gi = bb + 64;
    LAS float* mrow = gi + 64;
    LAS float* den = mrow + 64;
    for (int i = tid; i < 4096; i += 512) {
        const int s = i >> 6, d = i & 63;
        q[s * 65 + d] = MQ[(size_t)(t0 + s) * 256 + h * 64 + d];
        k[s * 65 + d] = MK[(size_t)(t0 + s) * 256 + h * 64 + d];
        v[s * 65 + d] = bf2f(Hb[(size_t)(t0 + s) * HN + H_V + h * 64 + d]);
        C[s * 65 + d] = MC[(size_t)cidx * 4096 + i];
    }
    if (tid < 64) { nn[tid] = MN[(size_t)cidx * 64 + tid]; bb[tid] = BC[(size_t)(t0 + tid) * 4 + h]; gi[tid] = IG[(size_t)(t0 + tid) * 4 + h]; }
    const float m_in = SCL[cidx * 4 + 2];
    __syncthreads();
    if (tid < 64) {
        const int t = tid; const float bt = bb[t]; float rm = -INFINITY;
        for (int s = 0; s <= t; ++s) rm = fmaxf(rm, bt - bb[s] + gi[s]);
        mrow[t] = fmaxf(bt + m_in, rm);
    }
    __syncthreads();
    for (int i = tid; i < 4096; i += 512) {
        const int t = i >> 6, s = i & 63; float a = 0.f;
        if (s <= t) {
#pragma unroll 8
            for (int d = 0; d < 64; ++d) a += q[t * 65 + d] * k[s * 65 + d];
            a *= __expf(bb[t] - bb[s] + gi[s] - mrow[t]);
        }
        S[t * 65 + s] = a;
    }
    __syncthreads();
    if (tid < 64) {
        const int t = tid; float a = 0.f, nq = 0.f;
        for (int s = 0; s < 64; ++s) a += S[t * 65 + s];
        for (int d = 0; d < 64; ++d) nq += nn[d] * q[t * 65 + d];
        const float wi = __expf(bb[t] + m_in - mrow[t]);
        const float dn = a + wi * nq;
        den[t] = fmaxf(fabsf(dn), __expf(-mrow[t]));
    }
    __syncthreads();
    for (int i = tid; i < 4096; i += 512) {
        const int t = i >> 6, vv = i & 63; float a = 0.f, cq = 0.f;
#pragma unroll 8
        for (int s = 0; s < 64; ++s) a += S[t * 65 + s] * v[s * 65 + vv];
#pragma unroll 8
        for (int d = 0; d < 64; ++d) cq += C[vv * 65 + d] * q[t * 65 + d];
        const float wi = __expf(bb[t] + m_in - mrow[t]);
        hh[t * 65 + vv] = (a + wi * cq) / den[t];
    }
    __syncthreads();
    {
        const int wave = tid >> 6, lane = tid & 63;
        for (int t = wave; t < 64; t += 8) {
            const float x = hh[t * 65 + lane];
            const float mean = wave_sum(x) * (1.f / 64.f);
            const float dx = x - mean;
            const float var = wave_sum(dx * dx) * (1.f / 64.f);
            const float y = dx * rsqrtf(var + LN_EPS) * nmg[h * 64 + lane];
            const float og = bf2f(Hb[(size_t)(t0 + t) * HN + H_O + h * 64 + lane]);
            CAT[(size_t)(t0 + t) * CATW + CAT_C + h * 64 + lane] = (bf16)f2bf(sigmoidf_(og) * y);
        }
    }
    __syncthreads();
}

__device__ __forceinline__ void xattn_token(LAS unsigned char* wl, int t, const bf16* QX, const bf16* KV, bf16* OX, int lane) {
    LAS float* qs = (LAS float*)wl;
    LAS float* P = qs + 256;
    const int b = t >> 13;
    const bf16* kvb = KV + (size_t)b * 256 * 2048;
    for (int h = 0; h < 4; ++h) {
        for (int i = lane; i < 256; i += 64) qs[i] = bf2f(QX[(size_t)t * D + h * 256 + i]);
        WAVE_LDS_SYNC();
        float lg[4];
#pragma unroll
        for (int i = 0; i < 4; ++i) {
            const int m = lane + 64 * i;
            const bf16* kr = kvb + (size_t)m * 2048 + h * 256;
            float a = 0.f;
            for (int c = 0; c < 256; c += 8) {
                const v4u kk = *(const v4u*)(kr + c);
                a += lo16(kk.x) * qs[c] + hi16(kk.x) * qs[c + 1] + lo16(kk.y) * qs[c + 2] + hi16(kk.y) * qs[c + 3] + lo16(kk.z) * qs[c + 4] + hi16(kk.z) * qs[c + 5] + lo16(kk.w) * qs[c + 6] + hi16(kk.w) * qs[c + 7];
            }
            lg[i] = a * 0.0625f;
        }
        const float mx = wave_max(fmaxf(fmaxf(lg[0], lg[1]), fmaxf(lg[2], lg[3])));
        float e[4], sm = 0.f;
#pragma unroll
        for (int i = 0; i < 4; ++i) { e[i] = __expf(lg[i] - mx); sm += e[i]; }
        const float inv = 1.f / wave_sum(sm);
#pragma unroll
        for (int i = 0; i < 4; ++i) P[lane + 64 * i] = e[i] * inv;
        WAVE_LDS_SYNC();
        float o[4] = { 0.f, 0.f, 0.f, 0.f };
        for (int m = 0; m < 256; ++m) {
            const float p = P[m];
            const bf16* vr = kvb + (size_t)m * 2048 + 1024 + h * 256;
#pragma unroll
            for (int i = 0; i < 4; ++i) o[i] += p * bf2f(vr[lane + 64 * i]);
        }
#pragma unroll
        for (int i = 0; i < 4; ++i) OX[(size_t)t * D + h * 256 + lane + 64 * i] = (bf16)f2bf(o[i]);
        WAVE_LDS_SYNC();
    }
}

__device__ __forceinline__ void wave_top16_128(float v0, float v1, int lane, float& tv, int& ti) {
    tv = -INFINITY; ti = 0;
    for (int r = 0; r < 16; ++r) {
        const float m = wave_max(fmaxf(v0, v1));
        const unsigned long long b0 = __ballot(v0 == m);
        int idx;
        if (b0) idx = __ffsll((long long)b0) - 1;
        else { const unsigned long long b1 = __ballot(v1 == m); idx = 64 + __ffsll((long long)b1) - 1; }
        if (lane == r) { tv = m; ti = idx; }
        if (lane == (idx & 63)) { if (idx < 64) v0 = -INFINITY; else v1 = -INFINITY; }
    }
}
__device__ __forceinline__ float gelu_exact(float x) { return 0.5f * x * (1.f + erff(x * 0.70710678118654752f)); }

__device__ __forceinline__ void peer_token(LAS unsigned char* wl, const LAS bf16* sk1, const LAS bf16* sk2, int t, const bf16* QP, const bf16* PU, const bf16* PV,
                                           const float* g3, const float* b3, float* xio, bf16* XB, int lane) {
    LAS bf16* qs = (LAS bf16*)wl;
    LAS int* el = (LAS int*)(wl + 4096);
    LAS float* gl = (LAS float*)(wl + 4096 + 512);
    for (int i = lane; i < 256; i += 64) ((LAS v4u*)qs)[i] = ((const v4u*)(QP + (size_t)t * 2048))[i];
    WAVE_LDS_SYNC();
    for (int hh = 0; hh < 8; ++hh) {
        float s1a = 0.f, s1b = 0.f, s2a = 0.f, s2b = 0.f;
        for (int c = 0; c < 128; c += 8) {
            const v4u q1 = *(const LAS v4u*)(qs + hh * 256 + c), q2 = *(const LAS v4u*)(qs + hh * 256 + 128 + c);
            s1a += dot8bb(*(const LAS v4u*)(sk1 + lane * 136 + c), q1);
            s1b += dot8bb(*(const LAS v4u*)(sk1 + (lane + 64) * 136 + c), q1);
            s2a += dot8bb(*(const LAS v4u*)(sk2 + lane * 136 + c), q2);
            s2b += dot8bb(*(const LAS v4u*)(sk2 + (lane + 64) * 136 + c), q2);
        }
        float tv1, tv2; int ti1, ti2;
        wave_top16_128(s1a, s1b, lane, tv1, ti1);
        wave_top16_128(s2a, s2b, lane, tv2, ti2);
        float cd[4];
#pragma unroll
        for (int i = 0; i < 4; ++i) cd[i] = __shfl(tv1, (lane >> 4) + 4 * i) + __shfl(tv2, lane & 15);
        float tv = -INFINITY; int ti = 0;
        for (int r = 0; r < 16; ++r) {
            const float m = wave_max(fmaxf(fmaxf(cd[0], cd[1]), fmaxf(cd[2], cd[3])));
            int idx = -1;
#pragma unroll
            for (int i = 0; i < 4; ++i) { const unsigned long long bq = __ballot(cd[i] == m); if (idx < 0 && bq) idx = 64 * i + __ffsll((long long)bq) - 1; }
            if (lane == r) { tv = m; ti = idx; }
#pragma unroll
            for (int i = 0; i < 4; ++i) if (idx == lane + 64 * i) cd[i] = -INFINITY;
        }
        const float mx = __shfl(tv, 0);
        const float ex = (lane < 16) ? __expf(tv - mx) : 0.f;
        const float inv = 1.f / wave_sum(ex);
        const int e1 = __shfl(ti1, ti >> 4), e2 = __shfl(ti2, ti & 15);
        if (lane < 16) { el[hh * 16 + lane] = e1 * 128 + e2; gl[hh * 16 + lane] = ex * inv; }
    }
    WAVE_LDS_SYNC();
    float xa[8], xb[8];
    {
        const f32x4* xr = (const f32x4*)(xio + (size_t)t * D);
        const f32x4 a0 = xr[2 * lane], a1 = xr[2 * lane + 1], c0 = xr[128 + 2 * lane], c1 = xr[128 + 2 * lane + 1];
        xa[0] = a0.x; xa[1] = a0.y; xa[2] = a0.z; xa[3] = a0.w; xa[4] = a1.x; xa[5] = a1.y; xa[6] = a1.z; xa[7] = a1.w;
        xb[0] = c0.x; xb[1] = c0.y; xb[2] = c0.z; xb[3] = c0.w; xb[4] = c1.x; xb[5] = c1.y; xb[6] = c1.z; xb[7] = c1.w;
    }
    float oa[8], ob[8];
#pragma unroll
    for (int i = 0; i < 8; ++i) { oa[i] = 0.f; ob[i] = 0.f; }
    const bool b5 = (lane & 32) != 0, b4 = (lane & 16) != 0, b3b = (lane & 8) != 0;
    for (int e0 = 0; e0 < 128; e0 += 8) {
        float p[8];
#pragma unroll
        for (int r = 0; r < 8; ++r) {
            const int id = el[e0 + r];
            const bf16* row = PU + (size_t)id * D;
            const v4u ua = *(const v4u*)(row + 8 * lane), ub = *(const v4u*)(row + 512 + 8 * lane);
            p[r] = dot8(ua, xa) + dot8(ub, xb);
        }
        float q4[4], r2[2], s;
#pragma unroll
        for (int i = 0; i < 4; ++i) { const float send = b5 ? p[i] : p[i + 4]; const float recv = __shfl_xor(send, 32); q4[i] = (b5 ? p[i + 4] : p[i]) + recv; }
#pragma unroll
        for (int i = 0; i < 2; ++i) { const float send = b4 ? q4[i] : q4[i + 2]; const float recv = __shfl_xor(send, 16); r2[i] = (b4 ? q4[i + 2] : q4[i]) + recv; }
        { const float send = b3b ? r2[0] : r2[1]; const float recv = __shfl_xor(send, 8); s = (b3b ? r2[1] : r2[0]) + recv; }
        s += __shfl_xor(s, 4); s += __shfl_xor(s, 2); s += __shfl_xor(s, 1);
        const int mine = (lane >> 3) & 7;
        const float coef = gelu_exact(s) * gl[e0 + mine];
#pragma unroll
        for (int r = 0; r < 8; ++r) {
            const float cr = __shfl(coef, r * 8);
            const int id = el[e0 + r];
            const bf16* row = PV + (size_t)id * D;
            const v4u va = *(const v4u*)(row + 8 * lane), vb = *(const v4u*)(row + 512 + 8 * lane);
            oa[0] += cr * lo16(va.x); oa[1] += cr * hi16(va.x); oa[2] += cr * lo16(va.y); oa[3] += cr * hi16(va.y);
            oa[4] += cr * lo16(va.z); oa[5] += cr * hi16(va.z); oa[6] += cr * lo16(va.w); oa[7] += cr * hi16(va.w);
            ob[0] += cr * lo16(vb.x); ob[1] += cr * hi16(vb.x); ob[2] += cr * lo16(vb.y); ob[3] += cr * hi16(vb.y);
            ob[4] += cr * lo16(vb.z); ob[5] += cr * hi16(vb.z); ob[6] += cr * lo16(vb.w); ob[7] += cr * hi16(vb.w);
        }
    }
    float s1 = 0.f;
#pragma unroll
    for (int i = 0; i < 8; ++i) { oa[i] = ALPHA * xa[i] + oa[i]; ob[i] = ALPHA * xb[i] + ob[i]; s1 += oa[i] + ob[i]; }
    const float mean = wave_sum(s1) * (1.f / D);
    float s2 = 0.f;
#pragma unroll
    for (int i = 0; i < 8; ++i) { oa[i] -= mean; ob[i] -= mean; s2 += oa[i] * oa[i] + ob[i] * ob[i]; }
    const float rstd = rsqrtf(wave_sum(s2) * (1.f / D) + LN_EPS);
    {
        const f32x4* gr = (const f32x4*)g3; const f32x4* br = (const f32x4*)b3;
        f32x4* xo = (f32x4*)(xio + (size_t)t * D);
        v4u* xbo = (v4u*)(XB + (size_t)t * D);
        const f32x4 g0 = gr[2 * lane], g1 = gr[2 * lane + 1], g2 = gr[128 + 2 * lane], g3v = gr[128 + 2 * lane + 1];
        const f32x4 c0 = br[2 * lane], c1 = br[2 * lane + 1], c2 = br[128 + 2 * lane], c3 = br[128 + 2 * lane + 1];
        f32x4 y0, y1, y2, y3;
        y0.x = oa[0] * rstd * g0.x + c0.x; y0.y = oa[1] * rstd * g0.y + c0.y; y0.z = oa[2] * rstd * g0.z + c0.z; y0.w = oa[3] * rstd * g0.w + c0.w;
        y1.x = oa[4] * rstd * g1.x + c1.x; y1.y = oa[5] * rstd * g1.y + c1.y; y1.z = oa[6] * rstd * g1.z + c1.z; y1.w = oa[7] * rstd * g1.w + c1.w;
        y2.x = ob[0] * rstd * g2.x + c2.x; y2.y = ob[1] * rstd * g2.y + c2.y; y2.z = ob[2] * rstd * g2.z + c2.z; y2.w = ob[3] * rstd * g2.w + c2.w;
        y3.x = ob[4] * rstd * g3v.x + c3.x; y3.y = ob[5] * rstd * g3v.y + c3.y; y3.z = ob[6] * rstd * g3v.z + c3.z; y3.w = ob[7] * rstd * g3v.w + c3.w;
        xo[2 * lane] = y0; xo[2 * lane + 1] = y1; xo[128 + 2 * lane] = y2; xo[128 + 2 * lane + 1] = y3;
        v4u w0, w1;
        w0.x = pk2(y0.x, y0.y); w0.y = pk2(y0.z, y0.w); w0.z = pk2(y1.x, y1.y); w0.w = pk2(y1.z, y1.w);
        w1.x = pk2(y2.x, y2.y); w1.y = pk2(y2.z, y2.w); w1.z = pk2(y3.x, y3.y); w1.w = pk2(y3.z, y3.w);
        xbo[lane] = w0; xbo[64 + lane] = w1;
    }
    WAVE_LDS_SYNC();
}

constexpr int PH_PER_LAYER = 12, NPH = 1 + 2 * PH_PER_LAYER;

#define PHASE_ENV() KArgs ap = kargs(); unsigned char* const ws = ap->ws; const int tid = threadIdx.x, lane = tid & 63, wave = __builtin_amdgcn_readfirstlane(tid >> 6); \
    const int G = gridDim.x, bid = blockIdx.x; (void)ws; (void)lane; (void)wave; (void)G; (void)bid
#define P_XB   ((bf16*)(ws + WS_XB))
#define P_HB   ((bf16*)(ws + WS_HB))
#define P_HS   ((float*)(ws + WS_HS))
#define P_CAT  ((bf16*)(ws + WS_CAT))
#define P_CKV  ((bf16*)(ws + WS_CKV))
#define P_SEL  ((unsigned short*)(ws + WS_SEL))
#define P_NSEL ((int*)(ws + WS_NSEL))
#define P_MQ   ((float*)(ws + WS_MQ))
#define P_MK   ((float*)(ws + WS_MK))
#define P_MC   ((float*)(ws + WS_MC))
#define P_MN   ((float*)(ws + WS_MN))
#define P_SCL  ((float*)(ws + WS_SCL))
#define P_BC   ((float*)(ws + WS_BC))
#define P_IG   ((float*)(ws + WS_IG))
#define P_QX   ((bf16*)(ws + WS_QX))
#define P_OX   ((bf16*)(ws + WS_OX))
#define P_QP   ((bf16*)(ws + WS_QP))

#ifndef ONLYSITE
#define SITE(j) true
#else
#define SITE(j) ((j) == ONLYSITE)
#endif
#define IN(k) (lo <= (k) && (k) < hi)
#define SEAM(k) do { if (IN(k) && IN((k) + 1)) xcd_barrier(bar); } while (0)


template <int l>
__device__ __forceinline__ void run_layer(LAS unsigned char* lds, const int lo, const int hi, const XcdBarrier& bar) {
        const int pb = 1 + PH_PER_LAYER * l;
        if (IN(pb + 0) && SITE(1)) {
            PHASE_ENV();
            {
                pg8::Gemm g{P_XB, (const bf16*)(ws + WS_WIN) + (size_t)l * HN * D, T, HN, D}; pg8::StaticOrder S; S.init(T, HN, G, bid);
                EpiH E{P_HB, P_HS};
                pg8::gemm_phase<EpiH, pg8::StaticOrder, true, true>(lds, g, S, E);
            }
            if (l == 0) {
                for (int l2 = 0; l2 < 2; ++l2) {
                    __syncthreads();
                    pg8::Gemm g2{(const bf16*)(ws + WS_MEMB), (const bf16*)(ws + WS_WCKV) + (size_t)l2 * 2048 * D, 512, 2048, D}; pg8::StaticOrder S2; S2.init(512, 2048, G, bid);
                    EpiB16 E2{(bf16*)(ws + WS_KV) + (size_t)l2 * 512 * 2048, 2048};
                    pg8::gemm_phase<EpiB16, pg8::StaticOrder, true, true>(lds, g2, S2, E2);
                }
            }
        }
        SEAM(pb + 0);
        if (IN(pb + 1) && SITE(2)) {
            PHASE_ENV();
#ifndef SUBMASK
#define SUBMASK 15
#endif
            if (SUBMASK & 1) for (int tile = bid; tile < T / 64; tile += G)
                conv_unit(lds, tile, P_HB, ap->in[I_CAW] + (size_t)l * 31 * 256, ap->in[I_CAB] + l * 256, ap->in[I_NAG] + l * 256, ap->in[I_NAB] + l * 256, P_CAT, tid);
            if (SUBMASK & 2) {
                const float* kg = ap->in[I_KVG] + l * 128; const bf16* HB = P_HB; bf16* CKV = P_CKV;
                for (int t = bid * 8 + wave; t < T; t += G * 8) {
                    const float c0 = bf2f(HB[(size_t)t * HN + H_CB + lane]), c1 = bf2f(HB[(size_t)t * HN + H_CB + 64 + lane]);
                    const float r = rsqrtf(wave_sum(c0 * c0 + c1 * c1) * (1.f / 128.f) + LN_EPS);
                    CKV[(size_t)t * 128 + lane] = (bf16)f2bf(c0 * r * kg[lane]); CKV[(size_t)t * 128 + 64 + lane] = (bf16)f2bf(c1 * r * kg[64 + lane]);
                }
            }
            if (SUBMASK & 4) for (int cidx = bid; cidx < NCHUNK; cidx += G)
                mlstm_prep_unit(lds, cidx, P_HB, P_HS, ap->in[I_CMW] + (size_t)l * 4 * 256, ap->in[I_CMB] + l * 256, ap->in[I_WQM] + (size_t)l * 4 * 4096, ap->in[I_WKM] + (size_t)l * 4 * 4096,
                                ap->in[I_BI] + l * 4, ap->in[I_BF] + l * 4, P_MQ, P_MK, P_MC, P_MN, P_SCL, P_BC, P_IG, tid);
#ifdef NAIVE_INDEXER
            if (SUBMASK & 8) for (int t = bid; t < T; t += G) indexer_query(lds, t, P_HB, P_HS, P_SEL, P_NSEL, tid);
#else
            if (SUBMASK & 8) for (int pr = bid; pr < 256; pr += G) {
                const int b = pr >> 7, i0 = pr & 127;
                indexer_strip(lds, b, 255 - i0, P_HB, P_HS, P_SEL, P_NSEL, tid);
                indexer_strip(lds, b, i0, P_HB, P_HS, P_SEL, P_NSEL, tid);
            }
#endif
        }
        SEAM(pb + 1);
        if (IN(pb + 2) && SITE(3)) {
            PHASE_ENV();
            if (bid < 65) mlstm_scan(bid * 512 + tid, P_MC, P_MN, P_SCL);
            for (int t = bid * 8 + wave; t < T; t += G * 8) dsa_attn_query(lds + wave * 16384, t, P_HB, P_CKV, P_SEL, P_NSEL, ap->in[I_RELB], P_CAT, lane);
        }
        SEAM(pb + 2);
        if (IN(pb + 3) && SITE(4)) {
            PHASE_ENV();
            for (int cidx = bid; cidx < NCHUNK; cidx += G)
                mlstm_out_unit(lds, cidx, P_HB, P_MQ, P_MK, P_MC, P_MN, P_SCL, P_BC, P_IG, ap->in[I_NMG] + l * 256, P_CAT, tid);
        }
        SEAM(pb + 3);
        if (IN(pb + 4) && SITE(5)) {
            PHASE_ENV();
            pg8::Gemm g{P_CAT, (const bf16*)(ws + WS_WOUT) + (size_t)l * D * CATW, T, D, CATW}; pg8::StaticOrder S; S.init(T, D, G, bid);
            EpiResid E{ap->out, D, ALPHA};
            pg8::gemm_phase<EpiResid, pg8::StaticOrder, true, true>(lds, g, S, E);
        }
        SEAM(pb + 4);
        if (IN(pb + 5) && SITE(6)) {
            PHASE_ENV();
            float* X = ap->out; bf16* XB = P_XB; const float* g1 = ap->in[I_LN1G] + l * D; const float* b1 = ap->in[I_LN1B] + l * D;
            for (int m = bid * 8 + wave; m < T; m += G * 8) ln_row(X + (size_t)m * D, g1, b1, X + (size_t)m * D, XB + (size_t)m * D, lane);
        }
        SEAM(pb + 5);
        if (IN(pb + 6) && SITE(7)) {
            PHASE_ENV();
            pg8::Gemm g{P_XB, (const bf16*)(ws + WS_WCQ) + (size_t)l * D * D, T, D, D}; pg8::StaticOrder S; S.init(T, D, G, bid);
            EpiB16 E{P_QX, D};
            pg8::gemm_phase<EpiB16, pg8::StaticOrder, true, true>(lds, g, S, E);
        }
        SEAM(pb + 6);
        if (IN(pb + 7) && SITE(8)) {
            PHASE_ENV();
            const bf16* KV = (const bf16*)(ws + WS_KV) + (size_t)l * 512 * 2048;
            for (int t = bid * 8 + wave; t < T; t += G * 8) xattn_token(lds + wave * 4096, t, P_QX, KV, P_OX, lane);
        }
        SEAM(pb + 7);
        if (IN(pb + 8) && SITE(9)) {
            PHASE_ENV();
            pg8::Gemm g{P_OX, (const bf16*)(ws + WS_WCO) + (size_t)l * D * D, T, D, D}; pg8::StaticOrder S; S.init(T, D, G, bid);
            EpiResid E{ap->out, D, ALPHA};
            pg8::gemm_phase<EpiResid, pg8::StaticOrder, true, true>(lds, g, S, E);
        }
        SEAM(pb + 8);
        if (IN(pb + 9) && SITE(10)) {
            PHASE_ENV();
            float* X = ap->out; bf16* XB = P_XB; const float* g2 = ap->in[I_LN2G] + l * D; const float* b2 = ap->in[I_LN2B] + l * D;
            for (int m = bid * 8 + wave; m < T; m += G * 8) ln_row(X + (size_t)m * D, g2, b2, X + (size_t)m * D, XB + (size_t)m * D, lane);
        }
        SEAM(pb + 9);
        if (IN(pb + 10) && SITE(11)) {
            PHASE_ENV();
            pg8::Gemm g{P_XB, (const bf16*)(ws + WS_WPQ) + (size_t)l * 2048 * D, T, 2048, D}; pg8::StaticOrder S; S.init(T, 2048, G, bid);
            EpiB16 E{P_QP, 2048};
            pg8::gemm_phase<EpiB16, pg8::StaticOrder, true, true>(lds, g, S, E);
        }
        SEAM(pb + 10);
        if (IN(pb + 11) && SITE(12)) {
            PHASE_ENV();
            LAS bf16* sk1 = (LAS bf16*)lds; LAS bf16* sk2 = sk1 + 128 * 136;
            const float* k1 = ap->in[I_SK1] + (size_t)l * 128 * 128; const float* k2 = ap->in[I_SK2] + (size_t)l * 128 * 128;
            for (int i = tid; i < 128 * 128; i += 512) { const int n = i >> 7, d = i & 127; sk1[n * 136 + d] = (bf16)f2bf(k1[i]); sk2[n * 136 + d] = (bf16)f2bf(k2[i]); }
            __syncthreads();
            const bf16* PU = (const bf16*)(ws + WS_PU) + (size_t)l * 16384 * D; const bf16* PV = (const bf16*)(ws + WS_PV) + (size_t)l * 16384 * D;
            for (int t = bid * 8 + wave; t < T; t += G * 8)
                peer_token(lds + 69632 + wave * 5120, sk1, sk2, t, P_QP, PU, PV, ap->in[I_LN3G] + l * D, ap->in[I_LN3B] + l * D, ap->out, P_XB, lane);
            __syncthreads();
        }
        SEAM(pb + 11);
}

__global__ void __launch_bounds__(512, 2) fwd(Args a_unused) {
    extern __shared__ __attribute__((aligned(16))) unsigned char lds_raw[];
    LAS unsigned char* lds = (LAS unsigned char*)lds_raw;
    volatile LAS unsigned* MISC = (volatile LAS unsigned*)(lds + MISC_OFF);
    if (threadIdx.x < 32) MISC[threadIdx.x] = 0u;
    __syncthreads();
    int lo, hi;
    XcdBarrier bar;
    { KArgs ap = kargs(); lo = ap->lo; hi = ap->hi; bar = xcd_barrier_post((unsigned*)(ap->ws + WS_CTL) + 4096 + ap->li * XCD_BAR_WORDS, MISC + 8); }
    if (IN(0) && SITE(0)) { p0_prologue(lds, threadIdx.x, gridDim.x, blockIdx.x); }
    SEAM(0);

    run_layer<0>(lds, lo, hi, bar);
    run_layer<1>(lds, lo, hi, bar);
#undef IN
#undef SEAM
}

extern "C" void kernel_launch(void* const* d_in, const int* in_sizes, int n_in, void* d_out, int out_size, void* d_ws, size_t ws_size, hipStream_t stream) {
    static int grid = 0;
    if (grid == 0) {
        if (n_in != 35 || out_size != T * D || ws_size < WS_END) { fprintf(stderr, "kernel_launch: unexpected shapes (n_in %d, out %d, ws %zu)\n", n_in, out_size, ws_size); grid = -1; return; }
        int dev = 0, cus = 0, per_cu = 0;
        if (hipGetDevice(&dev) != hipSuccess || hipDeviceGetAttribute(&cus, hipDeviceAttributeMultiprocessorCount, dev) != hipSuccess) { grid = -1; return; }
        if (hipFuncSetAttribute((const void*)fwd, hipFuncAttributeMaxDynamicSharedMemorySize, LDS_BYTES) != hipSuccess) { fprintf(stderr, "kernel_launch: hipFuncSetAttribute failed\n"); grid = -1; return; }
        if (hipOccupancyMaxActiveBlocksPerMultiprocessor(&per_cu, (const void*)fwd, 512, LDS_BYTES) != hipSuccess || per_cu < 1) fprintf(stderr, "kernel_launch: occupancy query reports %d\n", per_cu);
        (void)hipGetLastError();
        grid = cus;
    }
    if (grid < 0) return;
    (void)hipMemsetAsync((char*)d_ws + WS_CTL, 0, CTL_ZERO_BYTES, stream);
    Args a{};
    for (int i = 0; i < 35; ++i) a.in[i] = (const float*)d_in[i];
    a.out = (float*)d_out; a.ws = (unsigned char*)d_ws;
#if MK_SINGLE
    a.lo = 0; a.hi = NPH; a.li = 0; a.pad = 0;
    hipLaunchKernelGGL(fwd, dim3(grid), dim3(512), LDS_BYTES, stream, a);
#else
    for (int p = 0; p < NPH; ++p) { a.lo = p; a.hi = p + 1; a.li = 0; a.pad = 0; hipLaunchKernelGGL(fwd, dim3(grid), dim3(512), LDS_BYTES, stream, a); }
#endif
}
```

```cpp
#include <hip/hip_runtime.h>
#include <cstdio>
#include <cstdint>
namespace pg8 {
#define PG8_LAS __attribute__((address_space(3)))
typedef unsigned short bf16_t;
typedef short bf16x8 __attribute__((ext_vector_type(8)));
typedef float f32x4 __attribute__((ext_vector_type(4)));
typedef unsigned u32x4 __attribute__((ext_vector_type(4)));
constexpr int BM = 256, BK = 64, HALF = 128, HTB = HALF * BK * 2  , STAGE_BYTES = 8 * HTB, NXCD = 8, WGM = 8;

__host__ __device__ __forceinline__ int lds_byte(int r, int c) { const int st = (r >> 4) * 2 + (c >> 5), rr = r & 15, cc = c & 31, ob = rr * 64 + cc * 2; return st * 1024 + (ob ^ (((ob >> 9) & 1) << 5)); }
__host__ __device__ __forceinline__ void stage_rc(int b, int& R, int& C) { const int st = b / 1024, sb = b % 1024, swz = sb ^ (((sb >> 9) & 1) << 5); R = (st >> 1) * 16 + swz / 64; C = (st & 1) * 32 + (swz % 64) / 2; }
__host__ __device__ __forceinline__ int perm32(int rho) { const int n = rho >> 4, i = rho & 15; return 8 * (i >> 2) + 4 * n + (i & 3); }

struct Unit { int pm, pn; };
struct Gemm { const bf16_t* A; const bf16_t* Bt; int M, N, K; };

struct StaticOrder {
    int nM, nN, nwg, G, c;
    __host__ __device__ void init(int M, int N, int G_, int c_) { nM = M / BM; nN = N / BM; nwg = nM * nN; G = G_; c = c_; }
    __host__ __device__ bool next(int i, Unit& u) const {
        const long L = (long)i * G + c; if (L >= nwg) return false;
        int wgid = (int)L; { const int q = nwg / NXCD, r = nwg % NXCD, xcd = wgid % NXCD, off = wgid / NXCD; wgid = (xcd < r ? xcd * (q + 1) : r * (q + 1) + (xcd - r) * q) + off; }
        const int nig = WGM * nN, gid = wgid / nig, fm = gid * WGM, gsz = (nM - fm) < WGM ? (nM - fm) : WGM;
        u.pm = fm + ((wgid % nig) % gsz); u.pn = (wgid % nig) / gsz; return true;
    }
    __device__ __forceinline__ void a_ready(const Unit&) const {}
    __device__ __forceinline__ void done(const Unit&) const {}
};
__device__ __forceinline__ unsigned cvt_pk_bf16(float lo, float hi) { unsigned r; asm volatile("v_cvt_pk_bf16_f32 %0, %1, %2" : "=v"(r) : "v"(lo), "v"(hi)); return r; }
template <class Epi, class Sched, bool ALIGN_EPI = false, bool SP2 = false>
__device__ __forceinline__ void gemm_phase(PG8_LAS unsigned char* lds, const Gemm g, const Sched& S, const Epi& E) {
    const int tid = threadIdx.x, wid = __builtin_amdgcn_readfirstlane(tid >> 6), lane = tid & 63, wr = wid >> 2, wc = wid & 3, fr = lane & 15, fq = lane >> 4;
    const int K = g.K, nt = K / BK;
    unsigned voffA[2], voffB[2];
#pragma unroll
    for (int i = 0; i < 2; ++i) { int R, C; stage_rc(tid * 16 + i * 8192, R, C); const int Rb = Epi::PERM ? ((R & ~31) + perm32(R & 31)) : R;
        voffA[i] = (unsigned)(R * K + C) * 2u; voffB[i] = (unsigned)(Rb * K + C) * 2u; }
    const size_t kstep = (size_t)(BK * 2);
    const size_t hstep = (size_t)HALF * K * 2;
    const size_t tstep = 2 * hstep;
    const unsigned ldsw = (unsigned)wid * 1024u;
    const int aoff = lds_byte(wr * 64 + fr, fq * 8), boff = lds_byte(wc * 32 + fr, fq * 8);
#define PG8_SA(b, h) (((b) * 2 + (h)) * HTB)
#define PG8_SB(b, h) ((4 + (b) * 2 + (h)) * HTB)
#define PG8_STAGE(bufoff, gbase, voff) do { _Pragma("unroll") for (int _i = 0; _i < 2; ++_i) \
        __builtin_amdgcn_global_load_lds((const unsigned*)((const char*)(gbase) + (voff)[_i]), (PG8_LAS unsigned*)(lds + (bufoff) + ldsw + _i * 8192), 16, 0, 0); } while (0)
#define PG8_LDA(dst, b, h) do { _Pragma("unroll") for (int m = 0; m < 4; ++m) _Pragma("unroll") for (int k = 0; k < 2; ++k) dst[m][k] = *(const PG8_LAS bf16x8*)(lds + PG8_SA(b, h) + aoff + m * 2048 + k * 1024); } while (0)
#define PG8_LDB(dst, b, h) do { _Pragma("unroll") for (int n = 0; n < 2; ++n) _Pragma("unroll") for (int k = 0; k < 2; ++k) dst[n][k] = *(const PG8_LAS bf16x8*)(lds + PG8_SB(b, h) + boff + n * 2048 + k * 1024); } while (0)
#define PG8_MMA(ai, bj, At, Bt) do { __builtin_amdgcn_s_setprio(1); _Pragma("unroll") for (int m = 0; m < 4; ++m) _Pragma("unroll") for (int n = 0; n < 2; ++n) _Pragma("unroll") for (int k = 0; k < 2; ++k) \
        acc[ai][bj][m][n] = __builtin_amdgcn_mfma_f32_16x16x32_bf16(Bt[n][k], At[m][k], acc[ai][bj][m][n], 0, 0, 0); __builtin_amdgcn_s_setprio(0); } while (0)
#define PG8_WAIT_V(n) asm volatile("s_waitcnt vmcnt(" #n ")" ::: "memory")
#define PG8_WAIT_L(n) asm volatile("s_waitcnt lgkmcnt(" #n ")" ::: "memory")
#define PG8_BAR __builtin_amdgcn_s_barrier()
#define PG8_SCHED __builtin_amdgcn_sched_barrier(0)
    Unit cur, nxt; int ui = 0;
    if (!S.next(0, cur)) return;
    f32x4 acc[2][2][4][2];
#pragma unroll
    for (int a = 0; a < 2; ++a)
#pragma unroll
        for (int b = 0; b < 2; ++b)
#pragma unroll
            for (int m = 0; m < 4; ++m)
#pragma unroll
                for (int n = 0; n < 2; ++n) acc[a][b][m][n] = (f32x4){0.f, 0.f, 0.f, 0.f};
    bf16x8 At[4][2], B0[2][2], B1[2][2];
    const char* cA = (const char*)g.A + (size_t)cur.pm * tstep; const char* cB = (const char*)g.Bt + (size_t)cur.pn * tstep;
    S.a_ready(cur);
    if constexpr (SP2) {
        PG8_STAGE(PG8_SB(0, 0), cB, voffB); PG8_STAGE(PG8_SB(0, 1), cB + hstep, voffB); PG8_STAGE(PG8_SA(0, 0), cA, voffA); PG8_STAGE(PG8_SA(0, 1), cA + hstep, voffA);
        if (wr == 1) PG8_BAR;
        PG8_WAIT_V(2); PG8_BAR;
        PG8_STAGE(PG8_SB(1, 0), cB + kstep, voffB); PG8_STAGE(PG8_SA(1, 0), cA + kstep, voffA); PG8_STAGE(PG8_SB(1, 1), cB + hstep + kstep, voffB);
        PG8_WAIT_V(6); PG8_BAR;
    } else {
        PG8_STAGE(PG8_SB(0, 0), cB, voffB); PG8_STAGE(PG8_SA(0, 0), cA, voffA); PG8_STAGE(PG8_SB(0, 1), cB + hstep, voffB); PG8_STAGE(PG8_SA(0, 1), cA + hstep, voffA);
        if (wr == 1) PG8_BAR;
        PG8_WAIT_V(4); PG8_BAR;
        PG8_STAGE(PG8_SB(1, 0), cB + kstep, voffB); PG8_STAGE(PG8_SA(1, 0), cA + kstep, voffA); PG8_STAGE(PG8_SB(1, 1), cB + hstep + kstep, voffB);
        PG8_WAIT_V(6); PG8_BAR;
    }
    for (;;) {
        const bool has_next = S.next(ui + 1, nxt);
        const char* nA = has_next ? (const char*)g.A + (size_t)nxt.pm * tstep : cA; const char* nB = has_next ? (const char*)g.Bt + (size_t)nxt.pn * tstep : cB;
        for (int t = 0; t < nt; t += 2) {
            const bool last = (t == nt - 2);
            const char* a1 = cA + (size_t)(t + 1) * kstep;
            const char* a2 = last ? nA : cA + (size_t)(t + 2) * kstep; const char* b2 = last ? nB : cB + (size_t)(t + 2) * kstep;
            const char* a3 = a2 + kstep; const char* b3 = b2 + kstep;
            if (last && has_next) S.a_ready(nxt);
            if constexpr (SP2) {
            PG8_LDB(B0, 0, 0); PG8_LDB(B1, 0, 1); PG8_SCHED; PG8_LDA(At, 0, 0); PG8_STAGE(PG8_SA(1, 1), a1 + hstep, voffA);
            PG8_WAIT_V(8); PG8_WAIT_L(0); PG8_BAR; PG8_MMA(0, 0, At, B0); PG8_MMA(0, 1, At, B1); PG8_BAR; PG8_SCHED;
            PG8_LDA(At, 0, 1); PG8_STAGE(PG8_SB(0, 0), b2, voffB); PG8_STAGE(PG8_SB(0, 1), b2 + hstep, voffB); PG8_STAGE(PG8_SA(0, 0), a2, voffA);
            PG8_WAIT_V(8); PG8_WAIT_L(0); PG8_BAR; PG8_MMA(1, 0, At, B0); PG8_MMA(1, 1, At, B1); PG8_BAR; PG8_SCHED;
            PG8_LDB(B0, 1, 0); PG8_LDB(B1, 1, 1); PG8_SCHED; PG8_LDA(At, 1, 0); PG8_STAGE(PG8_SA(0, 1), a2 + hstep, voffA);
            PG8_WAIT_V(8); PG8_WAIT_L(0); PG8_BAR; PG8_MMA(0, 0, At, B0); PG8_MMA(0, 1, At, B1); PG8_BAR; PG8_SCHED;
            PG8_LDA(At, 1, 1); PG8_STAGE(PG8_SB(1, 0), b3, voffB); PG8_STAGE(PG8_SB(1, 1), b3 + hstep, voffB); PG8_STAGE(PG8_SA(1, 0), a3, voffA);
            PG8_WAIT_V(8); PG8_WAIT_L(0); PG8_BAR; PG8_MMA(1, 0, At, B0); PG8_MMA(1, 1, At, B1); PG8_BAR; PG8_SCHED;
            } else {
            PG8_LDB(B0, 0, 0); PG8_SCHED; PG8_LDA(At, 0, 0); PG8_STAGE(PG8_SA(1, 1), a1 + hstep, voffA);
            PG8_WAIT_L(8); PG8_BAR; PG8_WAIT_L(0); PG8_MMA(0, 0, At, B0); PG8_BAR; PG8_SCHED;
            PG8_LDB(B1, 0, 1); PG8_STAGE(PG8_SB(0, 0), b2, voffB);
            PG8_BAR; PG8_WAIT_L(0); PG8_MMA(0, 1, At, B1); PG8_BAR;
            PG8_LDA(At, 0, 1); PG8_STAGE(PG8_SA(0, 0), a2, voffA);
            PG8_BAR; PG8_WAIT_L(0); PG8_MMA(1, 0, At, B0); PG8_BAR; PG8_SCHED;
            PG8_STAGE(PG8_SB(0, 1), b2 + hstep, voffB);
            PG8_WAIT_V(6); PG8_BAR; PG8_MMA(1, 1, At, B1); PG8_BAR;
            PG8_LDB(B0, 1, 0); PG8_SCHED; PG8_LDA(At, 1, 0); PG8_STAGE(PG8_SA(0, 1), a2 + hstep, voffA);
            PG8_WAIT_L(8); PG8_BAR; PG8_WAIT_L(0); PG8_MMA(0, 0, At, B0); PG8_BAR; PG8_SCHED;
            PG8_LDB(B1, 1, 1); PG8_STAGE(PG8_SB(1, 0), b3, voffB);
            PG8_BAR; PG8_WAIT_L(0); PG8_MMA(0, 1, At, B1); PG8_BAR;
            PG8_LDA(At, 1, 1); PG8_STAGE(PG8_SA(1, 0), a3, voffA);
            PG8_BAR; PG8_WAIT_L(0); PG8_MMA(1, 0, At, B0); PG8_BAR; PG8_SCHED;
            PG8_STAGE(PG8_SB(1, 1), b3 + hstep, voffB);
            PG8_WAIT_V(6); PG8_BAR; PG8_MMA(1, 1, At, B1); PG8_BAR;
            }
        }
        if constexpr (ALIGN_EPI) { if (wr == 0) PG8_BAR; }
        if constexpr (!Epi::AFTER_DRAIN) { E(acc, cur, wr, wc, fr, fq); S.done(cur); }
        if (!has_next) break;
#pragma unroll
        for (int a = 0; a < 2; ++a)
#pragma unroll
            for (int b = 0; b < 2; ++b)
#pragma unroll
                for (int m = 0; m < 4; ++m)
#pragma unroll
                    for (int n = 0; n < 2; ++n) acc[a][b][m][n] = (f32x4){0.f, 0.f, 0.f, 0.f};
        cur = nxt; cA = nA; cB = nB; ++ui;
        if constexpr (ALIGN_EPI) { if (wr == 1) PG8_BAR; }
    }
    PG8_WAIT_V(0);
    if constexpr (!ALIGN_EPI) { if (wr == 0) PG8_BAR; }
    PG8_BAR;
    if constexpr (Epi::AFTER_DRAIN) { E.fused(acc, cur, wr, wc, fr, fq, lds, wid, lane); S.done(cur); }
#undef PG8_SA
#undef PG8_SB
#undef PG8_STAGE
#undef PG8_LDA
#undef PG8_LDB
#undef PG8_MMA
#undef PG8_WAIT_V
#undef PG8_WAIT_L
#undef PG8_BAR
#undef PG8_SCHED
}
}

#define LAS __attribute__((address_space(3)))
typedef unsigned short bf16;
typedef unsigned v4u __attribute__((ext_vector_type(4)));
typedef unsigned v2u __attribute__((ext_vector_type(2)));
typedef float f32x4 __attribute__((ext_vector_type(4)));

#ifndef MK_SINGLE
#define MK_SINGLE 1
#endif

constexpr int NB = 2, L = 8192, T = NB * L, D = 1024;
constexpr int HN = 2816;
constexpr int H_A = 0, H_QL = 512, H_CB = 1536, H_QI = 1664, H_KI = 1920, H_XC = 1984, H_V = 2240, H_O = 2496, H_S = 2752;
constexpr int CATW = 1536, CAT_A = 0, CAT_B = 256, CAT_C = 1280;
constexpr int WIN_N = 2252;
constexpr float ALPHA = 1.4142135623730951f;
constexpr float LN_EPS = 1e-5f;
constexpr int NCHUNK = 1024;

constexpr size_t MiB = 1u << 20;
constexpr size_t WS_CTL = 0, CTL_ZERO_BYTES = 1 * MiB;
constexpr size_t WS_WIN  = 1 * MiB;
constexpr size_t WS_WOUT = 12 * MiB;
constexpr size_t WS_WCQ  = 18 * MiB;
constexpr size_t WS_WCKV = 22 * MiB;
constexpr size_t WS_WCO  = 30 * MiB;
constexpr size_t WS_WPQ  = 34 * MiB;
constexpr size_t WS_MEMB = 42 * MiB;
constexpr size_t WS_KV   = 43 * MiB;
constexpr size_t WS_PU   = 48 * MiB;
constexpr size_t WS_PV   = 112 * MiB;
constexpr size_t WS_XB   = 176 * MiB;
constexpr size_t WS_HB   = 208 * MiB;
constexpr size_t WS_QX   = 208 * MiB;
constexpr size_t WS_OX   = 240 * MiB;
constexpr size_t WS_QP   = 208 * MiB;
constexpr size_t WS_HS   = 296 * MiB;
constexpr size_t WS_CAT  = 297 * MiB;
constexpr size_t WS_CKV  = 345 * MiB;
constexpr size_t WS_SEL  = 349 * MiB;
constexpr size_t WS_MQ   = 357 * MiB;
constexpr size_t WS_MK   = 373 * MiB;
constexpr size_t WS_MC   = 389 * MiB;
constexpr size_t WS_MN   = 405 * MiB;
constexpr size_t WS_SCL  = WS_MN + 512 * 1024;
constexpr size_t WS_BC   = 406 * MiB;
constexpr size_t WS_IG   = WS_BC + 512 * 1024;
constexpr size_t WS_NSEL = 407 * MiB;
constexpr size_t WS_END  = 408 * MiB;

constexpr int LDS_BYTES = 147456;
constexpr int MISC_OFF = 131072 + 320;

__device__ __forceinline__ float bf2f(unsigned h) { return __uint_as_float(h << 16); }
__device__ __forceinline__ unsigned f2bf(float f) { unsigned u = __float_as_uint(f); return (u + 0x7fffu + ((u >> 16) & 1u)) >> 16; }
__device__ __forceinline__ unsigned pk2(float lo, float hi) { return f2bf(lo) | (f2bf(hi) << 16); }
__device__ __forceinline__ float lo16(unsigned u) { return __uint_as_float(u << 16); }
__device__ __forceinline__ float hi16(unsigned u) { return __uint_as_float(u & 0xffff0000u); }
__device__ __forceinline__ float wave_sum(float v) {
#pragma unroll
    for (int o = 1; o < 64; o <<= 1) v += __shfl_xor(v, o);
    return v;
}
__device__ __forceinline__ float wave_max(float v) {
#pragma unroll
    for (int o = 1; o < 64; o <<= 1) v = fmaxf(v, __shfl_xor(v, o));
    return v;
}
__device__ __forceinline__ int wave_sum_i(int v) {
#pragma unroll
    for (int o = 1; o < 64; o <<= 1) v += __shfl_xor(v, o);
    return v;
}
#define WAVE_LDS_SYNC() asm volatile("s_waitcnt lgkmcnt(0)" ::: "memory")
__device__ __forceinline__ float sigmoidf_(float x) { return 1.f / (1.f + __expf(-x)); }
__device__ __forceinline__ float dot8(v4u a, const float (&x)[8]) {
    return lo16(a.x) * x[0] + hi16(a.x) * x[1] + lo16(a.y) * x[2] + hi16(a.y) * x[3] + lo16(a.z) * x[4] + hi16(a.z) * x[5] + lo16(a.w) * x[6] + hi16(a.w) * x[7];
}
__device__ __forceinline__ float dot8bb(v4u a, v4u b) {
    return lo16(a.x) * lo16(b.x) + hi16(a.x) * hi16(b.x) + lo16(a.y) * lo16(b.y) + hi16(a.y) * hi16(b.y) + lo16(a.z) * lo16(b.z) + hi16(a.z) * hi16(b.z) + lo16(a.w) * lo16(b.w) + hi16(a.w) * hi16(b.w);
}

#define XB_TMO      128
#define XB_XCNT(j)  (256  + 64 * (j))
#define XB_XSUB(j)  (1280 + 64 * (j))
#define XB_XGEN(j)  (2304 + 64 * (j))
#define XB_TOP      3328
#define XB_TOPGEN   3392
#define XCD_BAR_WORDS 3456
#define XB_SPIN_CAP (1u << 18)

__device__ __forceinline__ unsigned xb_ld(unsigned* p)              { return __hip_atomic_load(p, __ATOMIC_RELAXED, __HIP_MEMORY_SCOPE_AGENT); }
__device__ __forceinline__ unsigned xb_add(unsigned* p, unsigned v) { return __hip_atomic_fetch_add(p, v, __ATOMIC_RELAXED, __HIP_MEMORY_SCOPE_AGENT); }
__device__ __forceinline__ unsigned xb_xcc_id() { return (unsigned)__builtin_amdgcn_s_getreg((3 << 11) | 20) & 0xFu; }
#define XB_SPIN(cond, bar) do { unsigned _sp = 0; while (cond) { __builtin_amdgcn_s_sleep(1); \
    if ((++_sp & 255u) == 0u) { if (xb_ld(&(bar)[XB_TMO])) break; if (_sp > XB_SPIN_CAP) { atomicAdd(&(bar)[XB_TMO], 1u); break; } } } } while (0)

struct XcdBarrier { unsigned* bar; unsigned x; volatile LAS unsigned* st; };

__device__ __forceinline__ XcdBarrier xcd_barrier_post(unsigned* bar, volatile LAS unsigned* st) {
    XcdBarrier b; b.bar = bar; b.x = xb_xcc_id(); b.st = st;
    if (threadIdx.x == 0) (void)xb_add(&bar[XB_XCNT(b.x)], 1u);
    return b;
}
__device__ __forceinline__ void xcd_barrier_complete(unsigned* bar, unsigned x, unsigned& nloc, unsigned& nx) {
    const unsigned G = gridDim.x * gridDim.y * gridDim.z;
    unsigned sum, cnt, mine, sp = 0u;
    for (;;) {
        sum = 0u; cnt = 0u; mine = 0u;
#pragma unroll
        for (unsigned j = 0; j < 16; ++j) { const unsigned c = xb_ld(&bar[XB_XCNT(j)]); sum += c; cnt += (c > 0u) ? 1u : 0u; mine = (j == x) ? c : mine; }
        if (sum == G) break;
        __builtin_amdgcn_s_sleep(1);
        if ((++sp & 255u) == 0u) { if (xb_ld(&bar[XB_TMO])) break; if (sp > XB_SPIN_CAP) { atomicAdd(&bar[XB_TMO], 1u); break; } }
    }
    nloc = mine > 0u ? mine : 1u; nx = cnt > 0u ? cnt : 1u;
}
__device__ __forceinline__ void xcd_barrier(const XcdBarrier& b) {
    asm volatile("s_waitcnt vmcnt(0)" ::: "memory");
    __syncthreads();
    if (threadIdx.x == 0) {
        unsigned* bar = b.bar;
        __builtin_amdgcn_s_waitcnt(0);
        unsigned nloc = b.st[0], nx = b.st[1];
        if (nloc == 0u) { xcd_barrier_complete(bar, b.x, nloc, nx); b.st[0] = nloc; b.st[1] = nx; }
        const unsigned old = xb_add(&bar[XB_XSUB(b.x)], 1u);
        const unsigned gen = old / nloc;
        if (old + 1u == (gen + 1u) * nloc) {
            __builtin_amdgcn_fence(__ATOMIC_RELEASE, "agent");
            asm volatile("s_waitcnt vmcnt(0)" ::: "memory");
            const unsigned og = xb_add(&bar[XB_TOP], 1u);
            const unsigned tg = og / nx;
            if (og + 1u == (tg + 1u) * nx) xb_add(&bar[XB_TOPGEN], 1u);
            else XB_SPIN(xb_ld(&bar[XB_TOPGEN]) == tg, bar);
            __builtin_amdgcn_fence(__ATOMIC_ACQUIRE, "agent");
            xb_add(&bar[XB_XGEN(b.x)], 1u);
            asm volatile("s_waitcnt vmcnt(0)" ::: "memory");
        } else {
            XB_SPIN(xb_ld(&bar[XB_XGEN(b.x)]) == gen, bar);
            __builtin_amdgcn_fence(__ATOMIC_ACQUIRE, "agent");
            asm volatile("s_waitcnt vmcnt(0)" ::: "memory");
        }
    }
    __syncthreads();
}

struct EpiH {
    static constexpr bool PERM = true, AFTER_DRAIN = false;
    bf16* H; float* Hs;
    __device__ __forceinline__ void operator()(const pg8::f32x4 (&acc)[2][2][4][2], const pg8::Unit& u, int wr, int wc, int fr, int fq) const {
        const int row0 = u.pm * 256 + wr * 64 + fr, col0 = u.pn * 256 + wc * 32 + 8 * fq;
#pragma unroll
        for (int ai = 0; ai < 2; ++ai)
#pragma unroll
            for (int m = 0; m < 4; ++m) {
                const int row = row0 + ai * 128 + m * 16;
#pragma unroll
                for (int bj = 0; bj < 2; ++bj) {
                    const int c = col0 + bj * 128;
                    const pg8::f32x4 v0 = acc[ai][bj][m][0], v1 = acc[ai][bj][m][1];
                    v4u w; w.x = pk2(v0[0], v0[1]); w.y = pk2(v0[2], v0[3]); w.z = pk2(v1[0], v1[1]); w.w = pk2(v1[2], v1[3]);
                    *(v4u*)(H + (size_t)row * HN + c) = w;
                    if (c == H_S || c == H_S + 8) { float* s = Hs + (size_t)row * 16 + (c - H_S); *(pg8::f32x4*)s = v0; *(pg8::f32x4*)(s + 4) = v1; }
                }
            }
    }
};
struct EpiB16 {
    static constexpr bool PERM = true, AFTER_DRAIN = false;
    bf16* O; int ldc;
    __device__ __forceinline__ void operator()(const pg8::f32x4 (&acc)[2][2][4][2], const pg8::Unit& u, int wr, int wc, int fr, int fq) const {
        const int row0 = u.pm * 256 + wr * 64 + fr, col0 = u.pn * 256 + wc * 32 + 8 * fq;
#pragma unroll
        for (int ai = 0; ai < 2; ++ai)
#pragma unroll
            for (int m = 0; m < 4; ++m) {
                const int row = row0 + ai * 128 + m * 16;
#pragma unroll
                for (int bj = 0; bj < 2; ++bj) {
                    const int c = col0 + bj * 128;
                    const pg8::f32x4 v0 = acc[ai][bj][m][0], v1 = acc[ai][bj][m][1];
                    v4u w; w.x = pk2(v0[0], v0[1]); w.y = pk2(v0[2], v0[3]); w.z = pk2(v1[0], v1[1]); w.w = pk2(v1[2], v1[3]);
                    *(v4u*)(O + (size_t)row * ldc + c) = w;
                }
            }
    }
};
struct EpiResid {
    static constexpr bool PERM = false, AFTER_DRAIN = false;
    float* O; int ldc; float alpha;
    __device__ __forceinline__ void operator()(const pg8::f32x4 (&acc)[2][2][4][2], const pg8::Unit& u, int wr, int wc, int fr, int fq) const {
        const int row0 = u.pm * 256 + wr * 64 + fr, col0 = u.pn * 256 + wc * 32 + 4 * fq;
#pragma unroll
        for (int ai = 0; ai < 2; ++ai)
#pragma unroll
            for (int m = 0; m < 4; ++m) {
                float* rowp = O + (size_t)(row0 + ai * 128 + m * 16) * ldc + col0;
#pragma unroll
                for (int bj = 0; bj < 2; ++bj)
#pragma unroll
                    for (int n = 0; n < 2; ++n) {
                        pg8::f32x4* p = (pg8::f32x4*)(rowp + bj * 128 + n * 16);
                        const pg8::f32x4 x = *p;
                        *p = x * alpha + acc[ai][bj][m][n];
                    }
            }
    }
};

struct Args { const float* in[35]; float* out; unsigned char* ws; int lo, hi, li, pad; };
typedef const __attribute__((address_space(4))) Args* KArgs;
__device__ __forceinline__ KArgs kargs() { KArgs p = (KArgs)__builtin_amdgcn_kernarg_segment_ptr(); asm volatile("" : "+s"(p)); return p; }
enum { I_X = 0, I_MEM, I_LNIN_G, I_LNIN_B, I_RELB, I_WIN, I_CAW, I_CAB, I_NAG, I_NAB, I_KVG, I_WUK, I_WUV, I_CMW, I_CMB, I_WQM, I_WKM, I_BI, I_BF, I_NMG,
       I_WOUT, I_LN1G, I_LN1B, I_WCQ, I_WCKV, I_WCO, I_LN2G, I_LN2B, I_WPQ, I_SK1, I_SK2, I_PU, I_PV, I_LN3G, I_LN3B };

__device__ __forceinline__ void tr_item(LAS float* scr, const float* W, int ldw, int k0, int n0, int ncv, bf16* WT, int ldk, int dr0, int kofs, int tid) {
    const int c = tid & 63, r0 = tid >> 6;
#pragma unroll
    for (int i = 0; i < 8; ++i) { const int r = r0 + 8 * i; scr[r * 65 + c] = (c < ncv) ? W[(size_t)(k0 + r) * ldw + n0 + c] : 0.f; }
    __syncthreads();
#pragma unroll
    for (int i = 0; i < 8; ++i) { const int n = r0 + 8 * i; if (n < ncv) WT[(size_t)(dr0 + n) * ldk + kofs + k0 + c] = (bf16)f2bf(scr[c * 65 + n]); }
    __syncthreads();
}
__device__ __forceinline__ void tr_job(LAS float* scr, const float* W, int K, int ldw, int n0, int nc, bf16* WT, int ldk, int dr0, int kofs, int tid, int G, int bid) {
    const int nnt = (nc + 63) / 64, nitems = (K / 64) * nnt;
    for (int it = bid; it < nitems; it += G) {
        const int kt = it / nnt, nt = it % nnt;
        const int ncv = (nc - nt * 64) < 64 ? (nc - nt * 64) : 64;
        tr_item(scr, W, ldw, kt * 64, n0 + nt * 64, ncv, WT, ldk, dr0 + nt * 64, kofs, tid);
    }
}
__device__ __forceinline__ void ln_row(const float* src, const float* g, const float* b, float* dstf, bf16* dstb, int lane) {
    const f32x4* xr = (const f32x4*)src + lane;
    f32x4 v[4]; float s = 0.f;
#pragma unroll
    for (int j = 0; j < 4; ++j) { v[j] = xr[64 * j]; s += (v[j].x + v[j].y) + (v[j].z + v[j].w); }
    const float mean = wave_sum(s) * (1.f / D); float s2 = 0.f;
#pragma unroll
    for (int j = 0; j < 4; ++j) { v[j] = v[j] - mean; s2 += (v[j].x * v[j].x + v[j].y * v[j].y) + (v[j].z * v[j].z + v[j].w * v[j].w); }
    const float rstd = rsqrtf(wave_sum(s2) * (1.f / D) + LN_EPS);
#pragma unroll
    for (int j = 0; j < 4; ++j) {
        const f32x4 gg = ((const f32x4*)g)[lane + 64 * j], bb = ((const f32x4*)b)[lane + 64 * j];
        const f32x4 y = v[j] * rstd * gg + bb;
        ((f32x4*)dstf)[lane + 64 * j] = y;
        v2u o; o.x = pk2(y.x, y.y); o.y = pk2(y.z, y.w);
        ((v2u*)dstb)[lane + 64 * j] = o;
    }
}

__device__ __forceinline__ void p0_prologue(LAS unsigned char* lds, int tid, int G, int bid) {
    LAS float* scr = (LAS float*)lds;
    KArgs ap = kargs();
    unsigned char* ws = ap->ws;
    for (int l = 0; l < 2; ++l) {
        const float* win = ap->in[I_WIN] + (size_t)l * D * WIN_N;
        bf16* WinT = (bf16*)(ws + WS_WIN) + (size_t)l * HN * D;
        tr_job(scr, win, D, WIN_N, 0, 512, WinT, D, H_A, 0, tid, G, bid);
        tr_job(scr, win, D, WIN_N, 1024, 448, WinT, D, H_CB, 0, tid, G, bid);
        tr_job(scr, win, D, WIN_N, 1476, 768, WinT, D, H_XC, 0, tid, G, bid);
        tr_job(scr, win, D, WIN_N, 1472, 4, WinT, D, H_S, 0, tid, G, bid);
        tr_job(scr, win, D, WIN_N, 2244, 8, WinT, D, H_S + 4, 0, tid, G, bid);
        for (int i = bid * 512 + tid; i < (HN - (H_S + 12)) * D; i += G * 512) WinT[(size_t)(H_S + 12) * D + i] = 0;
        const float* wout = ap->in[I_WOUT] + (size_t)l * D * D;
        bf16* WoutT = (bf16*)(ws + WS_WOUT) + (size_t)l * D * CATW;
        tr_job(scr, wout, 256, D, 0, D, WoutT, CATW, 0, CAT_A, tid, G, bid);
        tr_job(scr, wout + (size_t)768 * D, 256, D, 0, D, WoutT, CATW, 0, CAT_C, tid, G, bid);
        tr_job(scr, ap->in[I_WCQ] + (size_t)l * D * D, D, D, 0, D, (bf16*)(ws + WS_WCQ) + (size_t)l * D * D, D, 0, 0, tid, G, bid);
        tr_job(scr, ap->in[I_WCKV] + (size_t)l * D * 2048, D, 2048, 0, 2048, (bf16*)(ws + WS_WCKV) + (size_t)l * 2048 * D, D, 0, 0, tid, G, bid);
        tr_job(scr, ap->in[I_WCO] + (size_t)l * D * D, D, D, 0, D, (bf16*)(ws + WS_WCO) + (size_t)l * D * D, D, 0, 0, tid, G, bid);
        tr_job(scr, ap->in[I_WPQ] + (size_t)l * D * 2048, D, 2048, 0, 2048, (bf16*)(ws + WS_WPQ) + (size_t)l * 2048 * D, D, 0, 0, tid, G, bid);
    }
    {
        LAS float* sa = (LAS float*)lds;
        LAS float* sb = sa + 64 * 65;
        for (int it = bid; it < 2 * 2 * 128; it += G) {
            const int l = it >> 8, kind = (it >> 7) & 1, h = (it >> 4) & 7, tile = it & 15;
            if (kind == 0) {
                const float* win = ap->in[I_WIN] + (size_t)l * D * WIN_N;
                const float* wuk = ap->in[I_WUK] + (size_t)l * 8 * 64 * 128 + (size_t)h * 64 * 128;
                bf16* WinT = (bf16*)(ws + WS_WIN) + (size_t)l * HN * D;
                const int k0 = tile * 64;
                for (int i = tid; i < 4096; i += 512) { const int kk = i >> 6, d = i & 63; sa[kk * 65 + d] = win[(size_t)(k0 + kk) * WIN_N + 512 + h * 64 + d]; }
                for (int i = tid; i < 8192; i += 512) sb[i] = wuk[i];
                __syncthreads();
                for (int i = tid; i < 8192; i += 512) { const int r = i >> 6, kk = i & 63; float s = 0.f;
#pragma unroll 8
                    for (int d = 0; d < 64; ++d) s += sa[kk * 65 + d] * sb[d * 128 + r];
                    WinT[(size_t)(H_QL + h * 128 + r) * D + k0 + kk] = (bf16)f2bf(s); }
                __syncthreads();
            } else {
                const float* wout = ap->in[I_WOUT] + (size_t)l * D * D;
                const float* wuv = ap->in[I_WUV] + (size_t)l * 8 * 128 * 64 + (size_t)h * 128 * 64;
                bf16* WoutT = (bf16*)(ws + WS_WOUT) + (size_t)l * D * CATW;
                const int n0 = tile * 64;
                for (int i = tid; i < 4096; i += 512) { const int d = i >> 6, n = i & 63; sa[d * 65 + n] = wout[(size_t)(256 + h * 64 + d) * D + n0 + n]; }
                for (int i = tid; i < 8192; i += 512) { const int r = i >> 6, d = i & 63; sb[r * 65 + d] = wuv[i]; }
                __syncthreads();
                for (int i = tid; i < 8192; i += 512) { const int n = i >> 7, r = i & 127; float s = 0.f;
#pragma unroll 8
                    for (int d = 0; d < 64; ++d) s += sb[r * 65 + d] * sa[d * 65 + n];
                    WoutT[(size_t)(n0 + n) * CATW + CAT_B + h * 128 + r] = (bf16)f2bf(s); }
                __syncthreads();
            }
        }
    }
    {
        const size_t gt = (size_t)bid * 512 + tid, gs = (size_t)G * 512;
        const f32x4* pu = (const f32x4*)ap->in[I_PU]; const f32x4* pv = (const f32x4*)ap->in[I_PV]; const f32x4* pm = (const f32x4*)ap->in[I_MEM];
        v2u* du = (v2u*)(ws + WS_PU); v2u* dv = (v2u*)(ws + WS_PV); v2u* dm = (v2u*)(ws + WS_MEMB);
        const size_t n4 = (size_t)2 * 16384 * 1024 / 4;
        for (size_t i = gt; i < n4; i += gs) { const f32x4 x = pu[i]; v2u o; o.x = pk2(x.x, x.y); o.y = pk2(x.z, x.w); du[i] = o; }
        for (size_t i = gt; i < n4; i += gs) { const f32x4 x = pv[i]; v2u o; o.x = pk2(x.x, x.y); o.y = pk2(x.z, x.w); dv[i] = o; }
        for (size_t i = gt; i < (size_t)512 * 1024 / 4; i += gs) { const f32x4 x = pm[i]; v2u o; o.x = pk2(x.x, x.y); o.y = pk2(x.z, x.w); dm[i] = o; }
    }
    {
        const int gw = bid * 8 + (tid >> 6), NGW = G * 8, lane = tid & 63;
        for (int m = gw; m < T; m += NGW)
            ln_row(ap->in[I_X] + (size_t)m * D, ap->in[I_LNIN_G], ap->in[I_LNIN_B], ap->out + (size_t)m * D, (bf16*)(ws + WS_XB) + (size_t)m * D, lane);
    }
}

__device__ __forceinline__ void conv_unit(LAS unsigned char* lds, int tile, const bf16* Hb, const float* cw, const float* cb, const float* ng, const float* nb, bf16* CAT, int tid) {
    LAS float* u = (LAS float*)lds;
    LAS float* w = u + 94 * 256;
    const int t0 = tile * 64, pos0 = t0 & (L - 1);
    for (int i = tid; i < 94 * 256; i += 512) {
        const int r = i >> 8, c = i & 255, pos = pos0 - 30 + r; float val = 0.f;
        if (pos >= 0) { const bf16* hr = Hb + (size_t)(t0 - 30 + r) * HN + H_A; const float av = bf2f(hr[c]), gt = bf2f(hr[256 + c]); val = av * sigmoidf_(gt); }
        u[i] = val;
    }
    for (int i = tid; i < 31 * 256; i += 512) w[i] = cw[i];
    __syncthreads();
    const int wave = tid >> 6, lane = tid & 63;
    for (int tt = wave; tt < 64; tt += 8) {
        float acc[4];
#pragma unroll
        for (int i = 0; i < 4; ++i) { const int c = lane + 64 * i; float s = cb[c];
            asm volatile("" ::: "memory");
#pragma unroll 8
            for (int k = 0; k < 31; ++k) s += w[k * 256 + c] * u[(tt + k) * 256 + c];
            acc[i] = s; }
        const float mean = wave_sum((acc[0] + acc[1]) + (acc[2] + acc[3])) * (1.f / 256.f);
        float s2 = 0.f;
#pragma unroll
        for (int i = 0; i < 4; ++i) { acc[i] -= mean; s2 += acc[i] * acc[i]; }
        const float rstd = rsqrtf(wave_sum(s2) * (1.f / 256.f) + LN_EPS);
#pragma unroll
        for (int i = 0; i < 4; ++i) { const int c = lane + 64 * i; const float y = acc[i] * rstd * ng[c] + nb[c];
            CAT[(size_t)(t0 + tt) * CATW + CAT_A + c] = (bf16)f2bf(y * sigmoidf_(y)); }
    }
    __syncthreads();
}

__device__ __forceinline__ unsigned fkey(float f) { const unsigned u = __float_as_uint(f); return (u & 0x80000000u) ? ~u : (u | 0x80000000u); }

__device__ __forceinline__ int block_sum_i(int v, LAS int* red, int tid) {
    v = wave_sum_i(v);
    if ((tid & 63) == 0) red[tid >> 6] = v;
    __syncthreads();
    int s = 0;
#pragma unroll
    for (int i = 0; i < 8; ++i) s += red[i];
    __syncthreads();
    return s;
}
__device__ __forceinline__ int block_excl_scan_i(int v, LAS int* red, int tid, int& tot) {
    const int lane = tid & 63, wave = tid >> 6;
    int inc = v;
#pragma unroll
    for (int o = 1; o < 64; o <<= 1) { const int y = __shfl_up(inc, o); if (lane >= o) inc += y; }
    if (lane == 63) red[wave] = inc;
    __syncthreads();
    int base = 0, t = 0;
#pragma unroll
    for (int i = 0; i < 8; ++i) { const int r = red[i]; if (i < wave) base += r; t += r; }
    __syncthreads();
    tot = t;
    return base + inc - v;
}

__device__ __forceinline__ void indexer_query(LAS unsigned char* lds, int t, const bf16* Hb, const float* Hs, unsigned short* SEL, int* NSEL, int tid) {
    LAS unsigned* keys = (LAS unsigned*)lds;
    LAS float* qi = (LAS float*)(lds + 32768);
    LAS int* red = (LAS int*)(lds + 32768 + 1024);
    const int b = t >> 13, pos = t & (L - 1), n = pos + 1;
    if (tid < 256) qi[tid] = bf2f(Hb[(size_t)t * HN + H_QI + tid]);
    const float w0 = Hs[(size_t)t * 16 + 0] * 0.5f, w1 = Hs[(size_t)t * 16 + 1] * 0.5f, w2 = Hs[(size_t)t * 16 + 2] * 0.5f, w3 = Hs[(size_t)t * 16 + 3] * 0.5f;
    __syncthreads();
    for (int s = tid; s < n; s += 512) {
        const bf16* kr = Hb + (size_t)(b * L + s) * HN + H_KI;
        float d0 = 0.f, d1 = 0.f, d2 = 0.f, d3 = 0.f;
#pragma unroll 1
        for (int c = 0; c < 64; c += 8) {
            asm volatile("" ::: "memory");
            const v4u kk = *(const v4u*)(kr + c);
            float kf[8] = { lo16(kk.x), hi16(kk.x), lo16(kk.y), hi16(kk.y), lo16(kk.z), hi16(kk.z), lo16(kk.w), hi16(kk.w) };
#pragma unroll
            for (int j = 0; j < 8; ++j) { d0 += qi[c + j] * kf[j]; d1 += qi[64 + c + j] * kf[j]; d2 += qi[128 + c + j] * kf[j]; d3 += qi[192 + c + j] * kf[j]; }
        }
        float sc = 0.f;
        sc += w0 * fmaxf(d0 * 0.125f, 0.f); sc += w1 * fmaxf(d1 * 0.125f, 0.f); sc += w2 * fmaxf(d2 * 0.125f, 0.f); sc += w3 * fmaxf(d3 * 0.125f, 0.f);
        keys[s] = fkey(sc);
    }
    __syncthreads();
    if (n <= 256) {
        for (int s = tid; s < n; s += 512) SEL[(size_t)t * 256 + s] = (unsigned short)s;
        if (tid == 0) NSEL[t] = n;
        __syncthreads();
        return;
    }
    unsigned prefix = 0u;
    for (int bit = 31; bit >= 0; --bit) {
        const unsigned cand = prefix | (1u << bit);
        int c = 0;
        for (int s = tid; s < n; s += 512) c += (keys[s] >= cand) ? 1 : 0;
        c = block_sum_i(c, red, tid);
        if (c >= 256) prefix = cand;
    }
    int ng = 0, nt = 0;
#pragma unroll
    for (int j = 0; j < 16; ++j) { const int s = tid * 16 + j; if (s < n) { const unsigned k = keys[s]; ng += (k > prefix) ? 1 : 0; nt += (k == prefix) ? 1 : 0; } }
    int totg, tott;
    int eg = block_excl_scan_i(ng, red, tid, totg);
    int et = block_excl_scan_i(nt, red, tid, tott);
    const int quota = 256 - totg;
#pragma unroll
    for (int j = 0; j < 16; ++j) { const int s = tid * 16 + j; if (s < n) { const unsigned k = keys[s];
        if (k > prefix) { SEL[(size_t)t * 256 + eg] = (unsigned short)s; ++eg; }
        else if (k == prefix) { if (et < quota) SEL[(size_t)t * 256 + totg + et] = (unsigned short)s; ++et; } } }
    if (tid == 0) NSEL[t] = 256;
    __syncthreads();
}

typedef short bf16x8s __attribute__((ext_vector_type(8)));
typedef float f32x16 __attribute__((ext_vector_type(16)));
constexpr int IDX_ROWW = 1025;
constexpr int IDX_CTL = 131072 + 512;

template <int PASS>
__device__ __forceinline__ void idx_pass(LAS unsigned char* lds, const bf16* Hb, int b, int si, int wave, int lane,
                                         const bf16x8s (&Qb)[4][4], const float (&wq)[4], unsigned short* SEL) {
    LAS unsigned* hist = (LAS unsigned*)lds;
    LAS unsigned* cB1 = (LAS unsigned*)(lds + IDX_CTL);
    LAS unsigned* cT22 = cB1 + 64;
    LAS unsigned* cCnt = cB1 + 128;
    const int r = lane & 31, h = lane >> 5;
    const int qpos = si * 32 + r;
    const unsigned myB1 = (PASS >= 2) ? cB1[r] : 0u;
    const unsigned myT = (PASS == 3) ? cT22[r] : 0u;
    bf16x8s ka[4];
    {
        const bf16* kp = Hb + (size_t)(b * L + wave * 32 + r) * HN + H_KI + 8 * h;
        if (wave <= si) {
#pragma unroll
            for (int s = 0; s < 4; ++s) ka[s] = *(const bf16x8s*)(kp + 16 * s);
        }
    }
    for (int kt = wave; kt <= si; kt += 8) {
        bf16x8s kn[4];
        const bool more = (kt + 8 <= si);
        if (more) {
            const bf16* kp = Hb + (size_t)(b * L + (kt + 8) * 32 + r) * HN + H_KI + 8 * h;
#pragma unroll
            for (int s = 0; s < 4; ++s) kn[s] = *(const bf16x8s*)(kp + 16 * s);
        }
        float sc[16];
#pragma unroll
        for (int i = 0; i < 16; ++i) sc[i] = 0.f;
#pragma unroll
        for (int hh = 0; hh < 4; ++hh) {
            f32x16 acc;
#pragma unroll
            for (int i = 0; i < 16; ++i) acc[i] = 0.f;
#pragma unroll
            for (int s = 0; s < 4; ++s) acc = __builtin_amdgcn_mfma_f32_32x32x16_bf16(ka[s], Qb[hh][s], acc, 0, 0, 0);
#pragma unroll
            for (int i = 0; i < 16; ++i) sc[i] += wq[hh] * fmaxf(acc[i], 0.f);
        }
        const bool diag = (kt == si);
#pragma unroll
        for (int i = 0; i < 16; ++i) {
            const int ko = (i & 3) + 8 * (i >> 2) + 4 * h;
            const bool valid = !diag || (ko <= r);
            const unsigned key = fkey(sc[i]);
            if (PASS == 1) {
                if (valid) { const unsigned bin = key >> 21; __hip_atomic_fetch_add(hist + r * IDX_ROWW + (bin >> 1), (bin & 1u) ? 65536u : 1u, __ATOMIC_RELAXED, __HIP_MEMORY_SCOPE_WORKGROUP); }
            } else if (PASS == 2) {
                if (valid && (key >> 21) == myB1) { const unsigned bin = (key >> 10) & 2047u; __hip_atomic_fetch_add(hist + r * IDX_ROWW + (bin >> 1), (bin & 1u) ? 65536u : 1u, __ATOMIC_RELAXED, __HIP_MEMORY_SCOPE_WORKGROUP); }
            } else {
                const unsigned k22 = key >> 10;
                const int kpos = kt * 32 + ko;
                if (valid) {
                    if (myB1 == 0xffffffffu || k22 > myT) {
                        __hip_atomic_fetch_or(hist + r * 256 + (kpos >> 5), 1u << (kpos & 31), __ATOMIC_RELAXED, __HIP_MEMORY_SCOPE_WORKGROUP);
                    } else if (k22 == myT) {
                        __hip_atomic_fetch_or(hist + 8192 + r * 256 + (kpos >> 5), 1u << (kpos & 31), __ATOMIC_RELAXED, __HIP_MEMORY_SCOPE_WORKGROUP);
                    }
                }
            }
        }
        if (more) {
#pragma unroll
            for (int s = 0; s < 4; ++s) ka[s] = kn[s];
        }
    }
}

__device__ __forceinline__ void idx_find(LAS unsigned* hist, int q, int need, int lane, unsigned& Bout, int& aboveOut, bool& found) {
    const LAS unsigned* row = hist + q * IDX_ROWW + 16 * lane;
    unsigned wv[16]; int own = 0;
#pragma unroll
    for (int i = 0; i < 16; ++i) { wv[i] = row[i]; own += (int)(wv[i] & 0xffffu) + (int)(wv[i] >> 16); }
    int suf = own;
#pragma unroll
    for (int o = 1; o < 64; o <<= 1) { const int y = __shfl_down(suf, o); if (lane + o < 64) suf += y; }
    const int above = suf - own;
    const bool here = (above < need) && (suf >= need);
    unsigned B = 0u; int ab = 0; bool f = false; int a = above;
#pragma unroll
    for (int i = 15; i >= 0; --i) {
        const int hi = (int)(wv[i] >> 16), lo = (int)(wv[i] & 0xffffu);
        if (!f && a + hi >= need) { B = 32u * lane + 2u * i + 1u; ab = a; f = true; }
        a += hi;
        if (!f && a + lo >= need) { B = 32u * lane + 2u * i; ab = a; f = true; }
        a += lo;
    }
    const unsigned long long m = __ballot(here);
    found = (m != 0ull);
    const int src = found ? (__ffsll((long long)m) - 1) : 0;
    Bout = (unsigned)__shfl((int)B, src); aboveOut = __shfl(ab, src);
}

__device__ __forceinline__ void indexer_strip(LAS unsigned char* lds, int b, int si, const bf16* Hb, const float* Hs, unsigned short* SEL, int* NSEL, int tid) {
    LAS unsigned* hist = (LAS unsigned*)lds;
    LAS unsigned* cB1 = (LAS unsigned*)(lds + IDX_CTL);
    LAS unsigned* cT22 = cB1 + 64;
    LAS unsigned* cCnt = cB1 + 128;
    LAS unsigned* cAb = cB1 + 192;
    const int lane = tid & 63, wave = __builtin_amdgcn_readfirstlane(tid >> 6);
    const int r = lane & 31, h = lane >> 5;
    const int t = b * L + si * 32 + r;
    bf16x8s Qb[4][4]; float wq[4];
#pragma unroll
    for (int hh = 0; hh < 4; ++hh) {
        wq[hh] = Hs[(size_t)t * 16 + hh] * 0.0625f;
#pragma unroll
        for (int s = 0; s < 4; ++s) Qb[hh][s] = *(const bf16x8s*)(Hb + (size_t)t * HN + H_QI + hh * 64 + 16 * s + 8 * h);
    }
    for (int i = tid; i < 32 * IDX_ROWW; i += 512) hist[i] = 0u;
    __syncthreads();
    idx_pass<1>(lds, Hb, b, si, wave, lane, Qb, wq, SEL);
    __syncthreads();
    for (int qq = 0; qq < 4; ++qq) {
        const int q = wave * 4 + qq; unsigned B; int ab; bool f;
        idx_find(hist, q, 256, lane, B, ab, f);
        if (lane == 0) { cB1[q] = f ? B : 0xffffffffu; cAb[q] = f ? (unsigned)ab : 0u; cCnt[q] = 0u; }
    }
    __syncthreads();
    for (int i = tid; i < 32 * IDX_ROWW; i += 512) hist[i] = 0u;
    __syncthreads();
    idx_pass<2>(lds, Hb, b, si, wave, lane, Qb, wq, SEL);
    __syncthreads();
    for (int qq = 0; qq < 4; ++qq) {
        const int q = wave * 4 + qq; unsigned B; int ab; bool f;
        const unsigned b1 = cB1[q]; const int ab1 = (int)cAb[q];
        idx_find(hist, q, 256 - ab1, lane, B, ab, f);
        if (lane == 0 && b1 != 0xffffffffu) { cT22[q] = (b1 << 11) | B; cAb[q] = (unsigned)(ab1 + ab); }
    }
    __syncthreads();
    for (int i = tid; i < 2 * 32 * 256; i += 512) hist[i] = 0u;
    __syncthreads();
    idx_pass<3>(lds, Hb, b, si, wave, lane, Qb, wq, SEL);
    __syncthreads();
    for (int qq = 0; qq < 4; ++qq) {
        const int q = wave * 4 + qq;
        const int tq = b * L + si * 32 + q;
        const bool takeall = (cB1[q] == 0xffffffffu);
        int base = 0;
#pragma unroll 1
        for (int part = 0; part < 2; ++part) {
            unsigned w4[4]; int own = 0;
#pragma unroll
            for (int i = 0; i < 4; ++i) { w4[i] = hist[part * 8192 + q * 256 + 4 * lane + i]; own += __popc(w4[i]); }
            int inc = own;
#pragma unroll
            for (int o = 1; o < 64; o <<= 1) { const int y = __shfl_up(inc, o); if (lane >= o) inc += y; }
            int rank = base + inc - own;
#pragma unroll
            for (int i = 0; i < 4; ++i) {
                unsigned w = w4[i];
                while (w) { const int bit = __ffs((int)w) - 1; w &= w - 1u;
                    if (rank < 256) SEL[(size_t)tq * 256 + rank] = (unsigned short)(128 * lane + 32 * i + bit);
                    ++rank; }
            }
            base += __shfl(inc, 63);
            if (takeall) break;
        }
        if (lane == 0) NSEL[tq] = takeall ? (si * 32 + q + 1) : 256;
    }
    __syncthreads();
}

__device__ __forceinline__ float logsigmoidf_(float x) { return fminf(x, 0.f) - log1pf(__expf(-fabsf(x))); }

__device__ __forceinline__ void mlstm_prep_unit(LAS unsigned char* lds, int cidx, const bf16* Hb, const float* Hs, const float* cmw, const float* cmb, const float* wqm, const float* wkm,
                                                const float* bi, const float* bfp, float* MQ, float* MK, float* MC, float* MN, float* SCL, float* BC, float* IG, int tid) {
    const int j = cidx & 127, h = (cidx >> 7) & 3, b = cidx >> 9, t0 = b * L + j * 64;
    LAS float* xc = (LAS float*)lds;
    LAS float* wq = xc + 64 * 65;
    LAS float* wk = wq + 4096;
    LAS float* kt = wk + 4096;
    LAS float* vt = kt + 64 * 65;
    LAS float* wg = vt + 64 * 65;
    for (int i = tid; i < 4096; i += 512) {
        const int s = i >> 6, d = i & 63, c = h * 64 + d; float av = cmb[c];
#pragma unroll
        for (int k = 0; k < 4; ++k) { const int pos = j * 64 + s - 3 + k; if (pos >= 0) av += cmw[k * 256 + c] * bf2f(Hb[(size_t)(b * L + pos) * HN + H_XC + c]); }
        xc[s * 65 + d] = av * sigmoidf_(av);
        wq[i] = wqm[h * 4096 + i]; wk[i] = wkm[h * 4096 + i];
        vt[s * 65 + d] = bf2f(Hb[(size_t)(t0 + s) * HN + H_V + c]);
    }
    __syncthreads();
    for (int i = tid; i < 4096; i += 512) {
        const int s = i >> 6, e = i & 63; float aq = 0.f, ak = 0.f;
#pragma unroll 8
        for (int d = 0; d < 64; ++d) { const float x = xc[s * 65 + d]; aq += x * wq[d * 64 + e]; ak += x * wk[d * 64 + e]; }
        MQ[(size_t)(t0 + s) * 256 + h * 64 + e] = aq * 0.125f; MK[(size_t)(t0 + s) * 256 + h * 64 + e] = ak; kt[s * 65 + e] = ak;
    }
    if (tid < 64) {
        const int s = tid, t = t0 + s;
        const float fl = logsigmoidf_(Hs[(size_t)t * 16 + 8 + h] + bfp[h]);
        const float ig = Hs[(size_t)t * 16 + 4 + h] + bi[h];
        float bs = fl;
#pragma unroll
        for (int o = 1; o < 64; o <<= 1) { const float y = __shfl_up(bs, o); if (s >= o) bs += y; }
        const float bL = __shfl(bs, 63);
        const float g = bL - bs + ig;
        const float mloc = wave_max(g);
        wg[s] = __expf(g - mloc);
        BC[(size_t)t * 4 + h] = bs; IG[(size_t)t * 4 + h] = ig;
        if (s == 0) { SCL[cidx * 4 + 0] = mloc; SCL[cidx * 4 + 1] = bL; }
    }
    __syncthreads();
    for (int i = tid; i < 4096; i += 512) {
        const int v = i >> 6, k = i & 63; float s2 = 0.f;
#pragma unroll 8
        for (int s = 0; s < 64; ++s) s2 += wg[s] * vt[s * 65 + v] * kt[s * 65 + k];
        MC[(size_t)cidx * 4096 + i] = s2;
    }
    if (tid < 64) { float s2 = 0.f;
        for (int s = 0; s < 64; ++s) s2 += wg[s] * kt[s * 65 + tid];
        MN[(size_t)cidx * 64 + tid] = s2; }
    __syncthreads();
}

__device__ __forceinline__ void mlstm_scan(int gtid, float* MC, float* MN, float* SCL) {
    const int stream = gtid / 4160, e = gtid - stream * 4160;
    if (stream >= 8) return;
    float* base = (e < 4096) ? (MC + e) : (MN + (e - 4096));
    const size_t stride = (e < 4096) ? 4096 : 64;
    float m = 0.f, C = 0.f;
    for (int j0 = 0; j0 < 128; j0 += 8) {
        float loc[8], ml[8], bl[8];
#pragma unroll
        for (int u = 0; u < 8; ++u) { const int cidx = stream * 128 + j0 + u; loc[u] = base[(size_t)cidx * stride]; ml[u] = SCL[cidx * 4 + 0]; bl[u] = SCL[cidx * 4 + 1]; }
#pragma unroll
        for (int u = 0; u < 8; ++u) {
            const int cidx = stream * 128 + j0 + u;
            const float mn = fmaxf(bl[u] + m, ml[u]);
            const float a = __expf(bl[u] + m - mn), c = __expf(ml[u] - mn);
            base[(size_t)cidx * stride] = C;
            if (e == 0) SCL[cidx * 4 + 2] = m;
            C = a * C + c * loc[u]; m = mn;
        }
    }
}

__device__ __forceinline__ int rel_bucket(int dist) {
    const int d = dist > 0 ? dist : 0;
    if (d < 16) return d;
    const int large = 16 + (int)(logf((float)d / 16.f) / 2.0794415416798357f * 16.f);
    return large < 31 ? large : 31;
}

__device__ __forceinline__ void dsa_attn_query(LAS unsigned char* wl, int t, const bf16* Hb, const bf16* CKV, const unsigned short* SEL, const int* NSEL, const float* relb, bf16* CAT, int lane) {
    LAS float* ql = (LAS float*)wl;
    LAS float* P = ql + 1024;
    LAS int* sl = (LAS int*)(P + 2048);
    const int b = t >> 13, pos = t & (L - 1), n = NSEL[t];
    for (int i = lane; i < 1024; i += 64) ql[i] = bf2f(Hb[(size_t)t * HN + H_QL + i]);
    for (int i = lane; i < 256; i += 64) sl[i] = (i < n) ? (int)SEL[(size_t)t * 256 + i] : 0;
    WAVE_LDS_SYNC();
    float lg[4][8];
#pragma unroll
    for (int i = 0; i < 4; ++i) {
        const int kk = lane + 64 * i;
        float acc[8];
#pragma unroll
        for (int h = 0; h < 8; ++h) acc[h] = 0.f;
        const int s = sl[kk];
        const bf16* cr = CKV + (size_t)(b * L + s) * 128;
        for (int c = 0; c < 128; c += 8) {
            const v4u cv = *(const v4u*)(cr + c);
            const float cf[8] = { lo16(cv.x), hi16(cv.x), lo16(cv.y), hi16(cv.y), lo16(cv.z), hi16(cv.z), lo16(cv.w), hi16(cv.w) };
#pragma unroll
            for (int h = 0; h < 8; ++h) {
#pragma unroll
                for (int jj = 0; jj < 8; ++jj) acc[h] += ql[h * 128 + c + jj] * cf[jj];
            }
        }
        const int bk = rel_bucket(pos - s);
#pragma unroll
        for (int h = 0; h < 8; ++h) lg[i][h] = (kk < n) ? (acc[h] * 0.125f + relb[bk * 8 + h]) : -INFINITY;
    }
#pragma unroll
    for (int h = 0; h < 8; ++h) {
        const float mx = wave_max(fmaxf(fmaxf(lg[0][h], lg[1][h]), fmaxf(lg[2][h], lg[3][h])));
        float e[4], sm = 0.f;
#pragma unroll
        for (int i = 0; i < 4; ++i) { e[i] = (lane + 64 * i < n) ? __expf(lg[i][h] - mx) : 0.f; sm += e[i]; }
        const float inv = 1.f / wave_sum(sm);
#pragma unroll
        for (int i = 0; i < 4; ++i) P[h * 256 + lane + 64 * i] = e[i] * inv;
    }
    WAVE_LDS_SYNC();
    float o[8][2];
#pragma unroll
    for (int h = 0; h < 8; ++h) { o[h][0] = 0.f; o[h][1] = 0.f; }
    for (int kk = 0; kk < n; ++kk) {
        const int s = sl[kk];
        const bf16* cr = CKV + (size_t)(b * L + s) * 128;
        const float c0 = bf2f(cr[lane]), c1 = bf2f(cr[64 + lane]);
#pragma unroll
        for (int h = 0; h < 8; ++h) { const float p = P[h * 256 + kk]; o[h][0] += p * c0; o[h][1] += p * c1; }
    }
#pragma unroll
    for (int h = 0; h < 8; ++h) {
        CAT[(size_t)t * CATW + CAT_B + h * 128 + lane] = (bf16)f2bf(o[h][0]);
        CAT[(size_t)t * CATW + CAT_B + h * 128 + 64 + lane] = (bf16)f2bf(o[h][1]);
    }
    WAVE_LDS_SYNC();
}

__device__ __forceinline__ void mlstm_out_unit(LAS unsigned char* lds, int cidx, const bf16* Hb, const float* MQ, const float* MK, const float* MC, const float* MN, const float* SCL,
                                               const float* BC, const float* IG, const float* nmg, bf16* CAT, int tid) {
    const int j = cidx & 127, h = (cidx >> 7) & 3, b = cidx >> 9, t0 = b * L + j * 64;
    LAS float* q = (LAS float*)lds;
    LAS float* k = q + 64 * 65;
    LAS float* v = k + 64 * 65;
    LAS float* C = v + 64 * 65;
    LAS float* S = C + 64 * 65;
    LAS float* hh = S + 64 * 65;
    LAS float* nn = hh + 64 * 65;
    LAS float* bb = nn + 64;
    LAS float* gi = bb + 64;
    LAS float* mrow = gi + 64;
    LAS float* den = mrow + 64;
    for (int i = tid; i < 4096; i += 512) {
        const int s = i >> 6, d = i & 63;
        q[s * 65 + d] = MQ[(size_t)(t0 + s) * 256 + h * 64 + d];
        k[s * 65 + d] = MK[(size_t)(t0 + s) * 256 + h * 64 + d];
        v[s * 65 + d] = bf2f(Hb[(size_t)(t0 + s) * HN + H_V + h * 64 + d]);
        C[s * 65 + d] = MC[(size_t)cidx * 4096 + i];
    }
    if (tid < 64) { nn[tid] = MN[(size_t)cidx * 64 + tid]; bb[tid] = BC[(size_t)(t0 + tid) * 4 + h]; gi[tid] = IG[(size_t)(t0 + tid) * 4 + h]; }
    const float m_in = SCL[cidx * 4 + 2];
    __syncthreads();
    if (tid < 64) {
        const int t = tid; const float bt = bb[t]; float rm = -INFINITY;
        for (int s = 0; s <= t; ++s) rm = fmaxf(rm, bt - bb[s] + gi[s]);
        mrow[t] = fmaxf(bt + m_in, rm);
    }
    __syncthreads();
    for (int i = tid; i < 4096; i += 512) {
        const int t = i >> 6, s = i & 63; float a = 0.f;
        if (s <= t) {
#pragma unroll 8
            for (int d = 0; d < 64; ++d) a += q[t * 65 + d] * k[s * 65 + d];
            a *= __expf(bb[t] - bb[s] + gi[s] - mrow[t]);
        }
        S[t * 65 + s] = a;
    }
    __syncthreads();
    if (tid < 64) {
        const int t = tid; float a = 0.f, nq = 0.f;
        for (int s = 0; s < 64; ++s) a += S[t * 65 + s];
        for (int d = 0; d < 64; ++d) nq += nn[d] * q[t * 65 + d];
        const float wi = __expf(bb[t] + m_in - mrow[t]);
        const float dn = a + wi * nq;
        den[t] = fmaxf(fabsf(dn), __expf(-mrow[t]));
    }
    __syncthreads();
    for (int i = tid; i < 4096; i += 512) {
        const int t = i >> 6, vv = i & 63; float a = 0.f, cq = 0.f;
#pragma unroll 8
        for (int s = 0; s < 64; ++s) a += S[t * 65 + s] * v[s * 65 + vv];
#pragma unroll 8
        for (int d = 0; d < 64; ++d) cq += C[vv * 65 + d] * q[t * 65 + d];
        const float wi = __expf(bb[t] + m_in - mrow[t]);
        hh[t * 65 + vv] = (a + wi * cq) / den[t];
    }
    __syncthreads();
    {
        const int wave = tid >> 6, lane = tid & 63;
        for (int t = wave; t < 64; t += 8) {
            const float x = hh[t * 65 + lane];
            const float mean = wave_sum(x) * (1.f / 64.f);
            const float dx = x - mean;
            const float var = wave_sum(dx * dx) * (1.f / 64.f);
            const float y = dx * rsqrtf(var + LN_EPS) * nmg[h * 64 + lane];
            const float og = bf2f(Hb[(size_t)(t0 + t) * HN + H_O + h * 64 + lane]);
            CAT[(size_t)(t0 + t) * CATW + CAT_C + h * 64 + lane] = (bf16)f2bf(sigmoidf_(og) * y);
        }
    }
    __syncthreads();
}

__device__ __forceinline__ void xattn_token(LAS unsigned char* wl, int t, const bf16* QX, const bf16* KV, bf16* OX, int lane) {
    LAS float* qs = (LAS float*)wl;
    LAS float* P = qs + 256;
    const int b = t >> 13;
    const bf16* kvb = KV + (size_t)b * 256 * 2048;
    for (int h = 0; h < 4; ++h) {
        for (int i = lane; i < 256; i += 64) qs[i] = bf2f(QX[(size_t)t * D + h * 256 + i]);
        WAVE_LDS_SYNC();
        float lg[4];
#pragma unroll
        for (int i = 0; i < 4; ++i) {
            const int m = lane + 64 * i;
            const bf16* kr = kvb + (size_t)m * 2048 + h * 256;
            float a = 0.f;
            for (int c = 0; c < 256; c += 8) {
                const v4u kk = *(const v4u*)(kr + c);
                a += lo16(kk.x) * qs[c] + hi16(kk.x) * qs[c + 1] + lo16(kk.y) * qs[c + 2] + hi16(kk.y) * qs[c + 3] + lo16(kk.z) * qs[c + 4] + hi16(kk.z) * qs[c + 5] + lo16(kk.w) * qs[c + 6] + hi16(kk.w) * qs[c + 7];
            }
            lg[i] = a * 0.0625f;
        }
        const float mx = wave_max(fmaxf(fmaxf(lg[0], lg[1]), fmaxf(lg[2], lg[3])));
        float e[4], sm = 0.f;
#pragma unroll
        for (int i = 0; i < 4; ++i) { e[i] = __expf(lg[i] - mx); sm += e[i]; }
        const float inv = 1.f / wave_sum(sm);
#pragma unroll
        for (int i = 0; i < 4; ++i) P[lane + 64 * i] = e[i] * inv;
        WAVE_LDS_SYNC();
        float o[4] = { 0.f, 0.f, 0.f, 0.f };
        for (int m = 0; m < 256; ++m) {
            const float p = P[m];
            const bf16* vr = kvb + (size_t)m * 2048 + 1024 + h * 256;
#pragma unroll
            for (int i = 0; i < 4; ++i) o[i] += p * bf2f(vr[lane + 64 * i]);
        }
#pragma unroll
        for (int i = 0; i < 4; ++i) OX[(size_t)t * D + h * 256 + lane + 64 * i] = (bf16)f2bf(o[i]);
        WAVE_LDS_SYNC();
    }
}

__device__ __forceinline__ unsigned cvt_pk_bf16_(float lo, float hi) { unsigned r; asm volatile("v_cvt_pk_bf16_f32 %0, %1, %2" : "=v"(r) : "v"(lo), "v"(hi)); return r; }
typedef unsigned u32x4_ __attribute__((ext_vector_type(4)));
__device__ __forceinline__ void xattn_unit(int unit, const bf16* QX, const bf16* Kb, const bf16* VT, bf16* OX, int lane) {
    const int strip = unit >> 2, hd = unit & 3;
    const int t0 = strip * 32, b = t0 >> 13;
    const int r = lane & 31, h = lane >> 5;
    const int sig = 16 * ((r >> 2) & 1) + 4 * (r >> 3) + (r & 3);
    bf16x8s Qf[16];
    {
        const bf16* qp = QX + (size_t)(t0 + r) * D + hd * 256 + 16 * h;
#pragma unroll
        for (int p = 0; p < 8; ++p) { Qf[2 * p] = *(const bf16x8s*)(qp + 32 * p); Qf[2 * p + 1] = *(const bf16x8s*)(qp + 32 * p + 8); }
    }
    f32x16 S[8];
#pragma unroll
    for (int kb = 0; kb < 8; ++kb) {
#pragma unroll
        for (int i = 0; i < 16; ++i) S[kb][i] = 0.f;
        const bf16* kp = Kb + (size_t)(b * 256 + kb * 32 + sig) * D + hd * 256 + 16 * h;
#pragma unroll
        for (int p = 0; p < 8; ++p) {
            if ((p & 3) == 0) asm volatile("" ::: "memory");
            const bf16x8s k0 = *(const bf16x8s*)(kp + 32 * p), k1 = *(const bf16x8s*)(kp + 32 * p + 8);
            S[kb] = __builtin_amdgcn_mfma_f32_32x32x16_bf16(k0, Qf[2 * p], S[kb], 0, 0, 0);
            S[kb] = __builtin_amdgcn_mfma_f32_32x32x16_bf16(k1, Qf[2 * p + 1], S[kb], 0, 0, 0);
        }
    }
    float mx = -INFINITY;
#pragma unroll
    for (int kb = 0; kb < 8; ++kb)
#pragma unroll
        for (int i = 0; i < 16; ++i) mx = fmaxf(mx, S[kb][i]);
    mx = fmaxf(mx, __shfl_xor(mx, 32));
    const float c = 0.0625f * 1.4426950408889634f;
    float sum = 0.f;
    bf16x8s Pf[16];
#pragma unroll
    for (int kb = 0; kb < 8; ++kb) {
#pragma unroll
        for (int i = 0; i < 16; ++i) { const float e = __builtin_amdgcn_exp2f((S[kb][i] - mx) * c); S[kb][i] = e; sum += e; }
#pragma unroll
        for (int s2 = 0; s2 < 2; ++s2) {
            u32x4_ w;
            w.x = cvt_pk_bf16_(S[kb][8 * s2 + 0], S[kb][8 * s2 + 1]); w.y = cvt_pk_bf16_(S[kb][8 * s2 + 2], S[kb][8 * s2 + 3]);
            w.z = cvt_pk_bf16_(S[kb][8 * s2 + 4], S[kb][8 * s2 + 5]); w.w = cvt_pk_bf16_(S[kb][8 * s2 + 6], S[kb][8 * s2 + 7]);
            Pf[2 * kb + s2] = __builtin_bit_cast(bf16x8s, w);
        }
    }
    sum += __shfl_xor(sum, 32);
    const float inv = 1.f / sum;
    bf16* op = OX + (size_t)(t0 + r) * D + hd * 256 + 4 * h;
#pragma unroll
    for (int db = 0; db < 8; ++db) {
        f32x16 O;
#pragma unroll
        for (int i = 0; i < 16; ++i) O[i] = 0.f;
        const bf16* vp = VT + (size_t)(hd * 256 + db * 32 + r) * 512 + b * 256 + 16 * h;
#pragma unroll
        for (int kb = 0; kb < 8; ++kb) {
            if ((kb & 3) == 0) asm volatile("" ::: "memory");
            const bf16x8s v0 = *(const bf16x8s*)(vp + 32 * kb), v1 = *(const bf16x8s*)(vp + 32 * kb + 8);
            O = __builtin_amdgcn_mfma_f32_32x32x16_bf16(v0, Pf[2 * kb], O, 0, 0, 0);
            O = __builtin_amdgcn_mfma_f32_32x32x16_bf16(v1, Pf[2 * kb + 1], O, 0, 0, 0);
        }
#pragma unroll
        for (int g = 0; g < 4; ++g) {
            v2u w; w.x = pk2(O[4 * g] * inv, O[4 * g + 1] * inv); w.y = pk2(O[4 * g + 2] * inv, O[4 * g + 3] * inv);
            *(v2u*)(op + db * 32 + 8 * g) = w;
        }
    }
}

typedef short s16x4 __attribute__((ext_vector_type(4)));
__device__ __forceinline__ unsigned off_b(unsigned row, unsigned ch) { return 256u * row + 16u * (ch ^ (((row & 3u) << 2) | ((row >> 2) & 3u))); }
constexpr int DSA_TILE = 8192;
__device__ __forceinline__ void dsa_fill(LAS unsigned char* tile, const LAS int* slb, const bf16* ckv_b, int ck, int lane) {
    const int pos = lane & 15;
#pragma unroll
    for (int i = 0; i < 8; ++i) {
        const int row = 4 * i + (lane >> 4);
        const int s = slb[ck * 32 + row] & 0xffff;
        const unsigned ch = (unsigned)pos ^ ((((unsigned)row & 3u) << 2) | (((unsigned)row >> 2) & 3u));
        __builtin_amdgcn_global_load_lds((const unsigned*)(ckv_b + (size_t)s * 128 + ch * 8), (LAS unsigned*)(tile + i * 1024), 16, 0, 0);
    }
}
__device__ __forceinline__ void dsa_attn_mfma(LAS unsigned char* wl, LAS int* slb, const LAS float* relb_l, int t, const bf16* Hb, const bf16* CKV,
                                              const unsigned short* SEL, const int* NSEL, bf16* CAT, int lane) {
    const int hd = lane & 15, G = lane >> 4;
    const int b = t >> 13, pos = t & (L - 1), n = NSEL[t];
    const bf16* ckv_b = CKV + (size_t)b * L * 128;
    for (int i = lane; i < 256; i += 64) { const int s = (i < n) ? (int)SEL[(size_t)t * 256 + i] : 0; slb[i] = s | (rel_bucket(pos - s) << 16); }
    bf16x8s Qf[4];
#pragma unroll
    for (int s = 0; s < 4; ++s) {
        if (hd < 8) Qf[s] = *(const bf16x8s*)(Hb + (size_t)t * HN + H_QL + hd * 128 + 32 * s + 8 * G);
        else {
#pragma unroll
            for (int j = 0; j < 8; ++j) Qf[s][j] = 0;
        }
    }
    WAVE_LDS_SYNC();
    const int nch = (n + 31) >> 5;
    dsa_fill(wl, slb, ckv_b, 0, lane);
    float m = -INFINITY, lsum = 0.f;
    f32x4 O[8];
#pragma unroll
    for (int c = 0; c < 8; ++c) O[c] = (f32x4){0.f, 0.f, 0.f, 0.f};
    const unsigned q4 = (unsigned)(lane & 15) >> 2, p4 = (unsigned)lane & 3u;
    for (int ck = 0; ck < nch; ++ck) {
        LAS unsigned char* tile = wl + (ck & 1) * DSA_TILE;
        WAVE_LDS_SYNC();
        if (ck + 1 < nch) { dsa_fill(wl + ((ck + 1) & 1) * DSA_TILE, slb, ckv_b, ck + 1, lane); asm volatile("s_waitcnt vmcnt(8)" ::: "memory"); }
        else asm volatile("s_waitcnt vmcnt(0)" ::: "memory");
        f32x4 acc[2];
#pragma unroll
        for (int rb = 0; rb < 2; ++rb) {
            acc[rb] = (f32x4){0.f, 0.f, 0.f, 0.f};
#pragma unroll
            for (int s = 0; s < 4; ++s) {
                const bf16x8s A = *(const LAS bf16x8s*)(tile + off_b((unsigned)hd + 16u * rb, 4u * s + (unsigned)G));
                acc[rb] = __builtin_amdgcn_mfma_f32_16x16x32_bf16(A, Qf[s], acc[rb], 0, 0, 0);
            }
        }
        float lg[8]; float cm = -INFINITY;
#pragma unroll
        for (int rb = 0; rb < 2; ++rb)
#pragma unroll
            for (int rg = 0; rg < 4; ++rg) {
                const int kk = ck * 32 + 16 * rb + 4 * G + rg;
                const int e = slb[kk];
                const float bias = relb_l[(e >> 16) * 8 + (hd & 7)];
                const float v = (hd < 8) ? (acc[rb][rg] * 0.125f + bias) : 0.f;
                lg[4 * rb + rg] = (kk < n) ? v : -INFINITY;
                cm = fmaxf(cm, lg[4 * rb + rg]);
            }
        cm = fmaxf(cm, __shfl_xor(cm, 16)); cm = fmaxf(cm, __shfl_xor(cm, 32));
        const float mn = fmaxf(m, cm);
        const float scale = __expf(m - mn);
        float ps = 0.f;
#pragma unroll
        for (int j = 0; j < 8; ++j) { lg[j] = __expf(lg[j] - mn); ps += lg[j]; }
        ps += __shfl_xor(ps, 16); ps += __shfl_xor(ps, 32);
        lsum = lsum * scale + ps; m = mn;
        u32x4_ pw; pw.x = cvt_pk_bf16_(lg[0], lg[1]); pw.y = cvt_pk_bf16_(lg[2], lg[3]); pw.z = cvt_pk_bf16_(lg[4], lg[5]); pw.w = cvt_pk_bf16_(lg[6], lg[7]);
        const bf16x8s Pf = __builtin_bit_cast(bf16x8s, pw);
#pragma unroll
        for (int c = 0; c < 8; ++c) {
            const s16x4 c0 = __builtin_amdgcn_ds_read_tr16_b64_v4i16((LAS s16x4*)(tile + off_b(4u * G + q4, 2u * c + (p4 >> 1)) + 8u * (p4 & 1u)));
            const s16x4 c1 = __builtin_amdgcn_ds_read_tr16_b64_v4i16((LAS s16x4*)(tile + off_b(16u + 4u * G + q4, 2u * c + (p4 >> 1)) + 8u * (p4 & 1u)));
            bf16x8s A; A[0] = c0[0]; A[1] = c0[1]; A[2] = c0[2]; A[3] = c0[3]; A[4] = c1[0]; A[5] = c1[1]; A[6] = c1[2]; A[7] = c1[3];
            O[c] = O[c] * scale;
            O[c] = __builtin_amdgcn_mfma_f32_16x16x32_bf16(A, Pf, O[c], 0, 0, 0);
        }
    }
    const float inv = 1.f / lsum;
    if (hd < 8) {
        bf16* op = CAT + (size_t)t * CATW + CAT_B + hd * 128 + 4 * G;
#pragma unroll
        for (int c = 0; c < 8; ++c) { v2u w; w.x = pk2(O[c][0] * inv, O[c][1] * inv); w.y = pk2(O[c][2] * inv, O[c][3] * inv); *(v2u*)(op + 16 * c) = w; }
    }
    WAVE_LDS_SYNC();
}

__device__ __forceinline__ void wave_top16_128(float v0, float v1, int lane, float& tv, int& ti) {
    tv = -INFINITY; ti = 0;
    for (int r = 0; r < 16; ++r) {
        const float m = wave_max(fmaxf(v0, v1));
        const unsigned long long b0 = __ballot(v0 == m);
        int idx;
        if (b0) idx = __ffsll((long long)b0) - 1;
        else { const unsigned long long b1 = __ballot(v1 == m); idx = 64 + __ffsll((long long)b1) - 1; }
        if (lane == r) { tv = m; ti = idx; }
        if (lane == (idx & 63)) { if (idx < 64) v0 = -INFINITY; else v1 = -INFINITY; }
    }
}
__device__ __forceinline__ float gelu_exact(float x) { return 0.5f * x * (1.f + erff(x * 0.70710678118654752f)); }

__device__ __forceinline__ void peer_token(LAS unsigned char* wl, const LAS bf16* sk1, const LAS bf16* sk2, int t, const bf16* QP, const bf16* PU, const bf16* PV,
                                           const float* g3, const float* b3, float* xio, bf16* XB, int lane) {
    LAS bf16* qs = (LAS bf16*)wl;
    LAS int* el = (LAS int*)(wl + 4096);
    LAS float* gl = (LAS float*)(wl + 4096 + 512);
    for (int i = lane; i < 256; i += 64) ((LAS v4u*)qs)[i] = ((const v4u*)(QP + (size_t)t * 2048))[i];
    WAVE_LDS_SYNC();
    for (int hh = 0; hh < 8; ++hh) {
        float s1a = 0.f, s1b = 0.f, s2a = 0.f, s2b = 0.f;
        for (int c = 0; c < 128; c += 8) {
            const v4u q1 = *(const LAS v4u*)(qs + hh * 256 + c), q2 = *(const LAS v4u*)(qs + hh * 256 + 128 + c);
            s1a += dot8bb(*(const LAS v4u*)(sk1 + lane * 136 + c), q1);
            s1b += dot8bb(*(const LAS v4u*)(sk1 + (lane + 64) * 136 + c), q1);
            s2a += dot8bb(*(const LAS v4u*)(sk2 + lane * 136 + c), q2);
            s2b += dot8bb(*(const LAS v4u*)(sk2 + (lane + 64) * 136 + c), q2);
        }
        float tv1, tv2; int ti1, ti2;
        wave_top16_128(s1a, s1b, lane, tv1, ti1);
        wave_top16_128(s2a, s2b, lane, tv2, ti2);
        float cd[4];
#pragma unroll
        for (int i = 0; i < 4; ++i) cd[i] = __shfl(tv1, (lane >> 4) + 4 * i) + __shfl(tv2, lane & 15);
        float tv = -INFINITY; int ti = 0;
        for (int r = 0; r < 16; ++r) {
            const float m = wave_max(fmaxf(fmaxf(cd[0], cd[1]), fmaxf(cd[2], cd[3])));
            int idx = -1;
#pragma unroll
            for (int i = 0; i < 4; ++i) { const unsigned long long bq = __ballot(cd[i] == m); if (idx < 0 && bq) idx = 64 * i + __ffsll((long long)bq) - 1; }
            if (lane == r) { tv = m; ti = idx; }
#pragma unroll
            for (int i = 0; i < 4; ++i) if (idx == lane + 64 * i) cd[i] = -INFINITY;
        }
        const float mx = __shfl(tv, 0);
        const float ex = (lane < 16) ? __expf(tv - mx) : 0.f;
        const float inv = 1.f / wave_sum(ex);
        const int e1 = __shfl(ti1, ti >> 4), e2 = __shfl(ti2, ti & 15);
        if (lane < 16) { el[hh * 16 + lane] = e1 * 128 + e2; gl[hh * 16 + lane] = ex * inv; }
    }
    WAVE_LDS_SYNC();
    float xa[8], xb[8];
    {
        const f32x4* xr = (const f32x4*)(xio + (size_t)t * D);
        const f32x4 a0 = xr[2 * lane], a1 = xr[2 * lane + 1], c0 = xr[128 + 2 * lane], c1 = xr[128 + 2 * lane + 1];
        xa[0] = a0.x; xa[1] = a0.y; xa[2] = a0.z; xa[3] = a0.w; xa[4] = a1.x; xa[5] = a1.y; xa[6] = a1.z; xa[7] = a1.w;
        xb[0] = c0.x; xb[1] = c0.y; xb[2] = c0.z; xb[3] = c0.w; xb[4] = c1.x; xb[5] = c1.y; xb[6] = c1.z; xb[7] = c1.w;
    }
    float oa[8], ob[8];
#pragma unroll
    for (int i = 0; i < 8; ++i) { oa[i] = 0.f; ob[i] = 0.f; }
    const bool b5 = (lane & 32) != 0, b4 = (lane & 16) != 0, b3b = (lane & 8) != 0;
    for (int e0 = 0; e0 < 128; e0 += 8) {
        float p[8];
#pragma unroll
        for (int r = 0; r < 8; ++r) {
            const int id = el[e0 + r];
            const bf16* row = PU + (size_t)id * D;
            const v4u ua = *(const v4u*)(row + 8 * lane), ub = *(const v4u*)(row + 512 + 8 * lane);
            p[r] = dot8(ua, xa) + dot8(ub, xb);
        }
        float q4[4], r2[2], s;
#pragma unroll
        for (int i = 0; i < 4; ++i) { const float send = b5 ? p[i] : p[i + 4]; const float recv = __shfl_xor(send, 32); q4[i] = (b5 ? p[i + 4] : p[i]) + recv; }
#pragma unroll
        for (int i = 0; i < 2; ++i) { const float send = b4 ? q4[i] : q4[i + 2]; const float recv = __shfl_xor(send, 16); r2[i] = (b4 ? q4[i + 2] : q4[i]) + recv; }
        { const float send = b3b ? r2[0] : r2[1]; const float recv = __shfl_xor(send, 8); s = (b3b ? r2[1] : r2[0]) + recv; }
        s += __shfl_xor(s, 4); s += __shfl_xor(s, 2); s += __shfl_xor(s, 1);
        const int mine = (lane >> 3) & 7;
        const float coef = gelu_exact(s) * gl[e0 + mine];
#pragma unroll
        for (int r = 0; r < 8; ++r) {
            const float cr = __shfl(coef, r * 8);
            const int id = el[e0 + r];
            const bf16* row = PV + (size_t)id * D;
            const v4u va = *(const v4u*)(row + 8 * lane), vb = *(const v4u*)(row + 512 + 8 * lane);
            oa[0] += cr * lo16(va.x); oa[1] += cr * hi16(va.x); oa[2] += cr * lo16(va.y); oa[3] += cr * hi16(va.y);
            oa[4] += cr * lo16(va.z); oa[5] += cr * hi16(va.z); oa[6] += cr * lo16(va.w); oa[7] += cr * hi16(va.w);
            ob[0] += cr * lo16(vb.x); ob[1] += cr * hi16(vb.x); ob[2] += cr * lo16(vb.y); ob[3] += cr * hi16(vb.y);
            ob[4] += cr * lo16(vb.z); ob[5] += cr * hi16(vb.z); ob[6] += cr * lo16(vb.w); ob[7] += cr * hi16(vb.w);
        }
    }
    float s1 = 0.f;
#pragma unroll
    for (int i = 0; i < 8; ++i) { oa[i] = ALPHA * xa[i] + oa[i]; ob[i] = ALPHA * xb[i] + ob[i]; s1 += oa[i] + ob[i]; }
    const float mean = wave_sum(s1) * (1.f / D);
    float s2 = 0.f;
#pragma unroll
    for (int i = 0; i < 8; ++i) { oa[i] -= mean; ob[i] -= mean; s2 += oa[i] * oa[i] + ob[i] * ob[i]; }
    const float rstd = rsqrtf(wave_sum(s2) * (1.f / D) + LN_EPS);
    {
        const f32x4* gr = (const f32x4*)g3; const f32x4* br = (const f32x4*)b3;
        f32x4* xo = (f32x4*)(xio + (size_t)t * D);
        v4u* xbo = (v4u*)(XB + (size_t)t * D);
        const f32x4 g0 = gr[2 * lane], g1 = gr[2 * lane + 1], g2 = gr[128 + 2 * lane], g3v = gr[128 + 2 * lane + 1];
        const f32x4 c0 = br[2 * lane], c1 = br[2 * lane + 1], c2 = br[128 + 2 * lane], c3 = br[128 + 2 * lane + 1];
        f32x4 y0, y1, y2, y3;
        y0.x = oa[0] * rstd * g0.x + c0.x; y0.y = oa[1] * rstd * g0.y + c0.y; y0.z = oa[2] * rstd * g0.z + c0.z; y0.w = oa[3] * rstd * g0.w + c0.w;
        y1.x = oa[4] * rstd * g1.x + c1.x; y1.y = oa[5] * rstd * g1.y + c1.y; y1.z = oa[6] * rstd * g1.z + c1.z; y1.w = oa[7] * rstd * g1.w + c1.w;
        y2.x = ob[0] * rstd * g2.x + c2.x; y2.y = ob[1] * rstd * g2.y + c2.y; y2.z = ob[2] * rstd * g2.z + c2.z; y2.w = ob[3] * rstd * g2.w + c2.w;
        y3.x = ob[4] * rstd * g3v.x + c3.x; y3.y = ob[5] * rstd * g3v.y + c3.y; y3.z = ob[6] * rstd * g3v.z + c3.z; y3.w = ob[7] * rstd * g3v.w + c3.w;
        xo[2 * lane] = y0; xo[2 * lane + 1] = y1; xo[128 + 2 * lane] = y2; xo[128 + 2 * lane + 1] = y3;
        v4u w0, w1;
        w0.x = pk2(y0.x, y0.y); w0.y = pk2(y0.z, y0.w); w0.z = pk2(y1.x, y1.y); w0.w = pk2(y1.z, y1.w);
        w1.x = pk2(y2.x, y2.y); w1.y = pk2(y2.z, y2.w); w1.z = pk2(y3.x, y3.y); w1.w = pk2(y3.z, y3.w);
        xbo[lane] = w0; xbo[64 + lane] = w1;
    }
    WAVE_LDS_SYNC();
}

constexpr int PH_PER_LAYER = 12, NPH = 1 + 2 * PH_PER_LAYER;

#define PHASE_ENV() KArgs ap = kargs(); unsigned char* const ws = ap->ws; const int tid = threadIdx.x, lane = tid & 63, wave = __builtin_amdgcn_readfirstlane(tid >> 6); \
    const int G = gridDim.x, bid = blockIdx.x; (void)ws; (void)lane; (void)wave; (void)G; (void)bid
#define P_XB   ((bf16*)(ws + WS_XB))
#define P_HB   ((bf16*)(ws + WS_HB))
#define P_HS   ((float*)(ws + WS_HS))
#define P_CAT  ((bf16*)(ws + WS_CAT))
#define P_CKV  ((bf16*)(ws + WS_CKV))
#define P_SEL  ((unsigned short*)(ws + WS_SEL))
#define P_NSEL ((int*)(ws + WS_NSEL))
#define P_MQ   ((float*)(ws + WS_MQ))
#define P_MK   ((float*)(ws + WS_MK))
#define P_MC   ((float*)(ws + WS_MC))
#define P_MN   ((float*)(ws + WS_MN))
#define P_SCL  ((float*)(ws + WS_SCL))
#define P_BC   ((float*)(ws + WS_BC))
#define P_IG   ((float*)(ws + WS_IG))
#define P_QX   ((bf16*)(ws + WS_QX))
#define P_OX   ((bf16*)(ws + WS_OX))
#define P_QP   ((bf16*)(ws + WS_QP))

#ifndef ONLYSITE
#define SITE(j) true
#else
#define SITE(j) ((j) == ONLYSITE)
#endif
#define IN(k) (lo <= (k) && (k) < hi)
#define SEAM(k) do { if (IN(k) && IN((k) + 1)) xcd_barrier(bar); } while (0)


template <int l>
__device__ __forceinline__ void run_layer(LAS unsigned char* lds, const int lo, const int hi, const XcdBarrier& bar) {
        const int pb = 1 + PH_PER_LAYER * l;
        if (IN(pb + 0) && SITE(1)) {
            PHASE_ENV();
            {
                pg8::Gemm g{P_XB, (const bf16*)(ws + WS_WIN) + (size_t)l * HN * D, T, HN, D}; pg8::StaticOrder S; S.init(T, HN, G, bid);
                EpiH E{P_HB, P_HS};
                pg8::gemm_phase<EpiH, pg8::StaticOrder, true, true>(lds, g, S, E);
            }
            if (l == 0) {
                for (int l2 = 0; l2 < 2; ++l2) {
                    __syncthreads();
                    {
                        pg8::Gemm g2{(const bf16*)(ws + WS_MEMB), (const bf16*)(ws + WS_WCKV) + (size_t)l2 * 2048 * D, 512, 1024, D}; pg8::StaticOrder S2; S2.init(512, 1024, G, bid);
                        EpiB16 E2{(bf16*)(ws + WS_KV) + (size_t)l2 * 512 * 1024, 1024};
                        pg8::gemm_phase<EpiB16, pg8::StaticOrder, true, true>(lds, g2, S2, E2);
                    }
                    __syncthreads();
                    {
                        pg8::Gemm g3{(const bf16*)(ws + WS_WCKV) + (size_t)l2 * 2048 * D + (size_t)1024 * D, (const bf16*)(ws + WS_MEMB), 1024, 512, D}; pg8::StaticOrder S3; S3.init(1024, 512, G, bid);
                        EpiB16 E3{(bf16*)(ws + WS_KV) + (size_t)(2 + l2) * 512 * 1024, 512};
                        pg8::gemm_phase<EpiB16, pg8::StaticOrder, true, true>(lds, g3, S3, E3);
                    }
                }
            }
        }
        SEAM(pb + 0);
        if (IN(pb + 1) && SITE(2)) {
            PHASE_ENV();
#ifndef SUBMASK
#define SUBMASK 15
#endif
            if (SUBMASK & 1) for (int tile = bid; tile < T / 64; tile += G)
                conv_unit(lds, tile, P_HB, ap->in[I_CAW] + (size_t)l * 31 * 256, ap->in[I_CAB] + l * 256, ap->in[I_NAG] + l * 256, ap->in[I_NAB] + l * 256, P_CAT, tid);
            if (SUBMASK & 2) {
                const float* kg = ap->in[I_KVG] + l * 128; const bf16* HB = P_HB; bf16* CKV = P_CKV;
                for (int t = bid * 8 + wave; t < T; t += G * 8) {
                    const float c0 = bf2f(HB[(size_t)t * HN + H_CB + lane]), c1 = bf2f(HB[(size_t)t * HN + H_CB + 64 + lane]);
                    const float r = rsqrtf(wave_sum(c0 * c0 + c1 * c1) * (1.f / 128.f) + LN_EPS);
                    CKV[(size_t)t * 128 + lane] = (bf16)f2bf(c0 * r * kg[lane]); CKV[(size_t)t * 128 + 64 + lane] = (bf16)f2bf(c1 * r * kg[64 + lane]);
                }
            }
            if (SUBMASK & 4) for (int cidx = bid; cidx < NCHUNK; cidx += G)
                mlstm_prep_unit(lds, cidx, P_HB, P_HS, ap->in[I_CMW] + (size_t)l * 4 * 256, ap->in[I_CMB] + l * 256, ap->in[I_WQM] + (size_t)l * 4 * 4096, ap->in[I_WKM] + (size_t)l * 4 * 4096,
                                ap->in[I_BI] + l * 4, ap->in[I_BF] + l * 4, P_MQ, P_MK, P_MC, P_MN, P_SCL, P_BC, P_IG, tid);
#ifdef NAIVE_INDEXER
            if (SUBMASK & 8) for (int t = bid; t < T; t += G) indexer_query(lds, t, P_HB, P_HS, P_SEL, P_NSEL, tid);
#else
            if (SUBMASK & 8) for (int pr = bid; pr < 256; pr += G) {
                const int b = pr >> 7, i0 = pr & 127;
                indexer_strip(lds, b, 255 - i0, P_HB, P_HS, P_SEL, P_NSEL, tid);
                indexer_strip(lds, b, i0, P_HB, P_HS, P_SEL, P_NSEL, tid);
            }
#endif
        }
        SEAM(pb + 1);
        if (IN(pb + 2) && SITE(3)) {
            PHASE_ENV();
            if (bid < 65) mlstm_scan(bid * 512 + tid, P_MC, P_MN, P_SCL);
#ifdef NAIVE_DSA
            for (int t = bid * 8 + wave; t < T; t += G * 8) dsa_attn_query(lds + wave * 16384, t, P_HB, P_CKV, P_SEL, P_NSEL, ap->in[I_RELB], P_CAT, lane);
#else
            {
                LAS float* relb_l = (LAS float*)(lds + 131072 + 1024);
                if (tid < 256) relb_l[tid] = ap->in[I_RELB][tid];
                __syncthreads();
                LAS int* slb = (LAS int*)(lds + 131072 + 2048 + wave * 1024);
                for (int t = bid * 8 + wave; t < T; t += G * 8) dsa_attn_mfma(lds + wave * 16384, slb, relb_l, t, P_HB, P_CKV, P_SEL, P_NSEL, P_CAT, lane);
            }
#endif
        }
        SEAM(pb + 2);
        if (IN(pb + 3) && SITE(4)) {
            PHASE_ENV();
            for (int cidx = bid; cidx < NCHUNK; cidx += G)
                mlstm_out_unit(lds, cidx, P_HB, P_MQ, P_MK, P_MC, P_MN, P_SCL, P_BC, P_IG, ap->in[I_NMG] + l * 256, P_CAT, tid);
        }
        SEAM(pb + 3);
        if (IN(pb + 4) && SITE(5)) {
            PHASE_ENV();
            pg8::Gemm g{P_CAT, (const bf16*)(ws + WS_WOUT) + (size_t)l * D * CATW, T, D, CATW}; pg8::StaticOrder S; S.init(T, D, G, bid);
            EpiResid E{ap->out, D, ALPHA};
            pg8::gemm_phase<EpiResid, pg8::StaticOrder, true, true>(lds, g, S, E);
        }
        SEAM(pb + 4);
        if (IN(pb + 5) && SITE(6)) {
            PHASE_ENV();
            float* X = ap->out; bf16* XB = P_XB; const float* g1 = ap->in[I_LN1G] + l * D; const float* b1 = ap->in[I_LN1B] + l * D;
            for (int m = bid * 8 + wave; m < T; m += G * 8) ln_row(X + (size_t)m * D, g1, b1, X + (size_t)m * D, XB + (size_t)m * D, lane);
        }
        SEAM(pb + 5);
        if (IN(pb + 6) && SITE(7)) {
            PHASE_ENV();
            pg8::Gemm g{P_XB, (const bf16*)(ws + WS_WCQ) + (size_t)l * D * D, T, D, D}; pg8::StaticOrder S; S.init(T, D, G, bid);
            EpiB16 E{P_QX, D};
            pg8::gemm_phase<EpiB16, pg8::StaticOrder, true, true>(lds, g, S, E);
        }
        SEAM(pb + 6);
        if (IN(pb + 7) && SITE(8)) {
            PHASE_ENV();
            const bf16* Kb = (const bf16*)(ws + WS_KV) + (size_t)l * 512 * 1024; const bf16* VT = (const bf16*)(ws + WS_KV) + (size_t)(2 + l) * 512 * 1024;
            for (int u = bid * 8 + wave; u < 2048; u += G * 8) xattn_unit(u, P_QX, Kb, VT, P_OX, lane);
        }
        SEAM(pb + 7);
        if (IN(pb + 8) && SITE(9)) {
            PHASE_ENV();
            pg8::Gemm g{P_OX, (const bf16*)(ws + WS_WCO) + (size_t)l * D * D, T, D, D}; pg8::StaticOrder S; S.init(T, D, G, bid);
            EpiResid E{ap->out, D, ALPHA};
            pg8::gemm_phase<EpiResid, pg8::StaticOrder, true, true>(lds, g, S, E);
        }
        SEAM(pb + 8);
        if (IN(pb + 9) && SITE(10)) {
            PHASE_ENV();
            float* X = ap->out; bf16* XB = P_XB; const float* g2 = ap->in[I_LN2G] + l * D; const float* b2 = ap->in[I_LN2B] + l * D;
            for (int m = bid * 8 + wave; m < T; m += G * 8) ln_row(X + (size_t)m * D, g2, b2, X + (size_t)m * D, XB + (size_t)m * D, lane);
        }
        SEAM(pb + 9);
        if (IN(pb + 10) && SITE(11)) {
            PHASE_ENV();
            pg8::Gemm g{P_XB, (const bf16*)(ws + WS_WPQ) + (size_t)l * 2048 * D, T, 2048, D}; pg8::StaticOrder S; S.init(T, 2048, G, bid);
            EpiB16 E{P_QP, 2048};
            pg8::gemm_phase<EpiB16, pg8::StaticOrder, true, true>(lds, g, S, E);
        }
        SEAM(pb + 10);
        if (IN(pb + 11) && SITE(12)) {
            PHASE_ENV();
            LAS bf16* sk1 = (LAS bf16*)lds; LAS bf16* sk2 = sk1 + 128 * 136;
            const float* k1 = ap->in[I_SK1] + (size_t)l * 128 * 128; const float* k2 = ap->in[I_SK2] + (size_t)l * 128 * 128;
            for (int i = tid; i < 128 * 128; i += 512) { const int n = i >> 7, d = i & 127; sk1[n * 136 + d] = (bf16)f2bf(k1[i]); sk2[n * 136 + d] = (bf16)f2bf(k2[i]); }
            __syncthreads();
            const bf16* PU = (const bf16*)(ws + WS_PU) + (size_t)l * 16384 * D; const bf16* PV = (const bf16*)(ws + WS_PV) + (size_t)l * 16384 * D;
            for (int t = bid * 8 + wave; t < T; t += G * 8)
                peer_token(lds + 69632 + wave * 5120, sk1, sk2, t, P_QP, PU, PV, ap->in[I_LN3G] + l * D, ap->in[I_LN3B] + l * D, ap->out, P_XB, lane);
            __syncthreads();
        }
        SEAM(pb + 11);
}

__global__ void __launch_bounds__(512, 2) fwd(Args a_unused) {
    extern __shared__ __attribute__((aligned(16))) unsigned char lds_raw[];
    LAS unsigned char* lds = (LAS unsigned char*)lds_raw;
    volatile LAS unsigned* MISC = (volatile LAS unsigned*)(lds + MISC_OFF);
    if (threadIdx.x < 32) MISC[threadIdx.x] = 0u;
    __syncthreads();
    int lo, hi;
    XcdBarrier bar;
    { KArgs ap = kargs(); lo = ap->lo; hi = ap->hi; bar = xcd_barrier_post((unsigned*)(ap->ws + WS_CTL) + 4096 + ap->li * XCD_BAR_WORDS, MISC + 8); }
    if (IN(0) && SITE(0)) { p0_prologue(lds, threadIdx.x, gridDim.x, blockIdx.x); }
    SEAM(0);

    run_layer<0>(lds, lo, hi, bar);
    run_layer<1>(lds, lo, hi, bar);
#undef IN
#undef SEAM
}

extern "C" void kernel_launch(void* const* d_in, const int* in_sizes, int n_in, void* d_out, int out_size, void* d_ws, size_t ws_size, hipStream_t stream) {
    static int grid = 0;
    if (grid == 0) {
        if (n_in != 35 || out_size != T * D || ws_size < WS_END) { fprintf(stderr, "kernel_launch: unexpected shapes (n_in %d, out %d, ws %zu)\n", n_in, out_size, ws_size); grid = -1; return; }
        int dev = 0, cus = 0, per_cu = 0;
        if (hipGetDevice(&dev) != hipSuccess || hipDeviceGetAttribute(&cus, hipDeviceAttributeMultiprocessorCount, dev) != hipSuccess) { grid = -1; return; }
        if (hipFuncSetAttribute((const void*)fwd, hipFuncAttributeMaxDynamicSharedMemorySize, LDS_BYTES) != hipSuccess) { fprintf(stderr, "kernel_launch: hipFuncSetAttribute failed\n"); grid = -1; return; }
        if (hipOccupancyMaxActiveBlocksPerMultiprocessor(&per_cu, (const void*)fwd, 512, LDS_BYTES) != hipSuccess || per_cu < 1) fprintf(stderr, "kernel_launch: occupancy query reports %d\n", per_cu);
        (void)hipGetLastError();
        grid = cus;
    }
    if (grid < 0) return;
    (void)hipMemsetAsync((char*)d_ws + WS_CTL, 0, CTL_ZERO_BYTES, stream);
    Args a{};
    for (int i = 0; i < 35; ++i) a.in[i] = (const float*)d_in[i];
    a.out = (float*)d_out; a.ws = (unsigned char*)d_ws;
#if MK_SINGLE
    a.lo = 0; a.hi = NPH; a.li = 0; a.pad = 0;
    hipLaunchKernelGGL(fwd, dim3(grid), dim3(512), LDS_BYTES, stream, a);
#else
    for (int p = 0; p < NPH; ++p) { a.lo = p; a.hi = p + 1; a.li = 0; a.pad = 0; hipLaunchKernelGGL(fwd, dim3(grid), dim3(512), LDS_BYTES, stream, a); }
#endif
}
```

```cpp
#include <hip/hip_runtime.h>
#include <cstdio>
#include <cstdint>
namespace pg8 {
#define PG8_LAS __attribute__((address_space(3)))
typedef unsigned short bf16_t;
typedef short bf16x8 __attribute__((ext_vector_type(8)));
typedef float f32x4 __attribute__((ext_vector_type(4)));
typedef unsigned u32x4 __attribute__((ext_vector_type(4)));
constexpr int BM = 256, BK = 64, HALF = 128, HTB = HALF * BK * 2  , STAGE_BYTES = 8 * HTB, NXCD = 8, WGM = 8;

__host__ __device__ __forceinline__ int lds_byte(int r, int c) { const int st = (r >> 4) * 2 + (c >> 5), rr = r & 15, cc = c & 31, ob = rr * 64 + cc * 2; return st * 1024 + (ob ^ (((ob >> 9) & 1) << 5)); }
__host__ __device__ __forceinline__ void stage_rc(int b, int& R, int& C) { const int st = b / 1024, sb = b % 1024, swz = sb ^ (((sb >> 9) & 1) << 5); R = (st >> 1) * 16 + swz / 64; C = (st & 1) * 32 + (swz % 64) / 2; }
__host__ __device__ __forceinline__ int perm32(int rho) { const int n = rho >> 4, i = rho & 15; return 8 * (i >> 2) + 4 * n + (i & 3); }

struct Unit { int pm, pn; };
struct Gemm { const bf16_t* A; const bf16_t* Bt; int M, N, K; };

struct StaticOrder {
    int nM, nN, nwg, G, c;
    __host__ __device__ void init(int M, int N, int G_, int c_) { nM = M / BM; nN = N / BM; nwg = nM * nN; G = G_; c = c_; }
    __host__ __device__ bool next(int i, Unit& u) const {
        const long L = (long)i * G + c; if (L >= nwg) return false;
        int wgid = (int)L; { const int q = nwg / NXCD, r = nwg % NXCD, xcd = wgid % NXCD, off = wgid / NXCD; wgid = (xcd < r ? xcd * (q + 1) : r * (q + 1) + (xcd - r) * q) + off; }
        const int nig = WGM * nN, gid = wgid / nig, fm = gid * WGM, gsz = (nM - fm) < WGM ? (nM - fm) : WGM;
        u.pm = fm + ((wgid % nig) % gsz); u.pn = (wgid % nig) / gsz; return true;
    }
    __device__ __forceinline__ void a_ready(const Unit&) const {}
    __device__ __forceinline__ void done(const Unit&) const {}
};
__device__ __forceinline__ unsigned cvt_pk_bf16(float lo, float hi) { unsigned r; asm volatile("v_cvt_pk_bf16_f32 %0, %1, %2" : "=v"(r) : "v"(lo), "v"(hi)); return r; }
template <class Epi, class Sched, bool ALIGN_EPI = false, bool SP2 = false>
__device__ __forceinline__ void gemm_phase(PG8_LAS unsigned char* lds, const Gemm g, const Sched& S, const Epi& E) {
    const int tid = threadIdx.x, wid = __builtin_amdgcn_readfirstlane(tid >> 6), lane = tid & 63, wr = wid >> 2, wc = wid & 3, fr = lane & 15, fq = lane >> 4;
    const int K = g.K, nt = K / BK;
    unsigned voffA[2], voffB[2];
#pragma unroll
    for (int i = 0; i < 2; ++i) { int R, C; stage_rc(tid * 16 + i * 8192, R, C); const int Rb = Epi::PERM ? ((R & ~31) + perm32(R & 31)) : R;
        voffA[i] = (unsigned)(R * K + C) * 2u; voffB[i] = (unsigned)(Rb * K + C) * 2u; }
    const size_t kstep = (size_t)(BK * 2);
    const size_t hstep = (size_t)HALF * K * 2;
    const size_t tstep = 2 * hstep;
    const unsigned ldsw = (unsigned)wid * 1024u;
    const int aoff = lds_byte(wr * 64 + fr, fq * 8), boff = lds_byte(wc * 32 + fr, fq * 8);
#define PG8_SA(b, h) (((b) * 2 + (h)) * HTB)
#define PG8_SB(b, h) ((4 + (b) * 2 + (h)) * HTB)
#define PG8_STAGE(bufoff, gbase, voff) do { _Pragma("unroll") for (int _i = 0; _i < 2; ++_i) \
        __builtin_amdgcn_global_load_lds((const unsigned*)((const char*)(gbase) + (voff)[_i]), (PG8_LAS unsigned*)(lds + (bufoff) + ldsw + _i * 8192), 16, 0, 0); } while (0)
#define PG8_LDA(dst, b, h) do { _Pragma("unroll") for (int m = 0; m < 4; ++m) _Pragma("unroll") for (int k = 0; k < 2; ++k) dst[m][k] = *(const PG8_LAS bf16x8*)(lds + PG8_SA(b, h) + aoff + m * 2048 + k * 1024); } while (0)
#define PG8_LDB(dst, b, h) do { _Pragma("unroll") for (int n = 0; n < 2; ++n) _Pragma("unroll") for (int k = 0; k < 2; ++k) dst[n][k] = *(const PG8_LAS bf16x8*)(lds + PG8_SB(b, h) + boff + n * 2048 + k * 1024); } while (0)
#define PG8_MMA(ai, bj, At, Bt) do { __builtin_amdgcn_s_setprio(1); _Pragma("unroll") for (int m = 0; m < 4; ++m) _Pragma("unroll") for (int n = 0; n < 2; ++n) _Pragma("unroll") for (int k = 0; k < 2; ++k) \
        acc[ai][bj][m][n] = __builtin_amdgcn_mfma_f32_16x16x32_bf16(Bt[n][k], At[m][k], acc[ai][bj][m][n], 0, 0, 0); __builtin_amdgcn_s_setprio(0); } while (0)
#define PG8_WAIT_V(n) asm volatile("s_waitcnt vmcnt(" #n ")" ::: "memory")
#define PG8_WAIT_L(n) asm volatile("s_waitcnt lgkmcnt(" #n ")" ::: "memory")
#define PG8_BAR __builtin_amdgcn_s_barrier()
#define PG8_SCHED __builtin_amdgcn_sched_barrier(0)
    Unit cur, nxt; int ui = 0;
    if (!S.next(0, cur)) return;
    f32x4 acc[2][2][4][2];
#pragma unroll
    for (int a = 0; a < 2; ++a)
#pragma unroll
        for (int b = 0; b < 2; ++b)
#pragma unroll
            for (int m = 0; m < 4; ++m)
#pragma unroll
                for (int n = 0; n < 2; ++n) acc[a][b][m][n] = (f32x4){0.f, 0.f, 0.f, 0.f};
    bf16x8 At[4][2], B0[2][2], B1[2][2];
    const char* cA = (const char*)g.A + (size_t)cur.pm * tstep; const char* cB = (const char*)g.Bt + (size_t)cur.pn * tstep;
    S.a_ready(cur);
    if constexpr (SP2) {
        PG8_STAGE(PG8_SB(0, 0), cB, voffB); PG8_STAGE(PG8_SB(0, 1), cB + hstep, voffB); PG8_STAGE(PG8_SA(0, 0), cA, voffA); PG8_STAGE(PG8_SA(0, 1), cA + hstep, voffA);
        if (wr == 1) PG8_BAR;
        PG8_WAIT_V(2); PG8_BAR;
        PG8_STAGE(PG8_SB(1, 0), cB + kstep, voffB); PG8_STAGE(PG8_SA(1, 0), cA + kstep, voffA); PG8_STAGE(PG8_SB(1, 1), cB + hstep + kstep, voffB);
        PG8_WAIT_V(6); PG8_BAR;
    } else {
        PG8_STAGE(PG8_SB(0, 0), cB, voffB); PG8_STAGE(PG8_SA(0, 0), cA, voffA); PG8_STAGE(PG8_SB(0, 1), cB + hstep, voffB); PG8_STAGE(PG8_SA(0, 1), cA + hstep, voffA);
        if (wr == 1) PG8_BAR;
        PG8_WAIT_V(4); PG8_BAR;
        PG8_STAGE(PG8_SB(1, 0), cB + kstep, voffB); PG8_STAGE(PG8_SA(1, 0), cA + kstep, voffA); PG8_STAGE(PG8_SB(1, 1), cB + hstep + kstep, voffB);
        PG8_WAIT_V(6); PG8_BAR;
    }
    for (;;) {
        const bool has_next = S.next(ui + 1, nxt);
        const char* nA = has_next ? (const char*)g.A + (size_t)nxt.pm * tstep : cA; const char* nB = has_next ? (const char*)g.Bt + (size_t)nxt.pn * tstep : cB;
        for (int t = 0; t < nt; t += 2) {
            const bool last = (t == nt - 2);
            const char* a1 = cA + (size_t)(t + 1) * kstep;
            const char* a2 = last ? nA : cA + (size_t)(t + 2) * kstep; const char* b2 = last ? nB : cB + (size_t)(t + 2) * kstep;
            const char* a3 = a2 + kstep; const char* b3 = b2 + kstep;
            if (last && has_next) S.a_ready(nxt);
            if constexpr (SP2) {
            PG8_LDB(B0, 0, 0); PG8_LDB(B1, 0, 1); PG8_SCHED; PG8_LDA(At, 0, 0); PG8_STAGE(PG8_SA(1, 1), a1 + hstep, voffA);
            PG8_WAIT_V(8); PG8_WAIT_L(0); PG8_BAR; PG8_MMA(0, 0, At, B0); PG8_MMA(0, 1, At, B1); PG8_BAR; PG8_SCHED;
            PG8_LDA(At, 0, 1); PG8_STAGE(PG8_SB(0, 0), b2, voffB); PG8_STAGE(PG8_SB(0, 1), b2 + hstep, voffB); PG8_STAGE(PG8_SA(0, 0), a2, voffA);
            PG8_WAIT_V(8); PG8_WAIT_L(0); PG8_BAR; PG8_MMA(1, 0, At, B0); PG8_MMA(1, 1, At, B1); PG8_BAR; PG8_SCHED;
            PG8_LDB(B0, 1, 0); PG8_LDB(B1, 1, 1); PG8_SCHED; PG8_LDA(At, 1, 0); PG8_STAGE(PG8_SA(0, 1), a2 + hstep, voffA);
            PG8_WAIT_V(8); PG8_WAIT_L(0); PG8_BAR; PG8_MMA(0, 0, At, B0); PG8_MMA(0, 1, At, B1); PG8_BAR; PG8_SCHED;
            PG8_LDA(At, 1, 1); PG8_STAGE(PG8_SB(1, 0), b3, voffB); PG8_STAGE(PG8_SB(1, 1), b3 + hstep, voffB); PG8_STAGE(PG8_SA(1, 0), a3, voffA);
            PG8_WAIT_V(8); PG8_WAIT_L(0); PG8_BAR; PG8_MMA(1, 0, At, B0); PG8_MMA(1, 1, At, B1); PG8_BAR; PG8_SCHED;
            } else {
            PG8_LDB(B0, 0, 0); PG8_SCHED; PG8_LDA(At, 0, 0); PG8_STAGE(PG8_SA(1, 1), a1 + hstep, voffA);
            PG8_WAIT_L(8); PG8_BAR; PG8_WAIT_L(0); PG8_MMA(0, 0, At, B0); PG8_BAR; PG8_SCHED;
            PG8_LDB(B1, 0, 1); PG8_STAGE(PG8_SB(0, 0), b2, voffB);
            PG8_BAR; PG8_WAIT_L(0); PG8_MMA(0, 1, At, B1); PG8_BAR;
            PG8_LDA(At, 0, 1); PG8_STAGE(PG8_SA(0, 0), a2, voffA);
            PG8_BAR; PG8_WAIT_L(0); PG8_MMA(1, 0, At, B0); PG8_BAR; PG8_SCHED;
            PG8_STAGE(PG8_SB(0, 1), b2 + hstep, voffB);
            PG8_WAIT_V(6); PG8_BAR; PG8_MMA(1, 1, At, B1); PG8_BAR;
            PG8_LDB(B0, 1, 0); PG8_SCHED; PG8_LDA(At, 1, 0); PG8_STAGE(PG8_SA(0, 1), a2 + hstep, voffA);
            PG8_WAIT_L(8); PG8_BAR; PG8_WAIT_L(0); PG8_MMA(0, 0, At, B0); PG8_BAR; PG8_SCHED;
            PG8_LDB(B1, 1, 1); PG8_STAGE(PG8_SB(1, 0), b3, voffB);
            PG8_BAR; PG8_WAIT_L(0); PG8_MMA(0, 1, At, B1); PG8_BAR;
            PG8_LDA(At, 1, 1); PG8_STAGE(PG8_SA(1, 0), a3, voffA);
            PG8_BAR; PG8_WAIT_L(0); PG8_MMA(1, 0, At, B0); PG8_BAR; PG8_SCHED;
            PG8_STAGE(PG8_SB(1, 1), b3 + hstep, voffB);
            PG8_WAIT_V(6); PG8_BAR; PG8_MMA(1, 1, At, B1); PG8_BAR;
            }
        }
        if constexpr (ALIGN_EPI) { if (wr == 0) PG8_BAR; }
        if constexpr (!Epi::AFTER_DRAIN) { E(acc, cur, wr, wc, fr, fq); S.done(cur); }
        if (!has_next) break;
#pragma unroll
        for (int a = 0; a < 2; ++a)
#pragma unroll
            for (int b = 0; b < 2; ++b)
#pragma unroll
                for (int m = 0; m < 4; ++m)
#pragma unroll
                    for (int n = 0; n < 2; ++n) acc[a][b][m][n] = (f32x4){0.f, 0.f, 0.f, 0.f};
        cur = nxt; cA = nA; cB = nB; ++ui;
        if constexpr (ALIGN_EPI) { if (wr == 1) PG8_BAR; }
    }
    PG8_WAIT_V(0);
    if constexpr (!ALIGN_EPI) { if (wr == 0) PG8_BAR; }
    PG8_BAR;
    if constexpr (Epi::AFTER_DRAIN) { E.fused(acc, cur, wr, wc, fr, fq, lds, wid, lane); S.done(cur); }
#undef PG8_SA
#undef PG8_SB
#undef PG8_STAGE
#undef PG8_LDA
#undef PG8_LDB
#undef PG8_MMA
#undef PG8_WAIT_V
#undef PG8_WAIT_L
#undef PG8_BAR
#undef PG8_SCHED
}
}

#define LAS __attribute__((address_space(3)))
typedef unsigned short bf16;
typedef unsigned v4u __attribute__((ext_vector_type(4)));
typedef unsigned v2u __attribute__((ext_vector_type(2)));
typedef float f32x4 __attribute__((ext_vector_type(4)));

#ifndef MK_SINGLE
#define MK_SINGLE 1
#endif

constexpr int NB = 2, L = 8192, T = NB * L, D = 1024;
constexpr int HN = 2816;
constexpr int H_A = 0, H_QL = 512, H_CB = 1536, H_QI = 1664, H_KI = 1920, H_XC = 1984, H_V = 2240, H_O = 2496, H_S = 2752;
constexpr int CATW = 1536, CAT_A = 0, CAT_B = 256, CAT_C = 1280;
constexpr int WIN_N = 2252;
constexpr float ALPHA = 1.4142135623730951f;
constexpr float LN_EPS = 1e-5f;
constexpr int NCHUNK = 1024;

constexpr size_t MiB = 1u << 20;
constexpr size_t WS_CTL = 0, CTL_ZERO_BYTES = 1 * MiB;
constexpr size_t WS_WIN  = 1 * MiB;
constexpr size_t WS_WOUT = 12 * MiB;
constexpr size_t WS_WCQ  = 18 * MiB;
constexpr size_t WS_WCKV = 22 * MiB;
constexpr size_t WS_WCO  = 30 * MiB;
constexpr size_t WS_WPQ  = 34 * MiB;
constexpr size_t WS_MEMB = 42 * MiB;
constexpr size_t WS_KV   = 43 * MiB;
constexpr size_t WS_PU8  = 48 * MiB;
constexpr size_t WS_PV8  = 80 * MiB;
constexpr size_t WS_PSC  = 112 * MiB;
constexpr size_t WS_XB   = 176 * MiB;
constexpr size_t WS_HB   = 208 * MiB;
constexpr size_t WS_QX   = 208 * MiB;
constexpr size_t WS_OX   = 240 * MiB;
constexpr size_t WS_QP   = 208 * MiB;
constexpr size_t WS_HS   = 296 * MiB;
constexpr size_t WS_CAT  = 297 * MiB;
constexpr size_t WS_CKV  = 345 * MiB;
constexpr size_t WS_SEL  = 349 * MiB;
constexpr size_t WS_MQ   = 357 * MiB;
constexpr size_t WS_MK   = 373 * MiB;
constexpr size_t WS_MC   = 389 * MiB;
constexpr size_t WS_MN   = 405 * MiB;
constexpr size_t WS_SCL  = WS_MN + 512 * 1024;
constexpr size_t WS_BC   = 406 * MiB;
constexpr size_t WS_IG   = WS_BC + 512 * 1024;
constexpr size_t WS_NSEL = 407 * MiB;
constexpr size_t WS_END  = 408 * MiB;

constexpr int LDS_BYTES = 147456;
constexpr int MISC_OFF = 131072 + 320;

__device__ __forceinline__ float bf2f(unsigned h) { return __uint_as_float(h << 16); }
__device__ __forceinline__ unsigned f2bf(float f) { unsigned u = __float_as_uint(f); return (u + 0x7fffu + ((u >> 16) & 1u)) >> 16; }
__device__ __forceinline__ unsigned pk2(float lo, float hi) { return f2bf(lo) | (f2bf(hi) << 16); }
__device__ __forceinline__ float lo16(unsigned u) { return __uint_as_float(u << 16); }
__device__ __forceinline__ float hi16(unsigned u) { return __uint_as_float(u & 0xffff0000u); }
__device__ __forceinline__ float wave_sum(float v) {
#pragma unroll
    for (int o = 1; o < 64; o <<= 1) v += __shfl_xor(v, o);
    return v;
}
__device__ __forceinline__ float wave_max(float v) {
#pragma unroll
    for (int o = 1; o < 64; o <<= 1) v = fmaxf(v, __shfl_xor(v, o));
    return v;
}
__device__ __forceinline__ int wave_sum_i(int v) {
#pragma unroll
    for (int o = 1; o < 64; o <<= 1) v += __shfl_xor(v, o);
    return v;
}
#define WAVE_LDS_SYNC() asm volatile("s_waitcnt lgkmcnt(0)" ::: "memory")
__device__ __forceinline__ float sigmoidf_(float x) { return 1.f / (1.f + __expf(-x)); }
__device__ __forceinline__ float dot8(v4u a, const float (&x)[8]) {
    return lo16(a.x) * x[0] + hi16(a.x) * x[1] + lo16(a.y) * x[2] + hi16(a.y) * x[3] + lo16(a.z) * x[4] + hi16(a.z) * x[5] + lo16(a.w) * x[6] + hi16(a.w) * x[7];
}
__device__ __forceinline__ float dot8bb(v4u a, v4u b) {
    return lo16(a.x) * lo16(b.x) + hi16(a.x) * hi16(b.x) + lo16(a.y) * lo16(b.y) + hi16(a.y) * hi16(b.y) + lo16(a.z) * lo16(b.z) + hi16(a.z) * hi16(b.z) + lo16(a.w) * lo16(b.w) + hi16(a.w) * hi16(b.w);
}

#define XB_TMO      128
#define XB_XCNT(j)  (256  + 64 * (j))
#define XB_XSUB(j)  (1280 + 64 * (j))
#define XB_XGEN(j)  (2304 + 64 * (j))
#define XB_TOP      3328
#define XB_TOPGEN   3392
#define XCD_BAR_WORDS 3456
#define XB_SPIN_CAP (1u << 18)

__device__ __forceinline__ unsigned xb_ld(unsigned* p)              { return __hip_atomic_load(p, __ATOMIC_RELAXED, __HIP_MEMORY_SCOPE_AGENT); }
__device__ __forceinline__ unsigned xb_add(unsigned* p, unsigned v) { return __hip_atomic_fetch_add(p, v, __ATOMIC_RELAXED, __HIP_MEMORY_SCOPE_AGENT); }
__device__ __forceinline__ unsigned xb_xcc_id() { return (unsigned)__builtin_amdgcn_s_getreg((3 << 11) | 20) & 0xFu; }
#define XB_SPIN(cond, bar) do { unsigned _sp = 0; while (cond) { __builtin_amdgcn_s_sleep(1); \
    if ((++_sp & 255u) == 0u) { if (xb_ld(&(bar)[XB_TMO])) break; if (_sp > XB_SPIN_CAP) { atomicAdd(&(bar)[XB_TMO], 1u); break; } } } } while (0)

struct XcdBarrier { unsigned* bar; unsigned x; volatile LAS unsigned* st; };

__device__ __forceinline__ XcdBarrier xcd_barrier_post(unsigned* bar, volatile LAS unsigned* st) {
    XcdBarrier b; b.bar = bar; b.x = xb_xcc_id(); b.st = st;
    if (threadIdx.x == 0) (void)xb_add(&bar[XB_XCNT(b.x)], 1u);
    return b;
}
__device__ __forceinline__ void xcd_barrier_complete(unsigned* bar, unsigned x, unsigned& nloc, unsigned& nx) {
    const unsigned G = gridDim.x * gridDim.y * gridDim.z;
    unsigned sum, cnt, mine, sp = 0u;
    for (;;) {
        sum = 0u; cnt = 0u; mine = 0u;
#pragma unroll
        for (unsigned j = 0; j < 16; ++j) { const unsigned c = xb_ld(&bar[XB_XCNT(j)]); sum += c; cnt += (c > 0u) ? 1u : 0u; mine = (j == x) ? c : mine; }
        if (sum == G) break;
        __builtin_amdgcn_s_sleep(1);
        if ((++sp & 255u) == 0u) { if (xb_ld(&bar[XB_TMO])) break; if (sp > XB_SPIN_CAP) { atomicAdd(&bar[XB_TMO], 1u); break; } }
    }
    nloc = mine > 0u ? mine : 1u; nx = cnt > 0u ? cnt : 1u;
}
__device__ __forceinline__ void xcd_barrier(const XcdBarrier& b) {
    asm volatile("s_waitcnt vmcnt(0)" ::: "memory");
    __syncthreads();
    if (threadIdx.x == 0) {
        unsigned* bar = b.bar;
        __builtin_amdgcn_s_waitcnt(0);
        unsigned nloc = b.st[0], nx = b.st[1];
        if (nloc == 0u) { xcd_barrier_complete(bar, b.x, nloc, nx); b.st[0] = nloc; b.st[1] = nx; }
        const unsigned old = xb_add(&bar[XB_XSUB(b.x)], 1u);
        const unsigned gen = old / nloc;
        if (old + 1u == (gen + 1u) * nloc) {
            __builtin_amdgcn_fence(__ATOMIC_RELEASE, "agent");
            asm volatile("s_waitcnt vmcnt(0)" ::: "memory");
            const unsigned og = xb_add(&bar[XB_TOP], 1u);
            const unsigned tg = og / nx;
            if (og + 1u == (tg + 1u) * nx) xb_add(&bar[XB_TOPGEN], 1u);
            else XB_SPIN(xb_ld(&bar[XB_TOPGEN]) == tg, bar);
            __builtin_amdgcn_fence(__ATOMIC_ACQUIRE, "agent");
            xb_add(&bar[XB_XGEN(b.x)], 1u);
            asm volatile("s_waitcnt vmcnt(0)" ::: "memory");
        } else {
            XB_SPIN(xb_ld(&bar[XB_XGEN(b.x)]) == gen, bar);
            __builtin_amdgcn_fence(__ATOMIC_ACQUIRE, "agent");
            asm volatile("s_waitcnt vmcnt(0)" ::: "memory");
        }
    }
    __syncthreads();
}

struct EpiH {
    static constexpr bool PERM = true, AFTER_DRAIN = false;
    bf16* H; float* Hs;
    __device__ __forceinline__ void operator()(const pg8::f32x4 (&acc)[2][2][4][2], const pg8::Unit& u, int wr, int wc, int fr, int fq) const {
        const int row0 = u.pm * 256 + wr * 64 + fr, col0 = u.pn * 256 + wc * 32 + 8 * fq;
#pragma unroll
        for (int ai = 0; ai < 2; ++ai)
#pragma unroll
            for (int m = 0; m < 4; ++m) {
                const int row = row0 + ai * 128 + m * 16;
#pragma unroll
                for (int bj = 0; bj < 2; ++bj) {
                    const int c = col0 + bj * 128;
                    const pg8::f32x4 v0 = acc[ai][bj][m][0], v1 = acc[ai][bj][m][1];
                    v4u w; w.x = pk2(v0[0], v0[1]); w.y = pk2(v0[2], v0[3]); w.z = pk2(v1[0], v1[1]); w.w = pk2(v1[2], v1[3]);
                    *(v4u*)(H + (size_t)row * HN + c) = w;
                    if (c == H_S || c == H_S + 8) { float* s = Hs + (size_t)row * 16 + (c - H_S); *(pg8::f32x4*)s = v0; *(pg8::f32x4*)(s + 4) = v1; }
                }
            }
    }
};
struct EpiB16 {
    static constexpr bool PERM = true, AFTER_DRAIN = false;
    bf16* O; int ldc;
    __device__ __forceinline__ void operator()(const pg8::f32x4 (&acc)[2][2][4][2], const pg8::Unit& u, int wr, int wc, int fr, int fq) const {
        const int row0 = u.pm * 256 + wr * 64 + fr, col0 = u.pn * 256 + wc * 32 + 8 * fq;
#pragma unroll
        for (int ai = 0; ai < 2; ++ai)
#pragma unroll
            for (int m = 0; m < 4; ++m) {
                const int row = row0 + ai * 128 + m * 16;
#pragma unroll
                for (int bj = 0; bj < 2; ++bj) {
                    const int c = col0 + bj * 128;
                    const pg8::f32x4 v0 = acc[ai][bj][m][0], v1 = acc[ai][bj][m][1];
                    v4u w; w.x = pk2(v0[0], v0[1]); w.y = pk2(v0[2], v0[3]); w.z = pk2(v1[0], v1[1]); w.w = pk2(v1[2], v1[3]);
                    *(v4u*)(O + (size_t)row * ldc + c) = w;
                }
            }
    }
};
struct EpiResid {
    static constexpr bool PERM = false, AFTER_DRAIN = false;
    float* O; int ldc; float alpha;
    __device__ __forceinline__ void operator()(const pg8::f32x4 (&acc)[2][2][4][2], const pg8::Unit& u, int wr, int wc, int fr, int fq) const {
        const int row0 = u.pm * 256 + wr * 64 + fr, col0 = u.pn * 256 + wc * 32 + 4 * fq;
#pragma unroll
        for (int ai = 0; ai < 2; ++ai)
#pragma unroll
            for (int m = 0; m < 4; ++m) {
                float* rowp = O + (size_t)(row0 + ai * 128 + m * 16) * ldc + col0;
#pragma unroll
                for (int bj = 0; bj < 2; ++bj)
#pragma unroll
                    for (int n = 0; n < 2; ++n) {
                        pg8::f32x4* p = (pg8::f32x4*)(rowp + bj * 128 + n * 16);
                        const pg8::f32x4 x = *p;
                        *p = x * alpha + acc[ai][bj][m][n];
                    }
            }
    }
};

struct Args { const float* in[35]; float* out; unsigned char* ws; int lo, hi, li, sub; };
typedef const __attribute__((address_space(4))) Args* KArgs;
__device__ __forceinline__ KArgs kargs() { KArgs p = (KArgs)__builtin_amdgcn_kernarg_segment_ptr(); asm volatile("" : "+s"(p)); return p; }
enum { I_X = 0, I_MEM, I_LNIN_G, I_LNIN_B, I_RELB, I_WIN, I_CAW, I_CAB, I_NAG, I_NAB, I_KVG, I_WUK, I_WUV, I_CMW, I_CMB, I_WQM, I_WKM, I_BI, I_BF, I_NMG,
       I_WOUT, I_LN1G, I_LN1B, I_WCQ, I_WCKV, I_WCO, I_LN2G, I_LN2B, I_WPQ, I_SK1, I_SK2, I_PU, I_PV, I_LN3G, I_LN3B };

__device__ __forceinline__ void tr_item(LAS float* scr, const float* W, int ldw, int k0, int n0, int ncv, bf16* WT, int ldk, int dr0, int kofs, int tid) {
    const int c = tid & 63, r0 = tid >> 6;
#pragma unroll
    for (int i = 0; i < 8; ++i) { const int r = r0 + 8 * i; scr[r * 65 + c] = (c < ncv) ? W[(size_t)(k0 + r) * ldw + n0 + c] : 0.f; }
    __syncthreads();
#pragma unroll
    for (int i = 0; i < 8; ++i) { const int n = r0 + 8 * i; if (n < ncv) WT[(size_t)(dr0 + n) * ldk + kofs + k0 + c] = (bf16)f2bf(scr[c * 65 + n]); }
    __syncthreads();
}
__device__ __forceinline__ void tr_job(LAS float* scr, const float* W, int K, int ldw, int n0, int nc, bf16* WT, int ldk, int dr0, int kofs, int tid, int G, int bid) {
    const int nnt = (nc + 63) / 64, nitems = (K / 64) * nnt;
    for (int it = bid; it < nitems; it += G) {
        const int kt = it / nnt, nt = it % nnt;
        const int ncv = (nc - nt * 64) < 64 ? (nc - nt * 64) : 64;
        tr_item(scr, W, ldw, kt * 64, n0 + nt * 64, ncv, WT, ldk, dr0 + nt * 64, kofs, tid);
    }
}
__device__ __forceinline__ void ln_row(const float* src, const float* g, const float* b, float* dstf, bf16* dstb, int lane) {
    const f32x4* xr = (const f32x4*)src + lane;
    f32x4 v[4]; float s = 0.f;
#pragma unroll
    for (int j = 0; j < 4; ++j) { v[j] = xr[64 * j]; s += (v[j].x + v[j].y) + (v[j].z + v[j].w); }
    const float mean = wave_sum(s) * (1.f / D); float s2 = 0.f;
#pragma unroll
    for (int j = 0; j < 4; ++j) { v[j] = v[j] - mean; s2 += (v[j].x * v[j].x + v[j].y * v[j].y) + (v[j].z * v[j].z + v[j].w * v[j].w); }
    const float rstd = rsqrtf(wave_sum(s2) * (1.f / D) + LN_EPS);
#pragma unroll
    for (int j = 0; j < 4; ++j) {
        const f32x4 gg = ((const f32x4*)g)[lane + 64 * j], bb = ((const f32x4*)b)[lane + 64 * j];
        const f32x4 y = v[j] * rstd * gg + bb;
        ((f32x4*)dstf)[lane + 64 * j] = y;
        v2u o; o.x = pk2(y.x, y.y); o.y = pk2(y.z, y.w);
        ((v2u*)dstb)[lane + 64 * j] = o;
    }
}

__device__ __forceinline__ void p0_prologue(LAS unsigned char* lds, int tid, int G, int bid) {
    LAS float* scr = (LAS float*)lds;
    KArgs ap = kargs();
    unsigned char* ws = ap->ws;
    for (int l = 0; l < 2; ++l) {
        const float* win = ap->in[I_WIN] + (size_t)l * D * WIN_N;
        bf16* WinT = (bf16*)(ws + WS_WIN) + (size_t)l * HN * D;
        tr_job(scr, win, D, WIN_N, 0, 512, WinT, D, H_A, 0, tid, G, bid);
        tr_job(scr, win, D, WIN_N, 1024, 448, WinT, D, H_CB, 0, tid, G, bid);
        tr_job(scr, win, D, WIN_N, 1476, 768, WinT, D, H_XC, 0, tid, G, bid);
        tr_job(scr, win, D, WIN_N, 1472, 4, WinT, D, H_S, 0, tid, G, bid);
        tr_job(scr, win, D, WIN_N, 2244, 8, WinT, D, H_S + 4, 0, tid, G, bid);
        for (int i = bid * 512 + tid; i < (HN - (H_S + 12)) * D; i += G * 512) WinT[(size_t)(H_S + 12) * D + i] = 0;
        const float* wout = ap->in[I_WOUT] + (size_t)l * D * D;
        bf16* WoutT = (bf16*)(ws + WS_WOUT) + (size_t)l * D * CATW;
        tr_job(scr, wout, 256, D, 0, D, WoutT, CATW, 0, CAT_A, tid, G, bid);
        tr_job(scr, wout + (size_t)768 * D, 256, D, 0, D, WoutT, CATW, 0, CAT_C, tid, G, bid);
        tr_job(scr, ap->in[I_WCQ] + (size_t)l * D * D, D, D, 0, D, (bf16*)(ws + WS_WCQ) + (size_t)l * D * D, D, 0, 0, tid, G, bid);
        tr_job(scr, ap->in[I_WCKV] + (size_t)l * D * 2048, D, 2048, 0, 2048, (bf16*)(ws + WS_WCKV) + (size_t)l * 2048 * D, D, 0, 0, tid, G, bid);
        tr_job(scr, ap->in[I_WCO] + (size_t)l * D * D, D, D, 0, D, (bf16*)(ws + WS_WCO) + (size_t)l * D * D, D, 0, 0, tid, G, bid);
        tr_job(scr, ap->in[I_WPQ] + (size_t)l * D * 2048, D, 2048, 0, 2048, (bf16*)(ws + WS_WPQ) + (size_t)l * 2048 * D, D, 0, 0, tid, G, bid);
    }
    {
        LAS float* sa = (LAS float*)lds;
        LAS float* sb = sa + 64 * 65;
        for (int it = bid; it < 2 * 2 * 128; it += G) {
            const int l = it >> 8, kind = (it >> 7) & 1, h = (it >> 4) & 7, tile = it & 15;
            if (kind == 0) {
                const float* win = ap->in[I_WIN] + (size_t)l * D * WIN_N;
                const float* wuk = ap->in[I_WUK] + (size_t)l * 8 * 64 * 128 + (size_t)h * 64 * 128;
                bf16* WinT = (bf16*)(ws + WS_WIN) + (size_t)l * HN * D;
                const int k0 = tile * 64;
                for (int i = tid; i < 4096; i += 512) { const int kk = i >> 6, d = i & 63; sa[kk * 65 + d] = win[(size_t)(k0 + kk) * WIN_N + 512 + h * 64 + d]; }
                for (int i = tid; i < 8192; i += 512) sb[i] = wuk[i];
                __syncthreads();
                for (int i = tid; i < 8192; i += 512) { const int r = i >> 6, kk = i & 63; float s = 0.f;
#pragma unroll 8
                    for (int d = 0; d < 64; ++d) s += sa[kk * 65 + d] * sb[d * 128 + r];
                    WinT[(size_t)(H_QL + h * 128 + r) * D + k0 + kk] = (bf16)f2bf(s); }
                __syncthreads();
            } else {
                const float* wout = ap->in[I_WOUT] + (size_t)l * D * D;
                const float* wuv = ap->in[I_WUV] + (size_t)l * 8 * 128 * 64 + (size_t)h * 128 * 64;
                bf16* WoutT = (bf16*)(ws + WS_WOUT) + (size_t)l * D * CATW;
                const int n0 = tile * 64;
                for (int i = tid; i < 4096; i += 512) { const int d = i >> 6, n = i & 63; sa[d * 65 + n] = wout[(size_t)(256 + h * 64 + d) * D + n0 + n]; }
                for (int i = tid; i < 8192; i += 512) { const int r = i >> 6, d = i & 63; sb[r * 65 + d] = wuv[i]; }
                __syncthreads();
                for (int i = tid; i < 8192; i += 512) { const int n = i >> 7, r = i & 127; float s = 0.f;
#pragma unroll 8
                    for (int d = 0; d < 64; ++d) s += sb[r * 65 + d] * sa[d * 65 + n];
                    WoutT[(size_t)(n0 + n) * CATW + CAT_B + h * 128 + r] = (bf16)f2bf(s); }
                __syncthreads();
            }
        }
    }
    {
        const int gw = bid * 8 + (tid >> 6), NGW = G * 8, lane = tid & 63;
        for (int row = gw; row < 2 * 2 * 16384; row += NGW) {
            const int tab = row >> 15, le = row & 32767;
            const f32x4* src = (const f32x4*)((tab ? ap->in[I_PV] : ap->in[I_PU]) + (size_t)le * D) + 4 * lane;
            f32x4 v[4]; float am = 0.f;
#pragma unroll
            for (int i = 0; i < 4; ++i) { v[i] = src[i]; am = fmaxf(am, fmaxf(fmaxf(fabsf(v[i].x), fabsf(v[i].y)), fmaxf(fabsf(v[i].z), fabsf(v[i].w)))); }
            am = wave_max(am);
            const float sc = am > 0.f ? 448.f / am : 1.f;
            v4u w; int q;
            q = 0; q = __builtin_amdgcn_cvt_pk_fp8_f32(v[0].x * sc, v[0].y * sc, q, false); q = __builtin_amdgcn_cvt_pk_fp8_f32(v[0].z * sc, v[0].w * sc, q, true); w.x = (unsigned)q;
            q = 0; q = __builtin_amdgcn_cvt_pk_fp8_f32(v[1].x * sc, v[1].y * sc, q, false); q = __builtin_amdgcn_cvt_pk_fp8_f32(v[1].z * sc, v[1].w * sc, q, true); w.y = (unsigned)q;
            q = 0; q = __builtin_amdgcn_cvt_pk_fp8_f32(v[2].x * sc, v[2].y * sc, q, false); q = __builtin_amdgcn_cvt_pk_fp8_f32(v[2].z * sc, v[2].w * sc, q, true); w.z = (unsigned)q;
            q = 0; q = __builtin_amdgcn_cvt_pk_fp8_f32(v[3].x * sc, v[3].y * sc, q, false); q = __builtin_amdgcn_cvt_pk_fp8_f32(v[3].z * sc, v[3].w * sc, q, true); w.w = (unsigned)q;
            *((v4u*)(ws + (tab ? WS_PV8 : WS_PU8) + (size_t)le * 1024) + lane) = w;
            if (lane == 0) ((float*)(ws + WS_PSC))[row] = am > 0.f ? am * (1.f / 448.f) : 1.f;
        }
        const size_t gt = (size_t)bid * 512 + tid, gs = (size_t)G * 512;
        const f32x4* pm = (const f32x4*)ap->in[I_MEM]; v2u* dm = (v2u*)(ws + WS_MEMB);
        for (size_t i = gt; i < (size_t)512 * 1024 / 4; i += gs) { const f32x4 x = pm[i]; v2u o; o.x = pk2(x.x, x.y); o.y = pk2(x.z, x.w); dm[i] = o; }
    }
    {
        const int gw = bid * 8 + (tid >> 6), NGW = G * 8, lane = tid & 63;
        for (int m = gw; m < T; m += NGW)
            ln_row(ap->in[I_X] + (size_t)m * D, ap->in[I_LNIN_G], ap->in[I_LNIN_B], ap->out + (size_t)m * D, (bf16*)(ws + WS_XB) + (size_t)m * D, lane);
    }
}

__device__ __forceinline__ void conv_unit(LAS unsigned char* lds, int tile, const bf16* Hb, const float* cw, const float* cb, const float* ng, const float* nb, bf16* CAT, int tid) {
    LAS float* u = (LAS float*)lds;
    LAS float* w = u + 94 * 256;
    const int t0 = tile * 64, pos0 = t0 & (L - 1);
    for (int i = tid; i < 94 * 256; i += 512) {
        const int r = i >> 8, c = i & 255, pos = pos0 - 30 + r; float val = 0.f;
        if (pos >= 0) { const bf16* hr = Hb + (size_t)(t0 - 30 + r) * HN + H_A; const float av = bf2f(hr[c]), gt = bf2f(hr[256 + c]); val = av * sigmoidf_(gt); }
        u[i] = val;
    }
    for (int i = tid; i < 31 * 256; i += 512) w[i] = cw[i];
    __syncthreads();
    const int wave = tid >> 6, lane = tid & 63;
    for (int tt = wave; tt < 64; tt += 8) {
        float acc[4];
#pragma unroll
        for (int i = 0; i < 4; ++i) { const int c = lane + 64 * i; float s = cb[c];
            asm volatile("" ::: "memory");
#pragma unroll 8
            for (int k = 0; k < 31; ++k) s += w[k * 256 + c] * u[(tt + k) * 256 + c];
            acc[i] = s; }
        const float mean = wave_sum((acc[0] + acc[1]) + (acc[2] + acc[3])) * (1.f / 256.f);
        float s2 = 0.f;
#pragma unroll
        for (int i = 0; i < 4; ++i) { acc[i] -= mean; s2 += acc[i] * acc[i]; }
        const float rstd = rsqrtf(wave_sum(s2) * (1.f / 256.f) + LN_EPS);
#pragma unroll
        for (int i = 0; i < 4; ++i) { const int c = lane + 64 * i; const float y = acc[i] * rstd * ng[c] + nb[c];
            CAT[(size_t)(t0 + tt) * CATW + CAT_A + c] = (bf16)f2bf(y * sigmoidf_(y)); }
    }
    __syncthreads();
}

__device__ __forceinline__ unsigned fkey(float f) { const unsigned u = __float_as_uint(f); return (u & 0x80000000u) ? ~u : (u | 0x80000000u); }

__device__ __forceinline__ int block_sum_i(int v, LAS int* red, int tid) {
    v = wave_sum_i(v);
    if ((tid & 63) == 0) red[tid >> 6] = v;
    __syncthreads();
    int s = 0;
#pragma unroll
    for (int i = 0; i < 8; ++i) s += red[i];
    __syncthreads();
    return s;
}
__device__ __forceinline__ int block_excl_scan_i(int v, LAS int* red, int tid, int& tot) {
    const int lane = tid & 63, wave = tid >> 6;
    int inc = v;
#pragma unroll
    for (int o = 1; o < 64; o <<= 1) { const int y = __shfl_up(inc, o); if (lane >= o) inc += y; }
    if (lane == 63) red[wave] = inc;
    __syncthreads();
    int base = 0, t = 0;
#pragma unroll
    for (int i = 0; i < 8; ++i) { const int r = red[i]; if (i < wave) base += r; t += r; }
    __syncthreads();
    tot = t;
    return base + inc - v;
}

__device__ __forceinline__ void indexer_query(LAS unsigned char* lds, int t, const bf16* Hb, const float* Hs, unsigned short* SEL, int* NSEL, int tid) {
    LAS unsigned* keys = (LAS unsigned*)lds;
    LAS float* qi = (LAS float*)(lds + 32768);
    LAS int* red = (LAS int*)(lds + 32768 + 1024);
    const int b = t >> 13, pos = t & (L - 1), n = pos + 1;
    if (tid < 256) qi[tid] = bf2f(Hb[(size_t)t * HN + H_QI + tid]);
    const float w0 = Hs[(size_t)t * 16 + 0] * 0.5f, w1 = Hs[(size_t)t * 16 + 1] * 0.5f, w2 = Hs[(size_t)t * 16 + 2] * 0.5f, w3 = Hs[(size_t)t * 16 + 3] * 0.5f;
    __syncthreads();
    for (int s = tid; s < n; s += 512) {
        const bf16* kr = Hb + (size_t)(b * L + s) * HN + H_KI;
        float d0 = 0.f, d1 = 0.f, d2 = 0.f, d3 = 0.f;
#pragma unroll 1
        for (int c = 0; c < 64; c += 8) {
            asm volatile("" ::: "memory");
            const v4u kk = *(const v4u*)(kr + c);
            float kf[8] = { lo16(kk.x), hi16(kk.x), lo16(kk.y), hi16(kk.y), lo16(kk.z), hi16(kk.z), lo16(kk.w), hi16(kk.w) };
#pragma unroll
            for (int j = 0; j < 8; ++j) { d0 += qi[c + j] * kf[j]; d1 += qi[64 + c + j] * kf[j]; d2 += qi[128 + c + j] * kf[j]; d3 += qi[192 + c + j] * kf[j]; }
        }
        float sc = 0.f;
        sc += w0 * fmaxf(d0 * 0.125f, 0.f); sc += w1 * fmaxf(d1 * 0.125f, 0.f); sc += w2 * fmaxf(d2 * 0.125f, 0.f); sc += w3 * fmaxf(d3 * 0.125f, 0.f);
        keys[s] = fkey(sc);
    }
    __syncthreads();
    if (n <= 256) {
        for (int s = tid; s < n; s += 512) SEL[(size_t)t * 256 + s] = (unsigned short)s;
        if (tid == 0) NSEL[t] = n;
        __syncthreads();
        return;
    }
    unsigned prefix = 0u;
    for (int bit = 31; bit >= 0; --bit) {
        const unsigned cand = prefix | (1u << bit);
        int c = 0;
        for (int s = tid; s < n; s += 512) c += (keys[s] >= cand) ? 1 : 0;
        c = block_sum_i(c, red, tid);
        if (c >= 256) prefix = cand;
    }
    int ng = 0, nt = 0;
#pragma unroll
    for (int j = 0; j < 16; ++j) { const int s = tid * 16 + j; if (s < n) { const unsigned k = keys[s]; ng += (k > prefix) ? 1 : 0; nt += (k == prefix) ? 1 : 0; } }
    int totg, tott;
    int eg = block_excl_scan_i(ng, red, tid, totg);
    int et = block_excl_scan_i(nt, red, tid, tott);
    const int quota = 256 - totg;
#pragma unroll
    for (int j = 0; j < 16; ++j) { const int s = tid * 16 + j; if (s < n) { const unsigned k = keys[s];
        if (k > prefix) { SEL[(size_t)t * 256 + eg] = (unsigned short)s; ++eg; }
        else if (k == prefix) { if (et < quota) SEL[(size_t)t * 256 + totg + et] = (unsigned short)s; ++et; } } }
    if (tid == 0) NSEL[t] = 256;
    __syncthreads();
}

typedef short bf16x8s __attribute__((ext_vector_type(8)));
typedef float f32x16 __attribute__((ext_vector_type(16)));
constexpr int IDX_ROWW = 1025;
constexpr int IDX_CTL = 131072 + 512;

template <int PASS>
__device__ __forceinline__ void idx_pass(LAS unsigned char* lds, const bf16* Hb, int b, int si, int wave, int lane,
                                         const bf16x8s (&Qb)[4][4], const float (&wq)[4], unsigned short* SEL) {
    LAS unsigned* hist = (LAS unsigned*)lds;
    LAS unsigned* cB1 = (LAS unsigned*)(lds + IDX_CTL);
    LAS unsigned* cT22 = cB1 + 64;
    LAS unsigned* cCnt = cB1 + 128;
    const int r = lane & 31, h = lane >> 5;
    const int qpos = si * 32 + r;
    const unsigned myB1 = (PASS >= 2) ? cB1[r] : 0u;
    const unsigned myT = (PASS == 3) ? cT22[r] : 0u;
    bf16x8s ka[4];
    {
        const bf16* kp = Hb + (size_t)(b * L + wave * 32 + r) * HN + H_KI + 8 * h;
        if (wave <= si) {
#pragma unroll
            for (int s = 0; s < 4; ++s) ka[s] = *(const bf16x8s*)(kp + 16 * s);
        }
    }
    for (int kt = wave; kt <= si; kt += 8) {
        bf16x8s kn[4];
        const bool more = (kt + 8 <= si);
        if (more) {
            const bf16* kp = Hb + (size_t)(b * L + (kt + 8) * 32 + r) * HN + H_KI + 8 * h;
#pragma unroll
            for (int s = 0; s < 4; ++s) kn[s] = *(const bf16x8s*)(kp + 16 * s);
        }
        float sc[16];
#pragma unroll
        for (int i = 0; i < 16; ++i) sc[i] = 0.f;
#pragma unroll
        for (int hh = 0; hh < 4; ++hh) {
            f32x16 acc;
#pragma unroll
            for (int i = 0; i < 16; ++i) acc[i] = 0.f;
#pragma unroll
            for (int s = 0; s < 4; ++s) acc = __builtin_amdgcn_mfma_f32_32x32x16_bf16(ka[s], Qb[hh][s], acc, 0, 0, 0);
#pragma unroll
            for (int i = 0; i < 16; ++i) sc[i] += wq[hh] * fmaxf(acc[i], 0.f);
        }
        const bool diag = (kt == si);
#pragma unroll
        for (int i = 0; i < 16; ++i) {
            const int ko = (i & 3) + 8 * (i >> 2) + 4 * h;
            const bool valid = !diag || (ko <= r);
            const unsigned key = fkey(sc[i]);
            if (PASS == 1) {
                if (valid) { const unsigned bin = key >> 21; __hip_atomic_fetch_add(hist + r * IDX_ROWW + (bin >> 1), (bin & 1u) ? 65536u : 1u, __ATOMIC_RELAXED, __HIP_MEMORY_SCOPE_WORKGROUP); }
            } else if (PASS == 2) {
                if (valid && (key >> 21) == myB1) { const unsigned bin = (key >> 10) & 2047u; __hip_atomic_fetch_add(hist + r * IDX_ROWW + (bin >> 1), (bin & 1u) ? 65536u : 1u, __ATOMIC_RELAXED, __HIP_MEMORY_SCOPE_WORKGROUP); }
            } else {
                const unsigned k22 = key >> 10;
                const int kpos = kt * 32 + ko;
                if (valid) {
                    if (myB1 == 0xffffffffu || k22 > myT) {
                        __hip_atomic_fetch_or(hist + r * 256 + (kpos >> 5), 1u << (kpos & 31), __ATOMIC_RELAXED, __HIP_MEMORY_SCOPE_WORKGROUP);
                    } else if (k22 == myT) {
                        __hip_atomic_fetch_or(hist + 8192 + r * 256 + (kpos >> 5), 1u << (kpos & 31), __ATOMIC_RELAXED, __HIP_MEMORY_SCOPE_WORKGROUP);
                    }
                }
            }
        }
        if (more) {
#pragma unroll
            for (int s = 0; s < 4; ++s) ka[s] = kn[s];
        }
    }
}

__device__ __forceinline__ void idx_find(LAS unsigned* hist, int q, int need, int lane, unsigned& Bout, int& aboveOut, bool& found) {
    const LAS unsigned* row = hist + q * IDX_ROWW + 16 * lane;
    unsigned wv[16]; int own = 0;
#pragma unroll
    for (int i = 0; i < 16; ++i) { wv[i] = row[i]; own += (int)(wv[i] & 0xffffu) + (int)(wv[i] >> 16); }
    int suf = own;
#pragma unroll
    for (int o = 1; o < 64; o <<= 1) { const int y = __shfl_down(suf, o); if (lane + o < 64) suf += y; }
    const int above = suf - own;
    const bool here = (above < need) && (suf >= need);
    unsigned B = 0u; int ab = 0; bool f = false; int a = above;
#pragma unroll
    for (int i = 15; i >= 0; --i) {
        const int hi = (int)(wv[i] >> 16), lo = (int)(wv[i] & 0xffffu);
        if (!f && a + hi >= need) { B = 32u * lane + 2u * i + 1u; ab = a; f = true; }
        a += hi;
        if (!f && a + lo >= need) { B = 32u * lane + 2u * i; ab = a; f = true; }
        a += lo;
    }
    const unsigned long long m = __ballot(here);
    found = (m != 0ull);
    const int src = found ? (__ffsll((long long)m) - 1) : 0;
    Bout = (unsigned)__shfl((int)B, src); aboveOut = __shfl(ab, src);
}

__device__ __forceinline__ void indexer_strip(LAS unsigned char* lds, int b, int si, const bf16* Hb, const float* Hs, unsigned short* SEL, int* NSEL, int tid) {
    LAS unsigned* hist = (LAS unsigned*)lds;
    LAS unsigned* cB1 = (LAS unsigned*)(lds + IDX_CTL);
    LAS unsigned* cT22 = cB1 + 64;
    LAS unsigned* cCnt = cB1 + 128;
    LAS unsigned* cAb = cB1 + 192;
    const int lane = tid & 63, wave = __builtin_amdgcn_readfirstlane(tid >> 6);
    const int r = lane & 31, h = lane >> 5;
    const int t = b * L + si * 32 + r;
    bf16x8s Qb[4][4]; float wq[4];
#pragma unroll
    for (int hh = 0; hh < 4; ++hh) {
        wq[hh] = Hs[(size_t)t * 16 + hh] * 0.0625f;
#pragma unroll
        for (int s = 0; s < 4; ++s) Qb[hh][s] = *(const bf16x8s*)(Hb + (size_t)t * HN + H_QI + hh * 64 + 16 * s + 8 * h);
    }
    for (int i = tid; i < 32 * IDX_ROWW; i += 512) hist[i] = 0u;
    __syncthreads();
    idx_pass<1>(lds, Hb, b, si, wave, lane, Qb, wq, SEL);
    __syncthreads();
    for (int qq = 0; qq < 4; ++qq) {
        const int q = wave * 4 + qq; unsigned B; int ab; bool f;
        idx_find(hist, q, 256, lane, B, ab, f);
        if (lane == 0) { cB1[q] = f ? B : 0xffffffffu; cAb[q] = f ? (unsigned)ab : 0u; cCnt[q] = 0u; }
    }
    __syncthreads();
    for (int i = tid; i < 32 * IDX_ROWW; i += 512) hist[i] = 0u;
    __syncthreads();
    idx_pass<2>(lds, Hb, b, si, wave, lane, Qb, wq, SEL);
    __syncthreads();
    for (int qq = 0; qq < 4; ++qq) {
        const int q = wave * 4 + qq; unsigned B; int ab; bool f;
        const unsigned b1 = cB1[q]; const int ab1 = (int)cAb[q];
        idx_find(hist, q, 256 - ab1, lane, B, ab, f);
        if (lane == 0 && b1 != 0xffffffffu) { cT22[q] = (b1 << 11) | B; cAb[q] = (unsigned)(ab1 + ab); }
    }
    __syncthreads();
    for (int i = tid; i < 2 * 32 * 256; i += 512) hist[i] = 0u;
    __syncthreads();
    idx_pass<3>(lds, Hb, b, si, wave, lane, Qb, wq, SEL);
    __syncthreads();
    for (int qq = 0; qq < 4; ++qq) {
        const int q = wave * 4 + qq;
        const int tq = b * L + si * 32 + q;
        const bool takeall = (cB1[q] == 0xffffffffu);
        int base = 0;
#pragma unroll 1
        for (int part = 0; part < 2; ++part) {
            unsigned w4[4]; int own = 0;
#pragma unroll
            for (int i = 0; i < 4; ++i) { w4[i] = hist[part * 8192 + q * 256 + 4 * lane + i]; own += __popc(w4[i]); }
            int inc = own;
#pragma unroll
            for (int o = 1; o < 64; o <<= 1) { const int y = __shfl_up(inc, o); if (lane >= o) inc += y; }
            int rank = base + inc - own;
#pragma unroll
            for (int i = 0; i < 4; ++i) {
                unsigned w = w4[i];
                while (w) { const int bit = __ffs((int)w) - 1; w &= w - 1u;
                    if (rank < 256) SEL[(size_t)tq * 256 + rank] = (unsigned short)(128 * lane + 32 * i + bit);
                    ++rank; }
            }
            base += __shfl(inc, 63);
            if (takeall) break;
        }
        if (lane == 0) NSEL[tq] = takeall ? (si * 32 + q + 1) : 256;
    }
    __syncthreads();
}

__device__ __forceinline__ float logsigmoidf_(float x) { return fminf(x, 0.f) - log1pf(__expf(-fabsf(x))); }

__device__ __forceinline__ void mlstm_prep_unit(LAS unsigned char* lds, int cidx, const bf16* Hb, const float* Hs, const float* cmw, const float* cmb, const float* wqm, const float* wkm,
                                                const float* bi, const float* bfp, float* MQ, float* MK, float* MC, float* MN, float* SCL, float* BC, float* IG, int tid) {
    const int j = cidx & 127, h = (cidx >> 7) & 3, b = cidx >> 9, t0 = b * L + j * 64;
    LAS float* xc = (LAS float*)lds;
    LAS float* wq = xc + 64 * 65;
    LAS float* wk = wq + 4096;
    LAS float* kt = wk + 4096;
    LAS float* vt = kt + 64 * 65;
    LAS float* wg = vt + 64 * 65;
    for (int i = tid; i < 4096; i += 512) {
        const int s = i >> 6, d = i & 63, c = h * 64 + d; float av = cmb[c];
#pragma unroll
        for (int k = 0; k < 4; ++k) { const int pos = j * 64 + s - 3 + k; if (pos >= 0) av += cmw[k * 256 + c] * bf2f(Hb[(size_t)(b * L + pos) * HN + H_XC + c]); }
        xc[s * 65 + d] = av * sigmoidf_(av);
        wq[i] = wqm[h * 4096 + i]; wk[i] = wkm[h * 4096 + i];
        vt[s * 65 + d] = bf2f(Hb[(size_t)(t0 + s) * HN + H_V + c]);
    }
    __syncthreads();
    for (int i = tid; i < 4096; i += 512) {
        const int s = i >> 6, e = i & 63; float aq = 0.f, ak = 0.f;
#pragma unroll 8
        for (int d = 0; d < 64; ++d) { const float x = xc[s * 65 + d]; aq += x * wq[d * 64 + e]; ak += x * wk[d * 64 + e]; }
        MQ[(size_t)(t0 + s) * 256 + h * 64 + e] = aq * 0.125f; MK[(size_t)(t0 + s) * 256 + h * 64 + e] = ak; kt[s * 65 + e] = ak;
    }
    if (tid < 64) {
        const int s = tid, t = t0 + s;
        const float fl = logsigmoidf_(Hs[(size_t)t * 16 + 8 + h] + bfp[h]);
        const float ig = Hs[(size_t)t * 16 + 4 + h] + bi[h];
        float bs = fl;
#pragma unroll
        for (int o = 1; o < 64; o <<= 1) { const float y = __shfl_up(bs, o); if (s >= o) bs += y; }
        const float bL = __shfl(bs, 63);
        const float g = bL - bs + ig;
        const float mloc = wave_max(g);
        wg[s] = __expf(g - mloc);
        BC[(size_t)t * 4 + h] = bs; IG[(size_t)t * 4 + h] = ig;
        if (s == 0) { SCL[cidx * 4 + 0] = mloc; SCL[cidx * 4 + 1] = bL; }
    }
    __syncthreads();
    for (int i = tid; i < 4096; i += 512) {
        const int v = i >> 6, k = i & 63; float s2 = 0.f;
#pragma unroll 8
        for (int s = 0; s < 64; ++s) s2 += wg[s] * vt[s * 65 + v] * kt[s * 65 + k];
        MC[(size_t)cidx * 4096 + i] = s2;
    }
    if (tid < 64) { float s2 = 0.f;
        for (int s = 0; s < 64; ++s) s2 += wg[s] * kt[s * 65 + tid];
        MN[(size_t)cidx * 64 + tid] = s2; }
    __syncthreads();
}

__device__ __forceinline__ void mlstm_scan(int gtid, float* MC, float* MN, float* SCL) {
    const int stream = gtid / 4160, e = gtid - stream * 4160;
    if (stream >= 8) return;
    float* base = (e < 4096) ? (MC + e) : (MN + (e - 4096));
    const size_t stride = (e < 4096) ? 4096 : 64;
    float m = 0.f, C = 0.f;
    for (int j0 = 0; j0 < 128; j0 += 8) {
        float loc[8], ml[8], bl[8];
#pragma unroll
        for (int u = 0; u < 8; ++u) { const int cidx = stream * 128 + j0 + u; loc[u] = base[(size_t)cidx * stride]; ml[u] = SCL[cidx * 4 + 0]; bl[u] = SCL[cidx * 4 + 1]; }
#pragma unroll
        for (int u = 0; u < 8; ++u) {
            const int cidx = stream * 128 + j0 + u;
            const float mn = fmaxf(bl[u] + m, ml[u]);
            const float a = __expf(bl[u] + m - mn), c = __expf(ml[u] - mn);
            base[(size_t)cidx * stride] = C;
            if (e == 0) SCL[cidx * 4 + 2] = m;
            C = a * C + c * loc[u]; m = mn;
        }
    }
}

__device__ __forceinline__ int rel_bucket(int dist) {
    const int d = dist > 0 ? dist : 0;
    if (d < 16) return d;
    const int large = 16 + (int)(logf((float)d / 16.f) / 2.0794415416798357f * 16.f);
    return large < 31 ? large : 31;
}

__device__ __forceinline__ void dsa_attn_query(LAS unsigned char* wl, int t, const bf16* Hb, const bf16* CKV, const unsigned short* SEL, const int* NSEL, const float* relb, bf16* CAT, int lane) {
    LAS float* ql = (LAS float*)wl;
    LAS float* P = ql + 1024;
    LAS int* sl = (LAS int*)(P + 2048);
    const int b = t >> 13, pos = t & (L - 1), n = NSEL[t];
    for (int i = lane; i < 1024; i += 64) ql[i] = bf2f(Hb[(size_t)t * HN + H_QL + i]);
    for (int i = lane; i < 256; i += 64) sl[i] = (i < n) ? (int)SEL[(size_t)t * 256 + i] : 0;
    WAVE_LDS_SYNC();
    float lg[4][8];
#pragma unroll
    for (int i = 0; i < 4; ++i) {
        const int kk = lane + 64 * i;
        float acc[8];
#pragma unroll
        for (int h = 0; h < 8; ++h) acc[h] = 0.f;
        const int s = sl[kk];
        const bf16* cr = CKV + (size_t)(b * L + s) * 128;
        for (int c = 0; c < 128; c += 8) {
            const v4u cv = *(const v4u*)(cr + c);
            const float cf[8] = { lo16(cv.x), hi16(cv.x), lo16(cv.y), hi16(cv.y), lo16(cv.z), hi16(cv.z), lo16(cv.w), hi16(cv.w) };
#pragma unroll
            for (int h = 0; h < 8; ++h) {
#pragma unroll
                for (int jj = 0; jj < 8; ++jj) acc[h] += ql[h * 128 + c + jj] * cf[jj];
            }
        }
        const int bk = rel_bucket(pos - s);
#pragma unroll
        for (int h = 0; h < 8; ++h) lg[i][h] = (kk < n) ? (acc[h] * 0.125f + relb[bk * 8 + h]) : -INFINITY;
    }
#pragma unroll
    for (int h = 0; h < 8; ++h) {
        const float mx = wave_max(fmaxf(fmaxf(lg[0][h], lg[1][h]), fmaxf(lg[2][h], lg[3][h])));
        float e[4], sm = 0.f;
#pragma unroll
        for (int i = 0; i < 4; ++i) { e[i] = (lane + 64 * i < n) ? __expf(lg[i][h] - mx) : 0.f; sm += e[i]; }
        const float inv = 1.f / wave_sum(sm);
#pragma unroll
        for (int i = 0; i < 4; ++i) P[h * 256 + lane + 64 * i] = e[i] * inv;
    }
    WAVE_LDS_SYNC();
    float o[8][2];
#pragma unroll
    for (int h = 0; h < 8; ++h) { o[h][0] = 0.f; o[h][1] = 0.f; }
    for (int kk = 0; kk < n; ++kk) {
        const int s = sl[kk];
        const bf16* cr = CKV + (size_t)(b * L + s) * 128;
        const float c0 = bf2f(cr[lane]), c1 = bf2f(cr[64 + lane]);
#pragma unroll
        for (int h = 0; h < 8; ++h) { const float p = P[h * 256 + kk]; o[h][0] += p * c0; o[h][1] += p * c1; }
    }
#pragma unroll
    for (int h = 0; h < 8; ++h) {
        CAT[(size_t)t * CATW + CAT_B + h * 128 + lane] = (bf16)f2bf(o[h][0]);
        CAT[(size_t)t * CATW + CAT_B + h * 128 + 64 + lane] = (bf16)f2bf(o[h][1]);
    }
    WAVE_LDS_SYNC();
}

__device__ __forceinline__ void mlstm_out_unit(LAS unsigned char* lds, int cidx, const bf16* Hb, const float* MQ, const float* MK, const float* MC, const float* MN, const float* SCL,
                                               const float* BC, const float* IG, const float* nmg, bf16* CAT, int tid) {
    const int j = cidx & 127, h = (cidx >> 7) & 3, b = cidx >> 9, t0 = b * L + j * 64;
    LAS float* q = (LAS float*)lds;
    LAS float* k = q + 64 * 65;
    LAS float* v = k + 64 * 65;
    LAS float* C = v + 64 * 65;
    LAS float* S = C + 64 * 65;
    LAS float* hh = S + 64 * 65;
    LAS float* nn = hh + 64 * 65;
    LAS float* bb = nn + 64;
    LAS float* gi = bb + 64;
    LAS float* mrow = gi + 64;
    LAS float* den = mrow + 64;
    for (int i = tid; i < 4096; i += 512) {
        const int s = i >> 6, d = i & 63;
        q[s * 65 + d] = MQ[(size_t)(t0 + s) * 256 + h * 64 + d];
        k[s * 65 + d] = MK[(size_t)(t0 + s) * 256 + h * 64 + d];
        v[s * 65 + d] = bf2f(Hb[(size_t)(t0 + s) * HN + H_V + h * 64 + d]);
        C[s * 65 + d] = MC[(size_t)cidx * 4096 + i];
    }
    if (tid < 64) { nn[tid] = MN[(size_t)cidx * 64 + tid]; bb[tid] = BC[(size_t)(t0 + tid) * 4 + h]; gi[tid] = IG[(size_t)(t0 + tid) * 4 + h]; }
    const float m_in = SCL[cidx * 4 + 2];
    __syncthreads();
    if (tid < 64) {
        const int t = tid; const float bt = bb[t]; float rm = -INFINITY;
        for (int s = 0; s <= t; ++s) rm = fmaxf(rm, bt - bb[s] + gi[s]);
        mrow[t] = fmaxf(bt + m_in, rm);
    }
    __syncthreads();
    for (int i = tid; i < 4096; i += 512) {
        const int t = i >> 6, s = i & 63; float a = 0.f;
        if (s <= t) {
#pragma unroll 8
            for (int d = 0; d < 64; ++d) a += q[t * 65 + d] * k[s * 65 + d];
            a *= __expf(bb[t] - bb[s] + gi[s] - mrow[t]);
        }
        S[t * 65 + s] = a;
    }
    __syncthreads();
    if (tid < 64) {
        const int t = tid; float a = 0.f, nq = 0.f;
        for (int s = 0; s < 64; ++s) a += S[t * 65 + s];
        for (int d = 0; d < 64; ++d) nq += nn[d] * q[t * 65 + d];
        const float wi = __expf(bb[t] + m_in - mrow[t]);
        const float dn = a + wi * nq;
        den[t] = fmaxf(fabsf(dn), __expf(-mrow[t]));
    }
    __syncthreads();
    for (int i = tid; i < 4096; i += 512) {
        const int t = i >> 6, vv = i & 63; float a = 0.f, cq = 0.f;
#pragma unroll 8
        for (int s = 0; s < 64; ++s) a += S[t * 65 + s] * v[s * 65 + vv];
#pragma unroll 8
        for (int d = 0; d < 64; ++d) cq += C[vv * 65 + d] * q[t * 65 + d];
        const float wi = __expf(bb[t] + m_in - mrow[t]);
        hh[t * 65 + vv] = (a + wi * cq) / den[t];
    }
    __syncthreads();
    {
        const int wave = tid >> 6, lane = tid & 63;
        for (int t = wave; t < 64; t += 8) {
            const float x = hh[t * 65 + lane];
            const float mean = wave_sum(x) * (1.f / 64.f);
            const float dx = x - mean;
            const float var = wave_sum(dx * dx) * (1.f / 64.f);
            const float y = dx * rsqrtf(var + LN_EPS) * nmg[h * 64 + lane];
            const float og = bf2f(Hb[(size_t)(t0 + t) * HN + H_O + h * 64 + lane]);
            CAT[(size_t)(t0 + t) * CATW + CAT_C + h * 64 + lane] = (bf16)f2bf(sigmoidf_(og) * y);
        }
    }
    __syncthreads();
}

__device__ __forceinline__ void xattn_token(LAS unsigned char* wl, int t, const bf16* QX, const bf16* KV, bf16* OX, int lane) {
    LAS float* qs = (LAS float*)wl;
    LAS float* P = qs + 256;
    const int b = t >> 13;
    const bf16* kvb = KV + (size_t)b * 256 * 2048;
    for (int h = 0; h < 4; ++h) {
        for (int i = lane; i < 256; i += 64) qs[i] = bf2f(QX[(size_t)t * D + h * 256 + i]);
        WAVE_LDS_SYNC();
        float lg[4];
#pragma unroll
        for (int i = 0; i < 4; ++i) {
            const int m = lane + 64 * i;
            const bf16* kr = kvb + (size_t)m * 2048 + h * 256;
            float a = 0.f;
            for (int c = 0; c < 256; c += 8) {
                const v4u kk = *(const v4u*)(kr + c);
                a += lo16(kk.x) * qs[c] + hi16(kk.x) * qs[c + 1] + lo16(kk.y) * qs[c + 2] + hi16(kk.y) * qs[c + 3] + lo16(kk.z) * qs[c + 4] + hi16(kk.z) * qs[c + 5] + lo16(kk.w) * qs[c + 6] + hi16(kk.w) * qs[c + 7];
            }
            lg[i] = a * 0.0625f;
        }
        const float mx = wave_max(fmaxf(fmaxf(lg[0], lg[1]), fmaxf(lg[2], lg[3])));
        float e[4], sm = 0.f;
#pragma unroll
        for (int i = 0; i < 4; ++i) { e[i] = __expf(lg[i] - mx); sm += e[i]; }
        const float inv = 1.f / wave_sum(sm);
#pragma unroll
        for (int i = 0; i < 4; ++i) P[lane + 64 * i] = e[i] * inv;
        WAVE_LDS_SYNC();
        float o[4] = { 0.f, 0.f, 0.f, 0.f };
        for (int m = 0; m < 256; ++m) {
            const float p = P[m];
            const bf16* vr = kvb + (size_t)m * 2048 + 1024 + h * 256;
#pragma unroll
            for (int i = 0; i < 4; ++i) o[i] += p * bf2f(vr[lane + 64 * i]);
        }
#pragma unroll
        for (int i = 0; i < 4; ++i) OX[(size_t)t * D + h * 256 + lane + 64 * i] = (bf16)f2bf(o[i]);
        WAVE_LDS_SYNC();
    }
}

__device__ __forceinline__ unsigned cvt_pk_bf16_(float lo, float hi) { unsigned r; asm volatile("v_cvt_pk_bf16_f32 %0, %1, %2" : "=v"(r) : "v"(lo), "v"(hi)); return r; }
typedef unsigned u32x4_ __attribute__((ext_vector_type(4)));
__device__ __forceinline__ void xattn_unit(int unit, const bf16* QX, const bf16* Kb, const bf16* VT, bf16* OX, int lane) {
    const int strip = unit >> 2, hd = unit & 3;
    const int t0 = strip * 32, b = t0 >> 13;
    const int r = lane & 31, h = lane >> 5;
    const int sig = 16 * ((r >> 2) & 1) + 4 * (r >> 3) + (r & 3);
    bf16x8s Qf[16];
    {
        const bf16* qp = QX + (size_t)(t0 + r) * D + hd * 256 + 16 * h;
#pragma unroll
        for (int p = 0; p < 8; ++p) { Qf[2 * p] = *(const bf16x8s*)(qp + 32 * p); Qf[2 * p + 1] = *(const bf16x8s*)(qp + 32 * p + 8); }
    }
    f32x16 S[8];
#pragma unroll
    for (int kb = 0; kb < 8; ++kb) {
#pragma unroll
        for (int i = 0; i < 16; ++i) S[kb][i] = 0.f;
        const bf16* kp = Kb + (size_t)(b * 256 + kb * 32 + sig) * D + hd * 256 + 16 * h;
#pragma unroll
        for (int p = 0; p < 8; ++p) {
            if ((p & 3) == 0) asm volatile("" ::: "memory");
            const bf16x8s k0 = *(const bf16x8s*)(kp + 32 * p), k1 = *(const bf16x8s*)(kp + 32 * p + 8);
            S[kb] = __builtin_amdgcn_mfma_f32_32x32x16_bf16(k0, Qf[2 * p], S[kb], 0, 0, 0);
            S[kb] = __builtin_amdgcn_mfma_f32_32x32x16_bf16(k1, Qf[2 * p + 1], S[kb], 0, 0, 0);
        }
    }
    float mx = -INFINITY;
#pragma unroll
    for (int kb = 0; kb < 8; ++kb)
#pragma unroll
        for (int i = 0; i < 16; ++i) mx = fmaxf(mx, S[kb][i]);
    mx = fmaxf(mx, __shfl_xor(mx, 32));
    const float c = 0.0625f * 1.4426950408889634f;
    float sum = 0.f;
    bf16x8s Pf[16];
#pragma unroll
    for (int kb = 0; kb < 8; ++kb) {
#pragma unroll
        for (int i = 0; i < 16; ++i) { const float e = __builtin_amdgcn_exp2f((S[kb][i] - mx) * c); S[kb][i] = e; sum += e; }
#pragma unroll
        for (int s2 = 0; s2 < 2; ++s2) {
            u32x4_ w;
            w.x = cvt_pk_bf16_(S[kb][8 * s2 + 0], S[kb][8 * s2 + 1]); w.y = cvt_pk_bf16_(S[kb][8 * s2 + 2], S[kb][8 * s2 + 3]);
            w.z = cvt_pk_bf16_(S[kb][8 * s2 + 4], S[kb][8 * s2 + 5]); w.w = cvt_pk_bf16_(S[kb][8 * s2 + 6], S[kb][8 * s2 + 7]);
            Pf[2 * kb + s2] = __builtin_bit_cast(bf16x8s, w);
        }
    }
    sum += __shfl_xor(sum, 32);
    const float inv = 1.f / sum;
    bf16* op = OX + (size_t)(t0 + r) * D + hd * 256 + 4 * h;
#pragma unroll
    for (int db = 0; db < 8; ++db) {
        f32x16 O;
#pragma unroll
        for (int i = 0; i < 16; ++i) O[i] = 0.f;
        const bf16* vp = VT + (size_t)(hd * 256 + db * 32 + r) * 512 + b * 256 + 16 * h;
#pragma unroll
        for (int kb = 0; kb < 8; ++kb) {
            if ((kb & 3) == 0) asm volatile("" ::: "memory");
            const bf16x8s v0 = *(const bf16x8s*)(vp + 32 * kb), v1 = *(const bf16x8s*)(vp + 32 * kb + 8);
            O = __builtin_amdgcn_mfma_f32_32x32x16_bf16(v0, Pf[2 * kb], O, 0, 0, 0);
            O = __builtin_amdgcn_mfma_f32_32x32x16_bf16(v1, Pf[2 * kb + 1], O, 0, 0, 0);
        }
#pragma unroll
        for (int g = 0; g < 4; ++g) {
            v2u w; w.x = pk2(O[4 * g] * inv, O[4 * g + 1] * inv); w.y = pk2(O[4 * g + 2] * inv, O[4 * g + 3] * inv);
            *(v2u*)(op + db * 32 + 8 * g) = w;
        }
    }
}

typedef short s16x4 __attribute__((ext_vector_type(4)));
__device__ __forceinline__ unsigned off_b(unsigned row, unsigned ch) { return 256u * row + 16u * (ch ^ (((row & 3u) << 2) | ((row >> 2) & 3u))); }
constexpr int DSA_TILE = 8192;
__device__ __forceinline__ void dsa_fill(LAS unsigned char* tile, const LAS int* slb, const bf16* ckv_b, int ck, int lane) {
    const int pos = lane & 15;
#pragma unroll
    for (int i = 0; i < 8; ++i) {
        const int row = 4 * i + (lane >> 4);
        const int s = slb[ck * 32 + row] & 0xffff;
        const unsigned ch = (unsigned)pos ^ ((((unsigned)row & 3u) << 2) | (((unsigned)row >> 2) & 3u));
        __builtin_amdgcn_global_load_lds((const unsigned*)(ckv_b + (size_t)s * 128 + ch * 8), (LAS unsigned*)(tile + i * 1024), 16, 0, 0);
    }
}
__device__ __forceinline__ void dsa_attn_mfma(LAS unsigned char* wl, LAS int* slb, const LAS float* relb_l, int t, const bf16* Hb, const bf16* CKV,
                                              const unsigned short* SEL, const int* NSEL, bf16* CAT, int lane) {
    const int hd = lane & 15, G = lane >> 4;
    const int b = t >> 13, pos = t & (L - 1), n = NSEL[t];
    const bf16* ckv_b = CKV + (size_t)b * L * 128;
    for (int i = lane; i < 256; i += 64) { const int s = (i < n) ? (int)SEL[(size_t)t * 256 + i] : 0; slb[i] = s | (rel_bucket(pos - s) << 16); }
    bf16x8s Qf[4];
#pragma unroll
    for (int s = 0; s < 4; ++s) {
        if (hd < 8) Qf[s] = *(const bf16x8s*)(Hb + (size_t)t * HN + H_QL + hd * 128 + 32 * s + 8 * G);
        else {
#pragma unroll
            for (int j = 0; j < 8; ++j) Qf[s][j] = 0;
        }
    }
    WAVE_LDS_SYNC();
    const int nch = (n + 31) >> 5;
    dsa_fill(wl, slb, ckv_b, 0, lane);
    float m = -INFINITY, lsum = 0.f;
    f32x4 O[8];
#pragma unroll
    for (int c = 0; c < 8; ++c) O[c] = (f32x4){0.f, 0.f, 0.f, 0.f};
    const unsigned q4 = (unsigned)(lane & 15) >> 2, p4 = (unsigned)lane & 3u;
    for (int ck = 0; ck < nch; ++ck) {
        LAS unsigned char* tile = wl + (ck & 1) * DSA_TILE;
        WAVE_LDS_SYNC();
        if (ck + 1 < nch) { dsa_fill(wl + ((ck + 1) & 1) * DSA_TILE, slb, ckv_b, ck + 1, lane); asm volatile("s_waitcnt vmcnt(8)" ::: "memory"); }
        else asm volatile("s_waitcnt vmcnt(0)" ::: "memory");
        f32x4 acc[2];
#pragma unroll
        for (int rb = 0; rb < 2; ++rb) {
            acc[rb] = (f32x4){0.f, 0.f, 0.f, 0.f};
#pragma unroll
            for (int s = 0; s < 4; ++s) {
                const bf16x8s A = *(const LAS bf16x8s*)(tile + off_b((unsigned)hd + 16u * rb, 4u * s + (unsigned)G));
                acc[rb] = __builtin_amdgcn_mfma_f32_16x16x32_bf16(A, Qf[s], acc[rb], 0, 0, 0);
            }
        }
        float lg[8]; float cm = -INFINITY;
#pragma unroll
        for (int rb = 0; rb < 2; ++rb)
#pragma unroll
            for (int rg = 0; rg < 4; ++rg) {
                const int kk = ck * 32 + 16 * rb + 4 * G + rg;
                const int e = slb[kk];
                const float bias = relb_l[(e >> 16) * 8 + (hd & 7)];
                const float v = (hd < 8) ? (acc[rb][rg] * 0.125f + bias) : 0.f;
                lg[4 * rb + rg] = (kk < n) ? v : -INFINITY;
                cm = fmaxf(cm, lg[4 * rb + rg]);
            }
        cm = fmaxf(cm, __shfl_xor(cm, 16)); cm = fmaxf(cm, __shfl_xor(cm, 32));
        const float mn = fmaxf(m, cm);
        const float scale = __expf(m - mn);
        float ps = 0.f;
#pragma unroll
        for (int j = 0; j < 8; ++j) { lg[j] = __expf(lg[j] - mn); ps += lg[j]; }
        ps += __shfl_xor(ps, 16); ps += __shfl_xor(ps, 32);
        lsum = lsum * scale + ps; m = mn;
        u32x4_ pw; pw.x = cvt_pk_bf16_(lg[0], lg[1]); pw.y = cvt_pk_bf16_(lg[2], lg[3]); pw.z = cvt_pk_bf16_(lg[4], lg[5]); pw.w = cvt_pk_bf16_(lg[6], lg[7]);
        const bf16x8s Pf = __builtin_bit_cast(bf16x8s, pw);
#pragma unroll
        for (int c = 0; c < 8; ++c) {
            const s16x4 c0 = __builtin_amdgcn_ds_read_tr16_b64_v4i16((LAS s16x4*)(tile + off_b(4u * G + q4, 2u * c + (p4 >> 1)) + 8u * (p4 & 1u)));
            const s16x4 c1 = __builtin_amdgcn_ds_read_tr16_b64_v4i16((LAS s16x4*)(tile + off_b(16u + 4u * G + q4, 2u * c + (p4 >> 1)) + 8u * (p4 & 1u)));
            bf16x8s A; A[0] = c0[0]; A[1] = c0[1]; A[2] = c0[2]; A[3] = c0[3]; A[4] = c1[0]; A[5] = c1[1]; A[6] = c1[2]; A[7] = c1[3];
            O[c] = O[c] * scale;
            O[c] = __builtin_amdgcn_mfma_f32_16x16x32_bf16(A, Pf, O[c], 0, 0, 0);
        }
    }
    const float inv = 1.f / lsum;
    if (hd < 8) {
        bf16* op = CAT + (size_t)t * CATW + CAT_B + hd * 128 + 4 * G;
#pragma unroll
        for (int c = 0; c < 8; ++c) { v2u w; w.x = pk2(O[c][0] * inv, O[c][1] * inv); w.y = pk2(O[c][2] * inv, O[c][3] * inv); *(v2u*)(op + 16 * c) = w; }
    }
    WAVE_LDS_SYNC();
}

__device__ __forceinline__ float gelu_exact(float x) { return 0.5f * x * (1.f + erff(x * 0.70710678118654752f)); }

template <int N> __device__ __forceinline__ void bitonic_desc(unsigned (&a)[N]) {
#pragma unroll
    for (int k = 2; k <= N; k <<= 1) {
#pragma unroll
        for (int j = k >> 1; j > 0; j >>= 1) {
#pragma unroll
            for (int i = 0; i < N; ++i) {
                const int l = i ^ j;
                if (l > i) {
                    const unsigned x = a[i], y = a[l];
                    const unsigned mx = x > y ? x : y, mn = x > y ? y : x;
                    if ((i & k) == 0) { a[i] = mx; a[l] = mn; } else { a[i] = mn; a[l] = mx; }
                }
            }
        }
    }
}
__device__ __forceinline__ float funkey(unsigned k) { return __uint_as_float((k & 0x80000000u) ? (k & 0x7fffffffu) : ~k); }

__device__ __forceinline__ void bitonic_merge16_desc(unsigned (&a)[16]) {
#pragma unroll
    for (int j = 8; j > 0; j >>= 1) {
#pragma unroll
        for (int i = 0; i < 16; ++i) {
            const int l = i ^ j;
            if (l > i) { const unsigned x = a[i], y = a[l]; a[i] = x > y ? x : y; a[l] = x > y ? y : x; }
        }
    }
}
__device__ __forceinline__ void merge_top16(unsigned (&top)[16], const unsigned (&b)[16]) {
#pragma unroll
    for (int i = 0; i < 16; ++i) top[i] = top[i] > b[15 - i] ? top[i] : b[15 - i];
    bitonic_merge16_desc(top);
}

__device__ __forceinline__ void peer_route_unit(const LAS unsigned char* sk, int t0, int tokl0, const bf16* QP, LAS int* EL, LAS float* GL, int lane) {
    asm volatile("" : "+v"(lane));
    const int r = lane & 31, h = lane >> 5, tokl = r >> 3, hh = r & 7;
    unsigned top[2][16];
#pragma unroll
    for (int sd = 0; sd < 2; ++sd) {
        bf16x8s Qf[8];
        {
            const bf16* qrow = QP + (size_t)(t0 + tokl) * 2048 + hh * 256 + 8 * h + sd * 128;
#pragma unroll
            for (int s = 0; s < 8; ++s) Qf[s] = *(const bf16x8s*)(qrow + 16 * s);
        }
#pragma unroll
        for (int kb = 0; kb < 4; ++kb) {
            f32x16 acc;
#pragma unroll
            for (int i = 0; i < 16; ++i) acc[i] = 0.f;
            const int n = kb * 32 + r;
            asm volatile("" ::: "memory");
#pragma unroll
            for (int s = 0; s < 8; ++s) {
                const bf16x8s A = *(const LAS bf16x8s*)(sk + sd * 32768 + n * 256 + (((2 * s + h) ^ (n & 15)) << 4));
                acc = __builtin_amdgcn_mfma_f32_32x32x16_bf16(A, Qf[s], acc, 0, 0, 0);
            }
            unsigned ky[16];
#pragma unroll
            for (int i = 0; i < 16; ++i) { const int c7 = 127 - (kb * 32 + (i & 3) + 8 * (i >> 2)); ky[i] = ((fkey(acc[i]) & ~127u) | (unsigned)c7) ^ (unsigned)(4 * h); }
            bitonic_desc<16>(ky);
            if (kb == 0) {
#pragma unroll
                for (int i = 0; i < 16; ++i) top[sd][i] = ky[i];
            } else merge_top16(top[sd], ky);
            __builtin_amdgcn_sched_barrier(0);
        }
        unsigned o16[16];
#pragma unroll
        for (int i = 0; i < 16; ++i) o16[i] = (unsigned)__shfl_xor((int)top[sd][i], 32);
        merge_top16(top[sd], o16);
        __builtin_amdgcn_sched_barrier(0);
    }
    float v1[16], v2[16]; unsigned P1[4] = {0u, 0u, 0u, 0u}, P2[4] = {0u, 0u, 0u, 0u};
#pragma unroll
    for (int a = 0; a < 16; ++a) {
        v1[a] = funkey(top[0][a] & ~127u); v2[a] = funkey(top[1][a] & ~127u);
        P1[a >> 2] |= (127u - (top[0][a] & 127u)) << (8 * (a & 3)); P2[a >> 2] |= (127u - (top[1][a] & 127u)) << (8 * (a & 3));
    }
#define CKEY(a, b) ((fkey(v1[a] + v2[b]) & ~255u) | (unsigned)(255 - ((a) * 16 + (b))))
    unsigned ctop[16], g[16];
#pragma unroll
    for (int b = 0; b < 16; ++b) ctop[b] = CKEY(0, b);
#pragma unroll
    for (int b = 0; b < 8; ++b) { g[b] = CKEY(1, b); g[15 - b] = CKEY(8 + b, 0); }
    bitonic_merge16_desc(g);
    merge_top16(ctop, g);
    g[0] = CKEY(2, 0); g[1] = CKEY(2, 1); g[2] = CKEY(2, 2); g[3] = CKEY(2, 3); g[4] = CKEY(2, 4);
    g[5] = CKEY(3, 0); g[6] = CKEY(3, 1); g[7] = CKEY(3, 2); g[8] = CKEY(3, 3);
    g[9] = CKEY(4, 0); g[10] = CKEY(4, 1); g[11] = CKEY(4, 2);
    g[12] = CKEY(5, 0); g[13] = CKEY(5, 1); g[14] = CKEY(6, 0); g[15] = CKEY(6, 1);
    bitonic_desc<16>(g);
    merge_top16(ctop, g);
    {
        const unsigned c0 = CKEY(7, 0), c1 = CKEY(7, 1);
        g[0] = c0 > c1 ? c0 : c1; g[1] = c0 > c1 ? c1 : c0;
#pragma unroll
        for (int i = 2; i < 16; ++i) g[i] = 0u;
        merge_top16(ctop, g);
    }
#undef CKEY
    float ex[16], sum = 0.f;
    const float mx = funkey(ctop[0] & ~255u);
#pragma unroll
    for (int j = 0; j < 16; ++j) { ex[j] = __expf(funkey(ctop[j] & ~255u) - mx); sum += ex[j]; }
    const float inv = 1.f / sum;
    LAS int* el = EL + (tokl0 + tokl) * 128 + hh * 16; LAS float* gl = GL + (tokl0 + tokl) * 128 + hh * 16;
#pragma unroll
    for (int j = 0; j < 16; ++j) {
        const unsigned flat = 255u - (ctop[j] & 255u), a = flat >> 4, b = flat & 15u;
        const unsigned w1 = (a >> 2) == 0 ? P1[0] : (a >> 2) == 1 ? P1[1] : (a >> 2) == 2 ? P1[2] : P1[3];
        const unsigned w2 = (b >> 2) == 0 ? P2[0] : (b >> 2) == 1 ? P2[1] : (b >> 2) == 2 ? P2[2] : P2[3];
        const unsigned i1 = (w1 >> (8 * (a & 3))) & 255u, i2 = (w2 >> (8 * (b & 3))) & 255u;
        if (h == 0) el[j] = (int)(i1 * 128u + i2); else gl[j] = ex[j] * inv;
    }
}

typedef float f32x2_ __attribute__((ext_vector_type(2)));
__device__ __forceinline__ float dot16_fp8(v4u w, const float (&x)[16]) {
    const f32x2_ a0 = __builtin_amdgcn_cvt_pk_f32_fp8((int)w.x, false), a1 = __builtin_amdgcn_cvt_pk_f32_fp8((int)w.x, true);
    const f32x2_ b0 = __builtin_amdgcn_cvt_pk_f32_fp8((int)w.y, false), b1 = __builtin_amdgcn_cvt_pk_f32_fp8((int)w.y, true);
    const f32x2_ c0 = __builtin_amdgcn_cvt_pk_f32_fp8((int)w.z, false), c1 = __builtin_amdgcn_cvt_pk_f32_fp8((int)w.z, true);
    const f32x2_ d0 = __builtin_amdgcn_cvt_pk_f32_fp8((int)w.w, false), d1 = __builtin_amdgcn_cvt_pk_f32_fp8((int)w.w, true);
    return ((a0.x * x[0] + a0.y * x[1]) + (a1.x * x[2] + a1.y * x[3])) + ((b0.x * x[4] + b0.y * x[5]) + (b1.x * x[6] + b1.y * x[7]))
         + ((c0.x * x[8] + c0.y * x[9]) + (c1.x * x[10] + c1.y * x[11])) + ((d0.x * x[12] + d0.y * x[13]) + (d1.x * x[14] + d1.y * x[15]));
}
__device__ __forceinline__ void axpy16_fp8(float c, v4u w, float (&o)[16]) {
    const f32x2_ a0 = __builtin_amdgcn_cvt_pk_f32_fp8((int)w.x, false), a1 = __builtin_amdgcn_cvt_pk_f32_fp8((int)w.x, true);
    const f32x2_ b0 = __builtin_amdgcn_cvt_pk_f32_fp8((int)w.y, false), b1 = __builtin_amdgcn_cvt_pk_f32_fp8((int)w.y, true);
    const f32x2_ c0 = __builtin_amdgcn_cvt_pk_f32_fp8((int)w.z, false), c1 = __builtin_amdgcn_cvt_pk_f32_fp8((int)w.z, true);
    const f32x2_ d0 = __builtin_amdgcn_cvt_pk_f32_fp8((int)w.w, false), d1 = __builtin_amdgcn_cvt_pk_f32_fp8((int)w.w, true);
    o[0] += c * a0.x; o[1] += c * a0.y; o[2] += c * a1.x; o[3] += c * a1.y; o[4] += c * b0.x; o[5] += c * b0.y; o[6] += c * b1.x; o[7] += c * b1.y;
    o[8] += c * c0.x; o[9] += c * c0.y; o[10] += c * c1.x; o[11] += c * c1.y; o[12] += c * d0.x; o[13] += c * d0.y; o[14] += c * d1.x; o[15] += c * d1.y;
}
__device__ __forceinline__ void peer_experts_token(const LAS int* el, const LAS float* gl, int t, const unsigned char* PU8, const unsigned char* PV8, const float* SCU, const float* SCV,
                                                   const float* g3, const float* b3, float* xio, bf16* XB, int lane, int flags) {
    asm volatile("" : "+v"(lane) :: "memory");
    float x[16], o[16];
    {
        const f32x4* xr = (const f32x4*)(xio + (size_t)t * D) + 4 * lane;
#pragma unroll
        for (int i = 0; i < 4; ++i) { const f32x4 v = xr[i]; x[4 * i] = v.x; x[4 * i + 1] = v.y; x[4 * i + 2] = v.z; x[4 * i + 3] = v.w; }
    }
#pragma unroll
    for (int i = 0; i < 16; ++i) o[i] = 0.f;
    const bool b5 = (lane & 32) != 0, b4 = (lane & 16) != 0, b3b = (lane & 8) != 0;
    const int mine = (lane >> 3) & 7;
    if (flags & 2) for (int e0 = 0; e0 < 128; e0 += 8) {
        float p[8];
#pragma unroll
        for (int r = 0; r < 8; ++r) {
            const int id = el[e0 + r];
            const v4u ua = *(const v4u*)(PU8 + (size_t)id * 1024 + 16 * lane);
            p[r] = dot16_fp8(ua, x);
        }
        const int idm = el[e0 + mine];
        const float su = SCU[idm], sv = SCV[idm];
        float q4[4], r2[2], s;
#pragma unroll
        for (int i = 0; i < 4; ++i) { const float send = b5 ? p[i] : p[i + 4]; const float recv = __shfl_xor(send, 32); q4[i] = (b5 ? p[i + 4] : p[i]) + recv; }
#pragma unroll
        for (int i = 0; i < 2; ++i) { const float send = b4 ? q4[i] : q4[i + 2]; const float recv = __shfl_xor(send, 16); r2[i] = (b4 ? q4[i + 2] : q4[i]) + recv; }
        { const float send = b3b ? r2[0] : r2[1]; const float recv = __shfl_xor(send, 8); s = (b3b ? r2[1] : r2[0]) + recv; }
        s += __shfl_xor(s, 4); s += __shfl_xor(s, 2); s += __shfl_xor(s, 1);
        const float coef = gelu_exact(s * su) * gl[e0 + mine] * sv;
#pragma unroll
        for (int r = 0; r < 8; ++r) {
            const float cr = __shfl(coef, r * 8);
            const int id = el[e0 + r];
            const v4u va = *(const v4u*)(PV8 + (size_t)id * 1024 + 16 * lane);
            axpy16_fp8(cr, va, o);
        }
    }
    float s1 = 0.f;
#pragma unroll
    for (int i = 0; i < 16; ++i) { o[i] = ALPHA * x[i] + o[i]; s1 += o[i]; }
    const float mean = wave_sum(s1) * (1.f / D);
    float s2 = 0.f;
#pragma unroll
    for (int i = 0; i < 16; ++i) { o[i] -= mean; s2 += o[i] * o[i]; }
    const float rstd = rsqrtf(wave_sum(s2) * (1.f / D) + LN_EPS);
    {
        asm volatile("" ::: "memory");
        const f32x4* gr = (const f32x4*)g3 + 4 * lane; const f32x4* br = (const f32x4*)b3 + 4 * lane;
        f32x4* xo = (f32x4*)(xio + (size_t)t * D) + 4 * lane;
        v4u* xbo = (v4u*)(XB + (size_t)t * D) + 2 * lane;
        if (flags & 4) { xo = (f32x4*)((unsigned char*)XB + (WS_CAT - WS_XB)) + (size_t)(t & 255) * 256 + 4 * lane; xbo = (v4u*)((unsigned char*)XB + (WS_CAT - WS_XB) + 2097152) + (size_t)(t & 255) * 128 + 2 * lane; }
        f32x4 y[4];
#pragma unroll
        for (int i = 0; i < 4; ++i) { const f32x4 g = gr[i], b = br[i];
            y[i].x = o[4 * i] * rstd * g.x + b.x; y[i].y = o[4 * i + 1] * rstd * g.y + b.y; y[i].z = o[4 * i + 2] * rstd * g.z + b.z; y[i].w = o[4 * i + 3] * rstd * g.w + b.w;
            xo[i] = y[i]; }
        v4u w0, w1;
        w0.x = pk2(y[0].x, y[0].y); w0.y = pk2(y[0].z, y[0].w); w0.z = pk2(y[1].x, y[1].y); w0.w = pk2(y[1].z, y[1].w);
        w1.x = pk2(y[2].x, y[2].y); w1.y = pk2(y[2].z, y[2].w); w1.z = pk2(y[3].x, y[3].y); w1.w = pk2(y[3].z, y[3].w);
        xbo[0] = w0; xbo[1] = w1;
    }
}

constexpr int PH_PER_LAYER = 12, NPH = 1 + 2 * PH_PER_LAYER;

#define PHASE_ENV() KArgs ap = kargs(); unsigned char* const ws = ap->ws; const int tid = threadIdx.x, lane = tid & 63, wave = __builtin_amdgcn_readfirstlane(tid >> 6); \
    const int G = gridDim.x, bid = blockIdx.x, sub = ap->sub; (void)sub; (void)ws; (void)lane; (void)wave; (void)G; (void)bid
#define P_XB   ((bf16*)(ws + WS_XB))
#define P_HB   ((bf16*)(ws + WS_HB))
#define P_HS   ((float*)(ws + WS_HS))
#define P_CAT  ((bf16*)(ws + WS_CAT))
#define P_CKV  ((bf16*)(ws + WS_CKV))
#define P_SEL  ((unsigned short*)(ws + WS_SEL))
#define P_NSEL ((int*)(ws + WS_NSEL))
#define P_MQ   ((float*)(ws + WS_MQ))
#define P_MK   ((float*)(ws + WS_MK))
#define P_MC   ((float*)(ws + WS_MC))
#define P_MN   ((float*)(ws + WS_MN))
#define P_SCL  ((float*)(ws + WS_SCL))
#define P_BC   ((float*)(ws + WS_BC))
#define P_IG   ((float*)(ws + WS_IG))
#define P_QX   ((bf16*)(ws + WS_QX))
#define P_OX   ((bf16*)(ws + WS_OX))
#define P_QP   ((bf16*)(ws + WS_QP))

#ifndef ONLYSITE
#define SITE(j) true
#else
#define SITE(j) ((j) == ONLYSITE)
#endif
#define IN(k) (lo <= (k) && (k) < hi)
#define SEAM(k) do { if (IN(k) && IN((k) + 1)) xcd_barrier(bar); } while (0)


template <int l>
__device__ __forceinline__ void run_layer(LAS unsigned char* lds, const int lo, const int hi, const XcdBarrier& bar) {
        const int pb = 1 + PH_PER_LAYER * l;
        if (IN(pb + 0) && SITE(1)) {
            PHASE_ENV();
            {
                pg8::Gemm g{P_XB, (const bf16*)(ws + WS_WIN) + (size_t)l * HN * D, T, HN, D}; pg8::StaticOrder S; S.init(T, HN, G, bid);
                EpiH E{P_HB, P_HS};
                pg8::gemm_phase<EpiH, pg8::StaticOrder, true, true>(lds, g, S, E);
            }
            if (l == 0) {
                for (int l2 = 0; l2 < 2; ++l2) {
                    __syncthreads();
                    {
                        pg8::Gemm g2{(const bf16*)(ws + WS_MEMB), (const bf16*)(ws + WS_WCKV) + (size_t)l2 * 2048 * D, 512, 1024, D}; pg8::StaticOrder S2; S2.init(512, 1024, G, bid);
                        EpiB16 E2{(bf16*)(ws + WS_KV) + (size_t)l2 * 512 * 1024, 1024};
                        pg8::gemm_phase<EpiB16, pg8::StaticOrder, true, true>(lds, g2, S2, E2);
                    }
                    __syncthreads();
                    {
                        pg8::Gemm g3{(const bf16*)(ws + WS_WCKV) + (size_t)l2 * 2048 * D + (size_t)1024 * D, (const bf16*)(ws + WS_MEMB), 1024, 512, D}; pg8::StaticOrder S3; S3.init(1024, 512, G, bid);
                        EpiB16 E3{(bf16*)(ws + WS_KV) + (size_t)(2 + l2) * 512 * 1024, 512};
                        pg8::gemm_phase<EpiB16, pg8::StaticOrder, true, true>(lds, g3, S3, E3);
                    }
                }
            }
        }
        SEAM(pb + 0);
        if (IN(pb + 1) && SITE(2)) {
            PHASE_ENV();
            if (sub & 1) for (int tile = bid; tile < T / 64; tile += G)
                conv_unit(lds, tile, P_HB, ap->in[I_CAW] + (size_t)l * 31 * 256, ap->in[I_CAB] + l * 256, ap->in[I_NAG] + l * 256, ap->in[I_NAB] + l * 256, P_CAT, tid);
            if (sub & 2) {
                const float* kg = ap->in[I_KVG] + l * 128; const bf16* HB = P_HB; bf16* CKV = P_CKV;
                for (int t = bid * 8 + wave; t < T; t += G * 8) {
                    const float c0 = bf2f(HB[(size_t)t * HN + H_CB + lane]), c1 = bf2f(HB[(size_t)t * HN + H_CB + 64 + lane]);
                    const float r = rsqrtf(wave_sum(c0 * c0 + c1 * c1) * (1.f / 128.f) + LN_EPS);
                    CKV[(size_t)t * 128 + lane] = (bf16)f2bf(c0 * r * kg[lane]); CKV[(size_t)t * 128 + 64 + lane] = (bf16)f2bf(c1 * r * kg[64 + lane]);
                }
            }
            if (sub & 4) for (int cidx = bid; cidx < NCHUNK; cidx += G)
                mlstm_prep_unit(lds, cidx, P_HB, P_HS, ap->in[I_CMW] + (size_t)l * 4 * 256, ap->in[I_CMB] + l * 256, ap->in[I_WQM] + (size_t)l * 4 * 4096, ap->in[I_WKM] + (size_t)l * 4 * 4096,
                                ap->in[I_BI] + l * 4, ap->in[I_BF] + l * 4, P_MQ, P_MK, P_MC, P_MN, P_SCL, P_BC, P_IG, tid);
#ifdef NAIVE_INDEXER
            if (sub & 8) for (int t = bid; t < T; t += G) indexer_query(lds, t, P_HB, P_HS, P_SEL, P_NSEL, tid);
#else
            if (sub & 8) for (int pr = bid; pr < 256; pr += G) {
                const int b = pr >> 7, i0 = pr & 127;
                indexer_strip(lds, b, 255 - i0, P_HB, P_HS, P_SEL, P_NSEL, tid);
                indexer_strip(lds, b, i0, P_HB, P_HS, P_SEL, P_NSEL, tid);
            }
#endif
        }
        SEAM(pb + 1);
        if (IN(pb + 2) && SITE(3)) {
            PHASE_ENV();
            if ((sub & 1) && bid < 65) mlstm_scan(bid * 512 + tid, P_MC, P_MN, P_SCL);
#ifdef NAIVE_DSA
            if (sub & 2) for (int t = bid * 8 + wave; t < T; t += G * 8) dsa_attn_query(lds + wave * 16384, t, P_HB, P_CKV, P_SEL, P_NSEL, ap->in[I_RELB], P_CAT, lane);
#else
            if (sub & 2) {
                LAS float* relb_l = (LAS float*)(lds + 131072 + 1024);
                if (tid < 256) relb_l[tid] = ap->in[I_RELB][tid];
                __syncthreads();
                LAS int* slb = (LAS int*)(lds + 131072 + 2048 + wave * 1024);
                for (int t = bid * 8 + wave; t < T; t += G * 8) dsa_attn_mfma(lds + wave * 16384, slb, relb_l, t, P_HB, P_CKV, P_SEL, P_NSEL, P_CAT, lane);
            }
#endif
        }
        SEAM(pb + 2);
        if (IN(pb + 3) && SITE(4)) {
            PHASE_ENV();
            for (int cidx = bid; cidx < NCHUNK; cidx += G)
                mlstm_out_unit(lds, cidx, P_HB, P_MQ, P_MK, P_MC, P_MN, P_SCL, P_BC, P_IG, ap->in[I_NMG] + l * 256, P_CAT, tid);
        }
        SEAM(pb + 3);
        if (IN(pb + 4) && SITE(5)) {
            PHASE_ENV();
            pg8::Gemm g{P_CAT, (const bf16*)(ws + WS_WOUT) + (size_t)l * D * CATW, T, D, CATW}; pg8::StaticOrder S; S.init(T, D, G, bid);
            EpiResid E{ap->out, D, ALPHA};
            pg8::gemm_phase<EpiResid, pg8::StaticOrder, true, true>(lds, g, S, E);
        }
        SEAM(pb + 4);
        if (IN(pb + 5) && SITE(6)) {
            PHASE_ENV();
            float* X = ap->out; bf16* XB = P_XB; const float* g1 = ap->in[I_LN1G] + l * D; const float* b1 = ap->in[I_LN1B] + l * D;
            for (int m = bid * 8 + wave; m < T; m += G * 8) ln_row(X + (size_t)m * D, g1, b1, X + (size_t)m * D, XB + (size_t)m * D, lane);
        }
        SEAM(pb + 5);
        if (IN(pb + 6) && SITE(7)) {
            PHASE_ENV();
            pg8::Gemm g{P_XB, (const bf16*)(ws + WS_WCQ) + (size_t)l * D * D, T, D, D}; pg8::StaticOrder S; S.init(T, D, G, bid);
            EpiB16 E{P_QX, D};
            pg8::gemm_phase<EpiB16, pg8::StaticOrder, true, true>(lds, g, S, E);
        }
        SEAM(pb + 6);
        if (IN(pb + 7) && SITE(8)) {
            PHASE_ENV();
            const bf16* Kb = (const bf16*)(ws + WS_KV) + (size_t)l * 512 * 1024; const bf16* VT = (const bf16*)(ws + WS_KV) + (size_t)(2 + l) * 512 * 1024;
            for (int u = bid * 8 + wave; u < 2048; u += G * 8) xattn_unit(u, P_QX, Kb, VT, P_OX, lane);
        }
        SEAM(pb + 7);
        if (IN(pb + 8) && SITE(9)) {
            PHASE_ENV();
            pg8::Gemm g{P_OX, (const bf16*)(ws + WS_WCO) + (size_t)l * D * D, T, D, D}; pg8::StaticOrder S; S.init(T, D, G, bid);
            EpiResid E{ap->out, D, ALPHA};
            pg8::gemm_phase<EpiResid, pg8::StaticOrder, true, true>(lds, g, S, E);
        }
        SEAM(pb + 8);
        if (IN(pb + 9) && SITE(10)) {
            PHASE_ENV();
            float* X = ap->out; bf16* XB = P_XB; const float* g2 = ap->in[I_LN2G] + l * D; const float* b2 = ap->in[I_LN2B] + l * D;
            for (int m = bid * 8 + wave; m < T; m += G * 8) ln_row(X + (size_t)m * D, g2, b2, X + (size_t)m * D, XB + (size_t)m * D, lane);
        }
        SEAM(pb + 9);
        if (IN(pb + 10) && SITE(11)) {
            PHASE_ENV();
            pg8::Gemm g{P_XB, (const bf16*)(ws + WS_WPQ) + (size_t)l * 2048 * D, T, 2048, D}; pg8::StaticOrder S; S.init(T, 2048, G, bid);
            EpiB16 E{P_QP, 2048};
            pg8::gemm_phase<EpiB16, pg8::StaticOrder, true, true>(lds, g, S, E);
        }
        SEAM(pb + 10);
        if (IN(pb + 11) && SITE(12)) {
            PHASE_ENV();
            LAS unsigned char* sk = lds; LAS int* EL = (LAS int*)(lds + 65536); LAS float* GL = (LAS float*)(lds + 98304);
            const float* k1 = ap->in[I_SK1] + (size_t)l * 128 * 128; const float* k2 = ap->in[I_SK2] + (size_t)l * 128 * 128;
            for (int i = tid; i < 128 * 128; i += 512) { const int n = i >> 7, d = i & 127; const int off = n * 256 + ((((d >> 3) ^ (n & 15))) << 4) + (d & 7) * 2;
                *(LAS bf16*)(sk + off) = (bf16)f2bf(k1[i]); *(LAS bf16*)(sk + 32768 + off) = (bf16)f2bf(k2[i]); }
            __syncthreads();
            const unsigned char* PU8 = ws + WS_PU8 + (size_t)l * 16384 * 1024; const unsigned char* PV8 = ws + WS_PV8 + (size_t)l * 16384 * 1024;
            const float* SCU = (const float*)(ws + WS_PSC) + l * 16384; const float* SCV = (const float*)(ws + WS_PSC) + 32768 + l * 16384;
            const int flags = (sub == -1) ? 3 : (sub & 7);
            for (int ch = bid; ch < T / 64; ch += G) {
                const int t0 = ch * 64;
                if (flags & 1) { peer_route_unit(sk, t0 + wave * 4, wave * 4, P_QP, EL, GL, lane); __builtin_amdgcn_sched_barrier(0); peer_route_unit(sk, t0 + 32 + wave * 4, 32 + wave * 4, P_QP, EL, GL, lane); __builtin_amdgcn_sched_barrier(0); }
                else for (int i = tid; i < 64 * 128; i += 512) { EL[i] = ((t0 + (i >> 7)) * 131 + (i & 127) * 977) & 16383; GL[i] = 0.0625f; }
                __syncthreads();
                if (flags & 2) for (int i = 0; i < 8; ++i) { const int tl = wave * 8 + i;
                    peer_experts_token(EL + tl * 128, GL + tl * 128, t0 + tl, PU8, PV8, SCU, SCV, ap->in[I_LN3G] + l * D, ap->in[I_LN3B] + l * D, ap->out, P_XB, lane, flags); }
                __syncthreads();
            }
        }
        SEAM(pb + 11);
}

__global__ void __launch_bounds__(512, 2) fwd(Args a_unused) {
    extern __shared__ __attribute__((aligned(16))) unsigned char lds_raw[];
    LAS unsigned char* lds = (LAS unsigned char*)lds_raw;
    volatile LAS unsigned* MISC = (volatile LAS unsigned*)(lds + MISC_OFF);
    if (threadIdx.x < 32) MISC[threadIdx.x] = 0u;
    __syncthreads();
    int lo, hi;
    XcdBarrier bar;
    { KArgs ap = kargs(); lo = ap->lo; hi = ap->hi; bar = xcd_barrier_post((unsigned*)(ap->ws + WS_CTL) + 4096 + ap->li * XCD_BAR_WORDS, MISC + 8); }
    if (IN(0) && SITE(0)) { p0_prologue(lds, threadIdx.x, gridDim.x, blockIdx.x); }
    SEAM(0);

    run_layer<0>(lds, lo, hi, bar);
    run_layer<1>(lds, lo, hi, bar);
#undef IN
#undef SEAM
}

extern "C" void kernel_launch(void* const* d_in, const int* in_sizes, int n_in, void* d_out, int out_size, void* d_ws, size_t ws_size, hipStream_t stream) {
    static int grid = 0;
    if (grid == 0) {
        if (n_in != 35 || out_size != T * D || ws_size < WS_END) { fprintf(stderr, "kernel_launch: unexpected shapes (n_in %d, out %d, ws %zu)\n", n_in, out_size, ws_size); grid = -1; return; }
        int dev = 0, cus = 0, per_cu = 0;
        if (hipGetDevice(&dev) != hipSuccess || hipDeviceGetAttribute(&cus, hipDeviceAttributeMultiprocessorCount, dev) != hipSuccess) { grid = -1; return; }
        if (hipFuncSetAttribute((const void*)fwd, hipFuncAttributeMaxDynamicSharedMemorySize, LDS_BYTES) != hipSuccess) { fprintf(stderr, "kernel_launch: hipFuncSetAttribute failed\n"); grid = -1; return; }
        if (hipOccupancyMaxActiveBlocksPerMultiprocessor(&per_cu, (const void*)fwd, 512, LDS_BYTES) != hipSuccess || per_cu < 1) fprintf(stderr, "kernel_launch: occupancy query reports %d\n", per_cu);
        (void)hipGetLastError();
        grid = cus;
    }
    if (grid < 0) return;
    (void)hipMemsetAsync((char*)d_ws + WS_CTL, 0, CTL_ZERO_BYTES, stream);
    Args a{};
    for (int i = 0; i < 35; ++i) a.in[i] = (const float*)d_in[i];
    a.out = (float*)d_out; a.ws = (unsigned char*)d_ws;
#if MK_SINGLE
    a.lo = 0; a.hi = NPH; a.li = 0; a.sub = -1;
    hipLaunchKernelGGL(fwd, dim3(grid), dim3(512), LDS_BYTES, stream, a);
#else
#ifndef PROBE_PHASE
#define PROBE_PHASE -1
#endif
#ifndef PROBE_EXTRA
#define PROBE_EXTRA 0
#endif
#ifndef PROBE_SUB
#define PROBE_SUB -1
#endif
    for (int p = 0; p < NPH; ++p) {
        a.lo = p; a.hi = p + 1; a.li = 0; a.sub = -1; hipLaunchKernelGGL(fwd, dim3(grid), dim3(512), LDS_BYTES, stream, a);
        if (p == PROBE_PHASE) for (int e = 0; e < PROBE_EXTRA; ++e) { a.sub = PROBE_SUB; hipLaunchKernelGGL(fwd, dim3(grid), dim3(512), LDS_BYTES, stream, a); }
    }
#endif
}
```

```cpp
#include <hip/hip_runtime.h>
#include <cstdio>
#include <cstdint>
namespace pg8 {
#define PG8_LAS __attribute__((address_space(3)))
typedef unsigned short bf16_t;
typedef short bf16x8 __attribute__((ext_vector_type(8)));
typedef float f32x4 __attribute__((ext_vector_type(4)));
typedef unsigned u32x4 __attribute__((ext_vector_type(4)));
constexpr int BM = 256, BK = 64, HALF = 128, HTB = HALF * BK * 2  , STAGE_BYTES = 8 * HTB, NXCD = 8, WGM = 8;

__host__ __device__ __forceinline__ int lds_byte(int r, int c) { const int st = (r >> 4) * 2 + (c >> 5), rr = r & 15, cc = c & 31, ob = rr * 64 + cc * 2; return st * 1024 + (ob ^ (((ob >> 9) & 1) << 5)); }
__host__ __device__ __forceinline__ void stage_rc(int b, int& R, int& C) { const int st = b / 1024, sb = b % 1024, swz = sb ^ (((sb >> 9) & 1) << 5); R = (st >> 1) * 16 + swz / 64; C = (st & 1) * 32 + (swz % 64) / 2; }
__host__ __device__ __forceinline__ int perm32(int rho) { const int n = rho >> 4, i = rho & 15; return 8 * (i >> 2) + 4 * n + (i & 3); }

struct Unit { int pm, pn; };
struct Gemm { const bf16_t* A; const bf16_t* Bt; int M, N, K; };

struct StaticOrder {
    int nM, nN, nwg, G, c;
    __host__ __device__ void init(int M, int N, int G_, int c_) { nM = M / BM; nN = N / BM; nwg = nM * nN; G = G_; c = c_; }
    __host__ __device__ bool next(int i, Unit& u) const {
        const long L = (long)i * G + c; if (L >= nwg) return false;
        int wgid = (int)L; { const int q = nwg / NXCD, r = nwg % NXCD, xcd = wgid % NXCD, off = wgid / NXCD; wgid = (xcd < r ? xcd * (q + 1) : r * (q + 1) + (xcd - r) * q) + off; }
        const int nig = WGM * nN, gid = wgid / nig, fm = gid * WGM, gsz = (nM - fm) < WGM ? (nM - fm) : WGM;
        u.pm = fm + ((wgid % nig) % gsz); u.pn = (wgid % nig) / gsz; return true;
    }
    __device__ __forceinline__ void a_ready(const Unit&) const {}
    __device__ __forceinline__ void done(const Unit&) const {}
};
__device__ __forceinline__ unsigned cvt_pk_bf16(float lo, float hi) { unsigned r; asm volatile("v_cvt_pk_bf16_f32 %0, %1, %2" : "=v"(r) : "v"(lo), "v"(hi)); return r; }
template <class Epi, class Sched, bool ALIGN_EPI = false, bool SP2 = false>
__device__ __forceinline__ void gemm_phase(PG8_LAS unsigned char* lds, const Gemm g, const Sched& S, const Epi& E) {
    const int tid = threadIdx.x, wid = __builtin_amdgcn_readfirstlane(tid >> 6), lane = tid & 63, wr = wid >> 2, wc = wid & 3, fr = lane & 15, fq = lane >> 4;
    const int K = g.K, nt = K / BK;
    unsigned voffA[2], voffB[2];
#pragma unroll
    for (int i = 0; i < 2; ++i) { int R, C; stage_rc(tid * 16 + i * 8192, R, C); const int Rb = Epi::PERM ? ((R & ~31) + perm32(R & 31)) : R;
        voffA[i] = (unsigned)(R * K + C) * 2u; voffB[i] = (unsigned)(Rb * K + C) * 2u; }
    const size_t kstep = (size_t)(BK * 2);
    const size_t hstep = (size_t)HALF * K * 2;
    const size_t tstep = 2 * hstep;
    const unsigned ldsw = (unsigned)wid * 1024u;
    const int aoff = lds_byte(wr * 64 + fr, fq * 8), boff = lds_byte(wc * 32 + fr, fq * 8);
#define PG8_SA(b, h) (((b) * 2 + (h)) * HTB)
#define PG8_SB(b, h) ((4 + (b) * 2 + (h)) * HTB)
#define PG8_STAGE(bufoff, gbase, voff) do { _Pragma("unroll") for (int _i = 0; _i < 2; ++_i) \
        __builtin_amdgcn_global_load_lds((const unsigned*)((const char*)(gbase) + (voff)[_i]), (PG8_LAS unsigned*)(lds + (bufoff) + ldsw + _i * 8192), 16, 0, 0); } while (0)
#define PG8_LDA(dst, b, h) do { _Pragma("unroll") for (int m = 0; m < 4; ++m) _Pragma("unroll") for (int k = 0; k < 2; ++k) dst[m][k] = *(const PG8_LAS bf16x8*)(lds + PG8_SA(b, h) + aoff + m * 2048 + k * 1024); } while (0)
#define PG8_LDB(dst, b, h) do { _Pragma("unroll") for (int n = 0; n < 2; ++n) _Pragma("unroll") for (int k = 0; k < 2; ++k) dst[n][k] = *(const PG8_LAS bf16x8*)(lds + PG8_SB(b, h) + boff + n * 2048 + k * 1024); } while (0)
#define PG8_MMA(ai, bj, At, Bt) do { __builtin_amdgcn_s_setprio(1); _Pragma("unroll") for (int m = 0; m < 4; ++m) _Pragma("unroll") for (int n = 0; n < 2; ++n) _Pragma("unroll") for (int k = 0; k < 2; ++k) \
        acc[ai][bj][m][n] = __builtin_amdgcn_mfma_f32_16x16x32_bf16(Bt[n][k], At[m][k], acc[ai][bj][m][n], 0, 0, 0); __builtin_amdgcn_s_setprio(0); } while (0)
#define PG8_WAIT_V(n) asm volatile("s_waitcnt vmcnt(" #n ")" ::: "memory")
#define PG8_WAIT_L(n) asm volatile("s_waitcnt lgkmcnt(" #n ")" ::: "memory")
#define PG8_BAR __builtin_amdgcn_s_barrier()
#define PG8_SCHED __builtin_amdgcn_sched_barrier(0)
    Unit cur, nxt; int ui = 0;
    if (!S.next(0, cur)) return;
    f32x4 acc[2][2][4][2];
#pragma unroll
    for (int a = 0; a < 2; ++a)
#pragma unroll
        for (int b = 0; b < 2; ++b)
#pragma unroll
            for (int m = 0; m < 4; ++m)
#pragma unroll
                for (int n = 0; n < 2; ++n) acc[a][b][m][n] = (f32x4){0.f, 0.f, 0.f, 0.f};
    bf16x8 At[4][2], B0[2][2], B1[2][2];
    const char* cA = (const char*)g.A + (size_t)cur.pm * tstep; const char* cB = (const char*)g.Bt + (size_t)cur.pn * tstep;
    S.a_ready(cur);
    if constexpr (SP2) {
        PG8_STAGE(PG8_SB(0, 0), cB, voffB); PG8_STAGE(PG8_SB(0, 1), cB + hstep, voffB); PG8_STAGE(PG8_SA(0, 0), cA, voffA); PG8_STAGE(PG8_SA(0, 1), cA + hstep, voffA);
        if (wr == 1) PG8_BAR;
        PG8_WAIT_V(2); PG8_BAR;
        PG8_STAGE(PG8_SB(1, 0), cB + kstep, voffB); PG8_STAGE(PG8_SA(1, 0), cA + kstep, voffA); PG8_STAGE(PG8_SB(1, 1), cB + hstep + kstep, voffB);
        PG8_WAIT_V(6); PG8_BAR;
    } else {
        PG8_STAGE(PG8_SB(0, 0), cB, voffB); PG8_STAGE(PG8_SA(0, 0), cA, voffA); PG8_STAGE(PG8_SB(0, 1), cB + hstep, voffB); PG8_STAGE(PG8_SA(0, 1), cA + hstep, voffA);
        if (wr == 1) PG8_BAR;
        PG8_WAIT_V(4); PG8_BAR;
        PG8_STAGE(PG8_SB(1, 0), cB + kstep, voffB); PG8_STAGE(PG8_SA(1, 0), cA + kstep, voffA); PG8_STAGE(PG8_SB(1, 1), cB + hstep + kstep, voffB);
        PG8_WAIT_V(6); PG8_BAR;
    }
    for (;;) {
        const bool has_next = S.next(ui + 1, nxt);
        const char* nA = has_next ? (const char*)g.A + (size_t)nxt.pm * tstep : cA; const char* nB = has_next ? (const char*)g.Bt + (size_t)nxt.pn * tstep : cB;
        for (int t = 0; t < nt; t += 2) {
            const bool last = (t == nt - 2);
            const char* a1 = cA + (size_t)(t + 1) * kstep;
            const char* a2 = last ? nA : cA + (size_t)(t + 2) * kstep; const char* b2 = last ? nB : cB + (size_t)(t + 2) * kstep;
            const char* a3 = a2 + kstep; const char* b3 = b2 + kstep;
            if (last && has_next) S.a_ready(nxt);
            if constexpr (SP2) {
            PG8_LDB(B0, 0, 0); PG8_LDB(B1, 0, 1); PG8_SCHED; PG8_LDA(At, 0, 0); PG8_STAGE(PG8_SA(1, 1), a1 + hstep, voffA);
            PG8_WAIT_V(8); PG8_WAIT_L(0); PG8_BAR; PG8_MMA(0, 0, At, B0); PG8_MMA(0, 1, At, B1); PG8_BAR; PG8_SCHED;
            PG8_LDA(At, 0, 1); PG8_STAGE(PG8_SB(0, 0), b2, voffB); PG8_STAGE(PG8_SB(0, 1), b2 + hstep, voffB); PG8_STAGE(PG8_SA(0, 0), a2, voffA);
            PG8_WAIT_V(8); PG8_WAIT_L(0); PG8_BAR; PG8_MMA(1, 0, At, B0); PG8_MMA(1, 1, At, B1); PG8_BAR; PG8_SCHED;
            PG8_LDB(B0, 1, 0); PG8_LDB(B1, 1, 1); PG8_SCHED; PG8_LDA(At, 1, 0); PG8_STAGE(PG8_SA(0, 1), a2 + hstep, voffA);
            PG8_WAIT_V(8); PG8_WAIT_L(0); PG8_BAR; PG8_MMA(0, 0, At, B0); PG8_MMA(0, 1, At, B1); PG8_BAR; PG8_SCHED;
            PG8_LDA(At, 1, 1); PG8_STAGE(PG8_SB(1, 0), b3, voffB); PG8_STAGE(PG8_SB(1, 1), b3 + hstep, voffB); PG8_STAGE(PG8_SA(1, 0), a3, voffA);
            PG8_WAIT_V(8); PG8_WAIT_L(0); PG8_BAR; PG8_MMA(1, 0, At, B0); PG8_MMA(1, 1, At, B1); PG8_BAR; PG8_SCHED;
            } else {
            PG8_LDB(B0, 0, 0); PG8_SCHED; PG8_LDA(At, 0, 0); PG8_STAGE(PG8_SA(1, 1), a1 + hstep, voffA);
            PG8_WAIT_L(8); PG8_BAR; PG8_WAIT_L(0); PG8_MMA(0, 0, At, B0); PG8_BAR; PG8_SCHED;
            PG8_LDB(B1, 0, 1); PG8_STAGE(PG8_SB(0, 0), b2, voffB);
            PG8_BAR; PG8_WAIT_L(0); PG8_MMA(0, 1, At, B1); PG8_BAR;
            PG8_LDA(At, 0, 1); PG8_STAGE(PG8_SA(0, 0), a2, voffA);
            PG8_BAR; PG8_WAIT_L(0); PG8_MMA(1, 0, At, B0); PG8_BAR; PG8_SCHED;
            PG8_STAGE(PG8_SB(0, 1), b2 + hstep, voffB);
            PG8_WAIT_V(6); PG8_BAR; PG8_MMA(1, 1, At, B1); PG8_BAR;
            PG8_LDB(B0, 1, 0); PG8_SCHED; PG8_LDA(At, 1, 0); PG8_STAGE(PG8_SA(0, 1), a2 + hstep, voffA);
            PG8_WAIT_L(8); PG8_BAR; PG8_WAIT_L(0); PG8_MMA(0, 0, At, B0); PG8_BAR; PG8_SCHED;
            PG8_LDB(B1, 1, 1); PG8_STAGE(PG8_SB(1, 0), b3, voffB);
            PG8_BAR; PG8_WAIT_L(0); PG8_MMA(0, 1, At, B1); PG8_BAR;
            PG8_LDA(At, 1, 1); PG8_STAGE(PG8_SA(1, 0), a3, voffA);
            PG8_BAR; PG8_WAIT_L(0); PG8_MMA(1, 0, At, B0); PG8_BAR; PG8_SCHED;
            PG8_STAGE(PG8_SB(1, 1), b3 + hstep, voffB);
            PG8_WAIT_V(6); PG8_BAR; PG8_MMA(1, 1, At, B1); PG8_BAR;
            }
        }
        if constexpr (ALIGN_EPI) { if (wr == 0) PG8_BAR; }
        if constexpr (!Epi::AFTER_DRAIN) { E(acc, cur, wr, wc, fr, fq); S.done(cur); }
        if (!has_next) break;
#pragma unroll
        for (int a = 0; a < 2; ++a)
#pragma unroll
            for (int b = 0; b < 2; ++b)
#pragma unroll
                for (int m = 0; m < 4; ++m)
#pragma unroll
                    for (int n = 0; n < 2; ++n) acc[a][b][m][n] = (f32x4){0.f, 0.f, 0.f, 0.f};
        cur = nxt; cA = nA; cB = nB; ++ui;
        if constexpr (ALIGN_EPI) { if (wr == 1) PG8_BAR; }
    }
    PG8_WAIT_V(0);
    if constexpr (!ALIGN_EPI) { if (wr == 0) PG8_BAR; }
    PG8_BAR;
    if constexpr (Epi::AFTER_DRAIN) { E.fused(acc, cur, wr, wc, fr, fq, lds, wid, lane); S.done(cur); }
#undef PG8_SA
#undef PG8_SB
#undef PG8_STAGE
#undef PG8_LDA
#undef PG8_LDB
#undef PG8_MMA
#undef PG8_WAIT_V
#undef PG8_WAIT_L
#undef PG8_BAR
#undef PG8_SCHED
}
}

#define LAS __attribute__((address_space(3)))
typedef unsigned short bf16;
typedef unsigned v4u __attribute__((ext_vector_type(4)));
typedef unsigned v2u __attribute__((ext_vector_type(2)));
typedef float f32x4 __attribute__((ext_vector_type(4)));

#ifndef MK_SINGLE
#define MK_SINGLE 1
#endif

constexpr int NB = 2, L = 8192, T = NB * L, D = 1024;
constexpr int HN = 2816;
constexpr int H_A = 0, H_QL = 512, H_CB = 1536, H_QI = 1664, H_KI = 1920, H_XC = 1984, H_V = 2240, H_O = 2496, H_S = 2752;
constexpr int CATW = 1536, CAT_A = 0, CAT_B = 256, CAT_C = 1280;
constexpr int WIN_N = 2252;
constexpr float ALPHA = 1.4142135623730951f;
constexpr float LN_EPS = 1e-5f;
constexpr int NCHUNK = 1024;

constexpr size_t MiB = 1u << 20;
constexpr size_t WS_CTL = 0, CTL_ZERO_BYTES = 1 * MiB;
constexpr size_t WS_WIN  = 1 * MiB;
constexpr size_t WS_WOUT = 12 * MiB;
constexpr size_t WS_WCQ  = 18 * MiB;
constexpr size_t WS_WCKV = 22 * MiB;
constexpr size_t WS_WCO  = 30 * MiB;
constexpr size_t WS_WPQ  = 34 * MiB;
constexpr size_t WS_MEMB = 42 * MiB;
constexpr size_t WS_KV   = 43 * MiB;
constexpr size_t WS_PU8  = 48 * MiB;
constexpr size_t WS_PV8  = 80 * MiB;
constexpr size_t WS_PSC  = 47 * MiB;
constexpr size_t WS_PD   = 112 * MiB;
constexpr size_t WS_EXP  = 297 * MiB;
constexpr size_t WS_GATE = 305 * MiB;
constexpr size_t WS_COEF = 313 * MiB;
constexpr int CW_QUEUE = 32768;
constexpr size_t WS_XB   = 176 * MiB;
constexpr size_t WS_HB   = 208 * MiB;
constexpr size_t WS_QX   = 208 * MiB;
constexpr size_t WS_OX   = 240 * MiB;
constexpr size_t WS_QP   = 208 * MiB;
constexpr size_t WS_HS   = 296 * MiB;
constexpr size_t WS_CAT  = 297 * MiB;
constexpr size_t WS_CKV  = 345 * MiB;
constexpr size_t WS_SEL  = 349 * MiB;
constexpr size_t WS_MQ   = 357 * MiB;
constexpr size_t WS_MK   = 373 * MiB;
constexpr size_t WS_MC   = 389 * MiB;
constexpr size_t WS_MN   = 405 * MiB;
constexpr size_t WS_SCL  = WS_MN + 512 * 1024;
constexpr size_t WS_BC   = 406 * MiB;
constexpr size_t WS_IG   = WS_BC + 512 * 1024;
constexpr size_t WS_NSEL = 407 * MiB;
constexpr size_t WS_END  = 408 * MiB;

constexpr int LDS_BYTES = 147456;
constexpr int MISC_OFF = 131072 + 320;

__device__ __forceinline__ float bf2f(unsigned h) { return __uint_as_float(h << 16); }
__device__ __forceinline__ unsigned f2bf(float f) { unsigned u = __float_as_uint(f); return (u + 0x7fffu + ((u >> 16) & 1u)) >> 16; }
__device__ __forceinline__ unsigned pk2(float lo, float hi) { return f2bf(lo) | (f2bf(hi) << 16); }
__device__ __forceinline__ float lo16(unsigned u) { return __uint_as_float(u << 16); }
__device__ __forceinline__ float hi16(unsigned u) { return __uint_as_float(u & 0xffff0000u); }
__device__ __forceinline__ float wave_sum(float v) {
#pragma unroll
    for (int o = 1; o < 64; o <<= 1) v += __shfl_xor(v, o);
    return v;
}
__device__ __forceinline__ float wave_max(float v) {
#pragma unroll
    for (int o = 1; o < 64; o <<= 1) v = fmaxf(v, __shfl_xor(v, o));
    return v;
}
__device__ __forceinline__ int wave_sum_i(int v) {
#pragma unroll
    for (int o = 1; o < 64; o <<= 1) v += __shfl_xor(v, o);
    return v;
}
#define WAVE_LDS_SYNC() asm volatile("s_waitcnt lgkmcnt(0)" ::: "memory")
__device__ __forceinline__ float sigmoidf_(float x) { return 1.f / (1.f + __expf(-x)); }
__device__ __forceinline__ float dot8(v4u a, const float (&x)[8]) {
    return lo16(a.x) * x[0] + hi16(a.x) * x[1] + lo16(a.y) * x[2] + hi16(a.y) * x[3] + lo16(a.z) * x[4] + hi16(a.z) * x[5] + lo16(a.w) * x[6] + hi16(a.w) * x[7];
}
__device__ __forceinline__ float dot8bb(v4u a, v4u b) {
    return lo16(a.x) * lo16(b.x) + hi16(a.x) * hi16(b.x) + lo16(a.y) * lo16(b.y) + hi16(a.y) * hi16(b.y) + lo16(a.z) * lo16(b.z) + hi16(a.z) * hi16(b.z) + lo16(a.w) * lo16(b.w) + hi16(a.w) * hi16(b.w);
}

#define XB_TMO      128
#define XB_XCNT(j)  (256  + 64 * (j))
#define XB_XSUB(j)  (1280 + 64 * (j))
#define XB_XGEN(j)  (2304 + 64 * (j))
#define XB_TOP      3328
#define XB_TOPGEN   3392
#define XCD_BAR_WORDS 3456
#define XB_SPIN_CAP (1u << 18)

__device__ __forceinline__ unsigned xb_ld(unsigned* p)              { return __hip_atomic_load(p, __ATOMIC_RELAXED, __HIP_MEMORY_SCOPE_AGENT); }
__device__ __forceinline__ unsigned xb_add(unsigned* p, unsigned v) { return __hip_atomic_fetch_add(p, v, __ATOMIC_RELAXED, __HIP_MEMORY_SCOPE_AGENT); }
__device__ __forceinline__ unsigned xb_xcc_id() { return (unsigned)__builtin_amdgcn_s_getreg((3 << 11) | 20) & 0xFu; }
#define XB_SPIN(cond, bar) do { unsigned _sp = 0; while (cond) { __builtin_amdgcn_s_sleep(1); \
    if ((++_sp & 255u) == 0u) { if (xb_ld(&(bar)[XB_TMO])) break; if (_sp > XB_SPIN_CAP) { atomicAdd(&(bar)[XB_TMO], 1u); break; } } } } while (0)

struct XcdBarrier { unsigned* bar; unsigned x; volatile LAS unsigned* st; };

__device__ __forceinline__ XcdBarrier xcd_barrier_post(unsigned* bar, volatile LAS unsigned* st) {
    XcdBarrier b; b.bar = bar; b.x = xb_xcc_id(); b.st = st;
    if (threadIdx.x == 0) (void)xb_add(&bar[XB_XCNT(b.x)], 1u);
    return b;
}
__device__ __forceinline__ void xcd_barrier_complete(unsigned* bar, unsigned x, unsigned& nloc, unsigned& nx) {
    const unsigned G = gridDim.x * gridDim.y * gridDim.z;
    unsigned sum, cnt, mine, sp = 0u;
    for (;;) {
        sum = 0u; cnt = 0u; mine = 0u;
#pragma unroll
        for (unsigned j = 0; j < 16; ++j) { const unsigned c = xb_ld(&bar[XB_XCNT(j)]); sum += c; cnt += (c > 0u) ? 1u : 0u; mine = (j == x) ? c : mine; }
        if (sum == G) break;
        __builtin_amdgcn_s_sleep(1);
        if ((++sp & 255u) == 0u) { if (xb_ld(&bar[XB_TMO])) break; if (sp > XB_SPIN_CAP) { atomicAdd(&bar[XB_TMO], 1u); break; } }
    }
    nloc = mine > 0u ? mine : 1u; nx = cnt > 0u ? cnt : 1u;
}
__device__ __forceinline__ void xcd_barrier(const XcdBarrier& b) {
    asm volatile("s_waitcnt vmcnt(0)" ::: "memory");
    __syncthreads();
    if (threadIdx.x == 0) {
        unsigned* bar = b.bar;
        __builtin_amdgcn_s_waitcnt(0);
        unsigned nloc = b.st[0], nx = b.st[1];
        if (nloc == 0u) { xcd_barrier_complete(bar, b.x, nloc, nx); b.st[0] = nloc; b.st[1] = nx; }
        const unsigned old = xb_add(&bar[XB_XSUB(b.x)], 1u);
        const unsigned gen = old / nloc;
        if (old + 1u == (gen + 1u) * nloc) {
            __builtin_amdgcn_fence(__ATOMIC_RELEASE, "agent");
            asm volatile("s_waitcnt vmcnt(0)" ::: "memory");
            const unsigned og = xb_add(&bar[XB_TOP], 1u);
            const unsigned tg = og / nx;
            if (og + 1u == (tg + 1u) * nx) xb_add(&bar[XB_TOPGEN], 1u);
            else XB_SPIN(xb_ld(&bar[XB_TOPGEN]) == tg, bar);
            __builtin_amdgcn_fence(__ATOMIC_ACQUIRE, "agent");
            xb_add(&bar[XB_XGEN(b.x)], 1u);
            asm volatile("s_waitcnt vmcnt(0)" ::: "memory");
        } else {
            XB_SPIN(xb_ld(&bar[XB_XGEN(b.x)]) == gen, bar);
            __builtin_amdgcn_fence(__ATOMIC_ACQUIRE, "agent");
            asm volatile("s_waitcnt vmcnt(0)" ::: "memory");
        }
    }
    __syncthreads();
}

struct EpiH {
    static constexpr bool PERM = true, AFTER_DRAIN = false;
    bf16* H; float* Hs;
    __device__ __forceinline__ void operator()(const pg8::f32x4 (&acc)[2][2][4][2], const pg8::Unit& u, int wr, int wc, int fr, int fq) const {
        const int row0 = u.pm * 256 + wr * 64 + fr, col0 = u.pn * 256 + wc * 32 + 8 * fq;
#pragma unroll
        for (int ai = 0; ai < 2; ++ai)
#pragma unroll
            for (int m = 0; m < 4; ++m) {
                const int row = row0 + ai * 128 + m * 16;
#pragma unroll
                for (int bj = 0; bj < 2; ++bj) {
                    const int c = col0 + bj * 128;
                    const pg8::f32x4 v0 = acc[ai][bj][m][0], v1 = acc[ai][bj][m][1];
                    v4u w; w.x = pk2(v0[0], v0[1]); w.y = pk2(v0[2], v0[3]); w.z = pk2(v1[0], v1[1]); w.w = pk2(v1[2], v1[3]);
                    *(v4u*)(H + (size_t)row * HN + c) = w;
                    if (c == H_S || c == H_S + 8) { float* s = Hs + (size_t)row * 16 + (c - H_S); *(pg8::f32x4*)s = v0; *(pg8::f32x4*)(s + 4) = v1; }
                }
            }
    }
};
struct EpiB16 {
    static constexpr bool PERM = true, AFTER_DRAIN = false;
    bf16* O; int ldc;
    __device__ __forceinline__ void operator()(const pg8::f32x4 (&acc)[2][2][4][2], const pg8::Unit& u, int wr, int wc, int fr, int fq) const {
        const int row0 = u.pm * 256 + wr * 64 + fr, col0 = u.pn * 256 + wc * 32 + 8 * fq;
#pragma unroll
        for (int ai = 0; ai < 2; ++ai)
#pragma unroll
            for (int m = 0; m < 4; ++m) {
                const int row = row0 + ai * 128 + m * 16;
#pragma unroll
                for (int bj = 0; bj < 2; ++bj) {
                    const int c = col0 + bj * 128;
                    const pg8::f32x4 v0 = acc[ai][bj][m][0], v1 = acc[ai][bj][m][1];
                    v4u w; w.x = pk2(v0[0], v0[1]); w.y = pk2(v0[2], v0[3]); w.z = pk2(v1[0], v1[1]); w.w = pk2(v1[2], v1[3]);
                    *(v4u*)(O + (size_t)row * ldc + c) = w;
                }
            }
    }
};
struct EpiResid {
    static constexpr bool PERM = false, AFTER_DRAIN = false;
    float* O; int ldc; float alpha;
    __device__ __forceinline__ void operator()(const pg8::f32x4 (&acc)[2][2][4][2], const pg8::Unit& u, int wr, int wc, int fr, int fq) const {
        const int row0 = u.pm * 256 + wr * 64 + fr, col0 = u.pn * 256 + wc * 32 + 4 * fq;
#pragma unroll
        for (int ai = 0; ai < 2; ++ai)
#pragma unroll
            for (int m = 0; m < 4; ++m) {
                float* rowp = O + (size_t)(row0 + ai * 128 + m * 16) * ldc + col0;
#pragma unroll
                for (int bj = 0; bj < 2; ++bj)
#pragma unroll
                    for (int n = 0; n < 2; ++n) {
                        pg8::f32x4* p = (pg8::f32x4*)(rowp + bj * 128 + n * 16);
                        const pg8::f32x4 x = *p;
                        *p = x * alpha + acc[ai][bj][m][n];
                    }
            }
    }
};

struct Args { const float* in[35]; float* out; unsigned char* ws; int lo, hi, li, sub; };
typedef const __attribute__((address_space(4))) Args* KArgs;
__device__ __forceinline__ KArgs kargs() { KArgs p = (KArgs)__builtin_amdgcn_kernarg_segment_ptr(); asm volatile("" : "+s"(p)); return p; }
enum { I_X = 0, I_MEM, I_LNIN_G, I_LNIN_B, I_RELB, I_WIN, I_CAW, I_CAB, I_NAG, I_NAB, I_KVG, I_WUK, I_WUV, I_CMW, I_CMB, I_WQM, I_WKM, I_BI, I_BF, I_NMG,
       I_WOUT, I_LN1G, I_LN1B, I_WCQ, I_WCKV, I_WCO, I_LN2G, I_LN2B, I_WPQ, I_SK1, I_SK2, I_PU, I_PV, I_LN3G, I_LN3B };

__device__ __forceinline__ void tr_item(LAS float* scr, const float* W, int ldw, int k0, int n0, int ncv, bf16* WT, int ldk, int dr0, int kofs, int tid) {
    const int c = tid & 63, r0 = tid >> 6;
#pragma unroll
    for (int i = 0; i < 8; ++i) { const int r = r0 + 8 * i; scr[r * 65 + c] = (c < ncv) ? W[(size_t)(k0 + r) * ldw + n0 + c] : 0.f; }
    __syncthreads();
#pragma unroll
    for (int i = 0; i < 8; ++i) { const int n = r0 + 8 * i; if (n < ncv) WT[(size_t)(dr0 + n) * ldk + kofs + k0 + c] = (bf16)f2bf(scr[c * 65 + n]); }
    __syncthreads();
}
__device__ __forceinline__ void tr_job(LAS float* scr, const float* W, int K, int ldw, int n0, int nc, bf16* WT, int ldk, int dr0, int kofs, int tid, int G, int bid) {
    const int nnt = (nc + 63) / 64, nitems = (K / 64) * nnt;
    for (int it = bid; it < nitems; it += G) {
        const int kt = it / nnt, nt = it % nnt;
        const int ncv = (nc - nt * 64) < 64 ? (nc - nt * 64) : 64;
        tr_item(scr, W, ldw, kt * 64, n0 + nt * 64, ncv, WT, ldk, dr0 + nt * 64, kofs, tid);
    }
}
__device__ __forceinline__ void ln_row(const float* src, const float* g, const float* b, float* dstf, bf16* dstb, int lane) {
    const f32x4* xr = (const f32x4*)src + lane;
    f32x4 v[4]; float s = 0.f;
#pragma unroll
    for (int j = 0; j < 4; ++j) { v[j] = xr[64 * j]; s += (v[j].x + v[j].y) + (v[j].z + v[j].w); }
    const float mean = wave_sum(s) * (1.f / D); float s2 = 0.f;
#pragma unroll
    for (int j = 0; j < 4; ++j) { v[j] = v[j] - mean; s2 += (v[j].x * v[j].x + v[j].y * v[j].y) + (v[j].z * v[j].z + v[j].w * v[j].w); }
    const float rstd = rsqrtf(wave_sum(s2) * (1.f / D) + LN_EPS);
#pragma unroll
    for (int j = 0; j < 4; ++j) {
        const f32x4 gg = ((const f32x4*)g)[lane + 64 * j], bb = ((const f32x4*)b)[lane + 64 * j];
        const f32x4 y = v[j] * rstd * gg + bb;
        ((f32x4*)dstf)[lane + 64 * j] = y;
        v2u o; o.x = pk2(y.x, y.y); o.y = pk2(y.z, y.w);
        ((v2u*)dstb)[lane + 64 * j] = o;
    }
}

__device__ __forceinline__ void p0_prologue(LAS unsigned char* lds, int tid, int G, int bid) {
    LAS float* scr = (LAS float*)lds;
    KArgs ap = kargs();
    unsigned char* ws = ap->ws;
    for (int l = 0; l < 2; ++l) {
        const float* win = ap->in[I_WIN] + (size_t)l * D * WIN_N;
        bf16* WinT = (bf16*)(ws + WS_WIN) + (size_t)l * HN * D;
        tr_job(scr, win, D, WIN_N, 0, 512, WinT, D, H_A, 0, tid, G, bid);
        tr_job(scr, win, D, WIN_N, 1024, 448, WinT, D, H_CB, 0, tid, G, bid);
        tr_job(scr, win, D, WIN_N, 1476, 768, WinT, D, H_XC, 0, tid, G, bid);
        tr_job(scr, win, D, WIN_N, 1472, 4, WinT, D, H_S, 0, tid, G, bid);
        tr_job(scr, win, D, WIN_N, 2244, 8, WinT, D, H_S + 4, 0, tid, G, bid);
        for (int i = bid * 512 + tid; i < (HN - (H_S + 12)) * D; i += G * 512) WinT[(size_t)(H_S + 12) * D + i] = 0;
        const float* wout = ap->in[I_WOUT] + (size_t)l * D * D;
        bf16* WoutT = (bf16*)(ws + WS_WOUT) + (size_t)l * D * CATW;
        tr_job(scr, wout, 256, D, 0, D, WoutT, CATW, 0, CAT_A, tid, G, bid);
        tr_job(scr, wout + (size_t)768 * D, 256, D, 0, D, WoutT, CATW, 0, CAT_C, tid, G, bid);
        tr_job(scr, ap->in[I_WCQ] + (size_t)l * D * D, D, D, 0, D, (bf16*)(ws + WS_WCQ) + (size_t)l * D * D, D, 0, 0, tid, G, bid);
        tr_job(scr, ap->in[I_WCKV] + (size_t)l * D * 2048, D, 2048, 0, 2048, (bf16*)(ws + WS_WCKV) + (size_t)l * 2048 * D, D, 0, 0, tid, G, bid);
        tr_job(scr, ap->in[I_WCO] + (size_t)l * D * D, D, D, 0, D, (bf16*)(ws + WS_WCO) + (size_t)l * D * D, D, 0, 0, tid, G, bid);
        tr_job(scr, ap->in[I_WPQ] + (size_t)l * D * 2048, D, 2048, 0, 2048, (bf16*)(ws + WS_WPQ) + (size_t)l * 2048 * D, D, 0, 0, tid, G, bid);
    }
    {
        LAS float* sa = (LAS float*)lds;
        LAS float* sb = sa + 64 * 65;
        for (int it = bid; it < 2 * 2 * 128; it += G) {
            const int l = it >> 8, kind = (it >> 7) & 1, h = (it >> 4) & 7, tile = it & 15;
            if (kind == 0) {
                const float* win = ap->in[I_WIN] + (size_t)l * D * WIN_N;
                const float* wuk = ap->in[I_WUK] + (size_t)l * 8 * 64 * 128 + (size_t)h * 64 * 128;
                bf16* WinT = (bf16*)(ws + WS_WIN) + (size_t)l * HN * D;
                const int k0 = tile * 64;
                for (int i = tid; i < 4096; i += 512) { const int kk = i >> 6, d = i & 63; sa[kk * 65 + d] = win[(size_t)(k0 + kk) * WIN_N + 512 + h * 64 + d]; }
                for (int i = tid; i < 8192; i += 512) sb[i] = wuk[i];
                __syncthreads();
                for (int i = tid; i < 8192; i += 512) { const int r = i >> 6, kk = i & 63; float s = 0.f;
#pragma unroll 8
                    for (int d = 0; d < 64; ++d) s += sa[kk * 65 + d] * sb[d * 128 + r];
                    WinT[(size_t)(H_QL + h * 128 + r) * D + k0 + kk] = (bf16)f2bf(s); }
                __syncthreads();
            } else {
                const float* wout = ap->in[I_WOUT] + (size_t)l * D * D;
                const float* wuv = ap->in[I_WUV] + (size_t)l * 8 * 128 * 64 + (size_t)h * 128 * 64;
                bf16* WoutT = (bf16*)(ws + WS_WOUT) + (size_t)l * D * CATW;
                const int n0 = tile * 64;
                for (int i = tid; i < 4096; i += 512) { const int d = i >> 6, n = i & 63; sa[d * 65 + n] = wout[(size_t)(256 + h * 64 + d) * D + n0 + n]; }
                for (int i = tid; i < 8192; i += 512) { const int r = i >> 6, d = i & 63; sb[r * 65 + d] = wuv[i]; }
                __syncthreads();
                for (int i = tid; i < 8192; i += 512) { const int n = i >> 7, r = i & 127; float s = 0.f;
#pragma unroll 8
                    for (int d = 0; d < 64; ++d) s += sb[r * 65 + d] * sa[d * 65 + n];
                    WoutT[(size_t)(n0 + n) * CATW + CAT_B + h * 128 + r] = (bf16)f2bf(s); }
                __syncthreads();
            }
        }
    }
    {
        const int gw = bid * 8 + (tid >> 6), NGW = G * 8, lane = tid & 63;
        for (int row = gw; row < 2 * 2 * 16384; row += NGW) {
            const int tab = row >> 15, le = row & 32767;
            const f32x4* src = (const f32x4*)((tab ? ap->in[I_PV] : ap->in[I_PU]) + (size_t)le * D) + 4 * lane;
            f32x4 v[4]; float am = 0.f;
#pragma unroll
            for (int i = 0; i < 4; ++i) { v[i] = src[i]; am = fmaxf(am, fmaxf(fmaxf(fabsf(v[i].x), fabsf(v[i].y)), fmaxf(fabsf(v[i].z), fabsf(v[i].w)))); }
            am = wave_max(am);
            const float sc = am > 0.f ? 448.f / am : 1.f;
            v4u w; int q;
            q = 0; q = __builtin_amdgcn_cvt_pk_fp8_f32(v[0].x * sc, v[0].y * sc, q, false); q = __builtin_amdgcn_cvt_pk_fp8_f32(v[0].z * sc, v[0].w * sc, q, true); w.x = (unsigned)q;
            q = 0; q = __builtin_amdgcn_cvt_pk_fp8_f32(v[1].x * sc, v[1].y * sc, q, false); q = __builtin_amdgcn_cvt_pk_fp8_f32(v[1].z * sc, v[1].w * sc, q, true); w.y = (unsigned)q;
            q = 0; q = __builtin_amdgcn_cvt_pk_fp8_f32(v[2].x * sc, v[2].y * sc, q, false); q = __builtin_amdgcn_cvt_pk_fp8_f32(v[2].z * sc, v[2].w * sc, q, true); w.z = (unsigned)q;
            q = 0; q = __builtin_amdgcn_cvt_pk_fp8_f32(v[3].x * sc, v[3].y * sc, q, false); q = __builtin_amdgcn_cvt_pk_fp8_f32(v[3].z * sc, v[3].w * sc, q, true); w.w = (unsigned)q;
            *(v4u*)(ws + (tab ? WS_PV8 : WS_PU8) + ((size_t)((le >> 14) * 8 + (lane >> 3)) * 16384 + (le & 16383)) * 128 + (lane & 7) * 16) = w;
            if (lane == 0) ((float*)(ws + WS_PSC))[row] = am > 0.f ? am * (1.f / 448.f) : 1.f;
        }
        const size_t gt = (size_t)bid * 512 + tid, gs = (size_t)G * 512;
        const f32x4* pm = (const f32x4*)ap->in[I_MEM]; v2u* dm = (v2u*)(ws + WS_MEMB);
        for (size_t i = gt; i < (size_t)512 * 1024 / 4; i += gs) { const f32x4 x = pm[i]; v2u o; o.x = pk2(x.x, x.y); o.y = pk2(x.z, x.w); dm[i] = o; }
    }
    {
        const int gw = bid * 8 + (tid >> 6), NGW = G * 8, lane = tid & 63;
        for (int m = gw; m < T; m += NGW)
            ln_row(ap->in[I_X] + (size_t)m * D, ap->in[I_LNIN_G], ap->in[I_LNIN_B], ap->out + (size_t)m * D, (bf16*)(ws + WS_XB) + (size_t)m * D, lane);
    }
}

__device__ __forceinline__ void conv_unit(LAS unsigned char* lds, int tile, const bf16* Hb, const float* cw, const float* cb, const float* ng, const float* nb, bf16* CAT, int tid) {
    asm volatile("" : "+v"(tid));
    LAS float* u = (LAS float*)lds;
    LAS float* w = u + 94 * 256;
    const int t0 = tile * 64, pos0 = t0 & (L - 1);
    for (int it = tid; it < 94 * 32; it += 512) {
        const int r = it >> 5, cg = it & 31, pos = pos0 - 30 + r;
        float o[8];
        if (pos >= 0) {
            const bf16* hr = Hb + (size_t)(t0 - 30 + r) * HN + H_A + 8 * cg;
            const v4u a = *(const v4u*)hr, g = *(const v4u*)(hr + 256);
            o[0] = lo16(a.x) * sigmoidf_(lo16(g.x)); o[1] = hi16(a.x) * sigmoidf_(hi16(g.x)); o[2] = lo16(a.y) * sigmoidf_(lo16(g.y)); o[3] = hi16(a.y) * sigmoidf_(hi16(g.y));
            o[4] = lo16(a.z) * sigmoidf_(lo16(g.z)); o[5] = hi16(a.z) * sigmoidf_(hi16(g.z)); o[6] = lo16(a.w) * sigmoidf_(lo16(g.w)); o[7] = hi16(a.w) * sigmoidf_(hi16(g.w));
        } else {
#pragma unroll
            for (int e = 0; e < 8; ++e) o[e] = 0.f;
        }
        LAS f32x4* up = (LAS f32x4*)(u + r * 256 + 8 * cg);
        up[0] = (f32x4){o[0], o[1], o[2], o[3]}; up[1] = (f32x4){o[4], o[5], o[6], o[7]};
    }
    for (int i = tid; i < 31 * 64; i += 512) ((LAS f32x4*)w)[i] = ((const f32x4*)cw)[i];
    __syncthreads();
    const int wave = tid >> 6, lane = tid & 63, tt0 = wave * 8;
    float acc[4][8];
#pragma unroll
    for (int i = 0; i < 4; ++i) {
        const int c = lane + 64 * i;
        const float bias = cb[c];
        float a[8], uw[8];
#pragma unroll
        for (int jj = 0; jj < 8; ++jj) { a[jj] = bias; uw[jj] = u[(tt0 + jj) * 256 + c]; }
#pragma unroll 1
        for (int tap = 0; tap < 31; ++tap) {
            const float wv = w[tap * 256 + c];
            const float un = u[(tt0 + (tap < 30 ? tap + 8 : 0)) * 256 + c];
#pragma unroll
            for (int jj = 0; jj < 8; ++jj) a[jj] += wv * uw[jj];
#pragma unroll
            for (int jj = 0; jj < 7; ++jj) uw[jj] = uw[jj + 1];
            uw[7] = un;
        }
#pragma unroll
        for (int jj = 0; jj < 8; ++jj) acc[i][jj] = a[jj];
    }
    float gg[4], bb[4];
#pragma unroll
    for (int i = 0; i < 4; ++i) { gg[i] = ng[lane + 64 * i]; bb[i] = nb[lane + 64 * i]; }
#pragma unroll
    for (int jj = 0; jj < 8; ++jj) {
        const float mean = wave_sum((acc[0][jj] + acc[1][jj]) + (acc[2][jj] + acc[3][jj])) * (1.f / 256.f);
        float d[4], s2 = 0.f;
#pragma unroll
        for (int i = 0; i < 4; ++i) { d[i] = acc[i][jj] - mean; s2 += d[i] * d[i]; }
        const float rstd = rsqrtf(wave_sum(s2) * (1.f / 256.f) + LN_EPS);
#pragma unroll
        for (int i = 0; i < 4; ++i) { const float y = d[i] * rstd * gg[i] + bb[i];
            CAT[(size_t)(t0 + tt0 + jj) * CATW + CAT_A + lane + 64 * i] = (bf16)f2bf(y * sigmoidf_(y)); }
    }
    __syncthreads();
}

__device__ __forceinline__ unsigned fkey(float f) { const unsigned u = __float_as_uint(f); return (u & 0x80000000u) ? ~u : (u | 0x80000000u); }

__device__ __forceinline__ int block_sum_i(int v, LAS int* red, int tid) {
    v = wave_sum_i(v);
    if ((tid & 63) == 0) red[tid >> 6] = v;
    __syncthreads();
    int s = 0;
#pragma unroll
    for (int i = 0; i < 8; ++i) s += red[i];
    __syncthreads();
    return s;
}
__device__ __forceinline__ int block_excl_scan_i(int v, LAS int* red, int tid, int& tot) {
    const int lane = tid & 63, wave = tid >> 6;
    int inc = v;
#pragma unroll
    for (int o = 1; o < 64; o <<= 1) { const int y = __shfl_up(inc, o); if (lane >= o) inc += y; }
    if (lane == 63) red[wave] = inc;
    __syncthreads();
    int base = 0, t = 0;
#pragma unroll
    for (int i = 0; i < 8; ++i) { const int r = red[i]; if (i < wave) base += r; t += r; }
    __syncthreads();
    tot = t;
    return base + inc - v;
}

__device__ __forceinline__ void indexer_query(LAS unsigned char* lds, int t, const bf16* Hb, const float* Hs, unsigned short* SEL, int* NSEL, int tid) {
    LAS unsigned* keys = (LAS unsigned*)lds;
    LAS float* qi = (LAS float*)(lds + 32768);
    LAS int* red = (LAS int*)(lds + 32768 + 1024);
    const int b = t >> 13, pos = t & (L - 1), n = pos + 1;
    if (tid < 256) qi[tid] = bf2f(Hb[(size_t)t * HN + H_QI + tid]);
    const float w0 = Hs[(size_t)t * 16 + 0] * 0.5f, w1 = Hs[(size_t)t * 16 + 1] * 0.5f, w2 = Hs[(size_t)t * 16 + 2] * 0.5f, w3 = Hs[(size_t)t * 16 + 3] * 0.5f;
    __syncthreads();
    for (int s = tid; s < n; s += 512) {
        const bf16* kr = Hb + (size_t)(b * L + s) * HN + H_KI;
        float d0 = 0.f, d1 = 0.f, d2 = 0.f, d3 = 0.f;
#pragma unroll 1
        for (int c = 0; c < 64; c += 8) {
            asm volatile("" ::: "memory");
            const v4u kk = *(const v4u*)(kr + c);
            float kf[8] = { lo16(kk.x), hi16(kk.x), lo16(kk.y), hi16(kk.y), lo16(kk.z), hi16(kk.z), lo16(kk.w), hi16(kk.w) };
#pragma unroll
            for (int j = 0; j < 8; ++j) { d0 += qi[c + j] * kf[j]; d1 += qi[64 + c + j] * kf[j]; d2 += qi[128 + c + j] * kf[j]; d3 += qi[192 + c + j] * kf[j]; }
        }
        float sc = 0.f;
        sc += w0 * fmaxf(d0 * 0.125f, 0.f); sc += w1 * fmaxf(d1 * 0.125f, 0.f); sc += w2 * fmaxf(d2 * 0.125f, 0.f); sc += w3 * fmaxf(d3 * 0.125f, 0.f);
        keys[s] = fkey(sc);
    }
    __syncthreads();
    if (n <= 256) {
        for (int s = tid; s < n; s += 512) SEL[(size_t)t * 256 + s] = (unsigned short)s;
        if (tid == 0) NSEL[t] = n;
        __syncthreads();
        return;
    }
    unsigned prefix = 0u;
    for (int bit = 31; bit >= 0; --bit) {
        const unsigned cand = prefix | (1u << bit);
        int c = 0;
        for (int s = tid; s < n; s += 512) c += (keys[s] >= cand) ? 1 : 0;
        c = block_sum_i(c, red, tid);
        if (c >= 256) prefix = cand;
    }
    int ng = 0, nt = 0;
#pragma unroll
    for (int j = 0; j < 16; ++j) { const int s = tid * 16 + j; if (s < n) { const unsigned k = keys[s]; ng += (k > prefix) ? 1 : 0; nt += (k == prefix) ? 1 : 0; } }
    int totg, tott;
    int eg = block_excl_scan_i(ng, red, tid, totg);
    int et = block_excl_scan_i(nt, red, tid, tott);
    const int quota = 256 - totg;
#pragma unroll
    for (int j = 0; j < 16; ++j) { const int s = tid * 16 + j; if (s < n) { const unsigned k = keys[s];
        if (k > prefix) { SEL[(size_t)t * 256 + eg] = (unsigned short)s; ++eg; }
        else if (k == prefix) { if (et < quota) SEL[(size_t)t * 256 + totg + et] = (unsigned short)s; ++et; } } }
    if (tid == 0) NSEL[t] = 256;
    __syncthreads();
}

typedef short bf16x8s __attribute__((ext_vector_type(8)));
typedef float f32x16 __attribute__((ext_vector_type(16)));
constexpr int IDX_ROWW = 1025;
constexpr int IDX_CTL = 131072 + 512;

template <int PASS>
__device__ __forceinline__ void idx_pass(LAS unsigned char* lds, const bf16* Hb, int b, int si, int wave, int lane,
                                         const bf16x8s (&Qb)[4][4], const float (&wq)[4], unsigned short* SEL) {
    LAS unsigned* hist = (LAS unsigned*)lds;
    LAS unsigned* cB1 = (LAS unsigned*)(lds + IDX_CTL);
    LAS unsigned* cT22 = cB1 + 64;
    LAS unsigned* cCnt = cB1 + 128;
    const int r = lane & 31, h = lane >> 5;
    const int qpos = si * 32 + r;
    const unsigned myB1 = (PASS >= 2) ? cB1[r] : 0u;
    const unsigned myT = (PASS == 3) ? cT22[r] : 0u;
    bf16x8s ka[4];
    {
        const bf16* kp = Hb + (size_t)(b * L + wave * 32 + r) * HN + H_KI + 8 * h;
        if (wave <= si) {
#pragma unroll
            for (int s = 0; s < 4; ++s) ka[s] = *(const bf16x8s*)(kp + 16 * s);
        }
    }
    for (int kt = wave; kt <= si; kt += 8) {
        bf16x8s kn[4];
        const bool more = (kt + 8 <= si);
        if (more) {
            const bf16* kp = Hb + (size_t)(b * L + (kt + 8) * 32 + r) * HN + H_KI + 8 * h;
#pragma unroll
            for (int s = 0; s < 4; ++s) kn[s] = *(const bf16x8s*)(kp + 16 * s);
        }
        float sc[16];
#pragma unroll
        for (int i = 0; i < 16; ++i) sc[i] = 0.f;
#pragma unroll
        for (int hh = 0; hh < 4; ++hh) {
            f32x16 acc;
#pragma unroll
            for (int i = 0; i < 16; ++i) acc[i] = 0.f;
#pragma unroll
            for (int s = 0; s < 4; ++s) acc = __builtin_amdgcn_mfma_f32_32x32x16_bf16(ka[s], Qb[hh][s], acc, 0, 0, 0);
#pragma unroll
            for (int i = 0; i < 16; ++i) sc[i] += wq[hh] * fmaxf(acc[i], 0.f);
        }
        const bool diag = (kt == si);
#pragma unroll
        for (int i = 0; i < 16; ++i) {
            const int ko = (i & 3) + 8 * (i >> 2) + 4 * h;
            const bool valid = !diag || (ko <= r);
            const unsigned key = fkey(sc[i]);
            if (PASS == 1) {
                if (valid) { const unsigned bin = key >> 21; __hip_atomic_fetch_add(hist + r * IDX_ROWW + (bin >> 1), (bin & 1u) ? 65536u : 1u, __ATOMIC_RELAXED, __HIP_MEMORY_SCOPE_WORKGROUP); }
            } else if (PASS == 2) {
                if (valid && (key >> 21) == myB1) { const unsigned bin = (key >> 10) & 2047u; __hip_atomic_fetch_add(hist + r * IDX_ROWW + (bin >> 1), (bin & 1u) ? 65536u : 1u, __ATOMIC_RELAXED, __HIP_MEMORY_SCOPE_WORKGROUP); }
            } else {
                const unsigned k22 = key >> 10;
                const int kpos = kt * 32 + ko;
                if (valid) {
                    if (myB1 == 0xffffffffu || k22 > myT) {
                        __hip_atomic_fetch_or(hist + r * 256 + (kpos >> 5), 1u << (kpos & 31), __ATOMIC_RELAXED, __HIP_MEMORY_SCOPE_WORKGROUP);
                    } else if (k22 == myT) {
                        __hip_atomic_fetch_or(hist + 8192 + r * 256 + (kpos >> 5), 1u << (kpos & 31), __ATOMIC_RELAXED, __HIP_MEMORY_SCOPE_WORKGROUP);
                    }
                }
            }
        }
        if (more) {
#pragma unroll
            for (int s = 0; s < 4; ++s) ka[s] = kn[s];
        }
    }
}

__device__ __forceinline__ void idx_find(LAS unsigned* hist, int q, int need, int lane, unsigned& Bout, int& aboveOut, bool& found) {
    const LAS unsigned* row = hist + q * IDX_ROWW + 16 * lane;
    unsigned wv[16]; int own = 0;
#pragma unroll
    for (int i = 0; i < 16; ++i) { wv[i] = row[i]; own += (int)(wv[i] & 0xffffu) + (int)(wv[i] >> 16); }
    int suf = own;
#pragma unroll
    for (int o = 1; o < 64; o <<= 1) { const int y = __shfl_down(suf, o); if (lane + o < 64) suf += y; }
    const int above = suf - own;
    const bool here = (above < need) && (suf >= need);
    unsigned B = 0u; int ab = 0; bool f = false; int a = above;
#pragma unroll
    for (int i = 15; i >= 0; --i) {
        const int hi = (int)(wv[i] >> 16), lo = (int)(wv[i] & 0xffffu);
        if (!f && a + hi >= need) { B = 32u * lane + 2u * i + 1u; ab = a; f = true; }
        a += hi;
        if (!f && a + lo >= need) { B = 32u * lane + 2u * i; ab = a; f = true; }
        a += lo;
    }
    const unsigned long long m = __ballot(here);
    found = (m != 0ull);
    const int src = found ? (__ffsll((long long)m) - 1) : 0;
    Bout = (unsigned)__shfl((int)B, src); aboveOut = __shfl(ab, src);
}

__device__ __forceinline__ void indexer_strip(LAS unsigned char* lds, int b, int si, const bf16* Hb, const float* Hs, unsigned short* SEL, int* NSEL, int tid) {
    LAS unsigned* hist = (LAS unsigned*)lds;
    LAS unsigned* cB1 = (LAS unsigned*)(lds + IDX_CTL);
    LAS unsigned* cT22 = cB1 + 64;
    LAS unsigned* cCnt = cB1 + 128;
    LAS unsigned* cAb = cB1 + 192;
    const int lane = tid & 63, wave = __builtin_amdgcn_readfirstlane(tid >> 6);
    const int r = lane & 31, h = lane >> 5;
    const int t = b * L + si * 32 + r;
    bf16x8s Qb[4][4]; float wq[4];
#pragma unroll
    for (int hh = 0; hh < 4; ++hh) {
        wq[hh] = Hs[(size_t)t * 16 + hh] * 0.0625f;
#pragma unroll
        for (int s = 0; s < 4; ++s) Qb[hh][s] = *(const bf16x8s*)(Hb + (size_t)t * HN + H_QI + hh * 64 + 16 * s + 8 * h);
    }
    for (int i = tid; i < 32 * IDX_ROWW; i += 512) hist[i] = 0u;
    __syncthreads();
    idx_pass<1>(lds, Hb, b, si, wave, lane, Qb, wq, SEL);
    __syncthreads();
    for (int qq = 0; qq < 4; ++qq) {
        const int q = wave * 4 + qq; unsigned B; int ab; bool f;
        idx_find(hist, q, 256, lane, B, ab, f);
        if (lane == 0) { cB1[q] = f ? B : 0xffffffffu; cAb[q] = f ? (unsigned)ab : 0u; cCnt[q] = 0u; }
    }
    __syncthreads();
    for (int i = tid; i < 32 * IDX_ROWW; i += 512) hist[i] = 0u;
    __syncthreads();
    idx_pass<2>(lds, Hb, b, si, wave, lane, Qb, wq, SEL);
    __syncthreads();
    for (int qq = 0; qq < 4; ++qq) {
        const int q = wave * 4 + qq; unsigned B; int ab; bool f;
        const unsigned b1 = cB1[q]; const int ab1 = (int)cAb[q];
        idx_find(hist, q, 256 - ab1, lane, B, ab, f);
        if (lane == 0 && b1 != 0xffffffffu) { cT22[q] = (b1 << 11) | B; cAb[q] = (unsigned)(ab1 + ab); }
    }
    __syncthreads();
    for (int i = tid; i < 2 * 32 * 256; i += 512) hist[i] = 0u;
    __syncthreads();
    idx_pass<3>(lds, Hb, b, si, wave, lane, Qb, wq, SEL);
    __syncthreads();
    for (int qq = 0; qq < 4; ++qq) {
        const int q = wave * 4 + qq;
        const int tq = b * L + si * 32 + q;
        const bool takeall = (cB1[q] == 0xffffffffu);
        int base = 0;
#pragma unroll 1
        for (int part = 0; part < 2; ++part) {
            unsigned w4[4]; int own = 0;
#pragma unroll
            for (int i = 0; i < 4; ++i) { w4[i] = hist[part * 8192 + q * 256 + 4 * lane + i]; own += __popc(w4[i]); }
            int inc = own;
#pragma unroll
            for (int o = 1; o < 64; o <<= 1) { const int y = __shfl_up(inc, o); if (lane >= o) inc += y; }
            int rank = base + inc - own;
#pragma unroll
            for (int i = 0; i < 4; ++i) {
                unsigned w = w4[i];
                while (w) { const int bit = __ffs((int)w) - 1; w &= w - 1u;
                    if (rank < 256) SEL[(size_t)tq * 256 + rank] = (unsigned short)(128 * lane + 32 * i + bit);
                    ++rank; }
            }
            base += __shfl(inc, 63);
            if (takeall) break;
        }
        if (lane == 0) NSEL[tq] = takeall ? (si * 32 + q + 1) : 256;
    }
    __syncthreads();
}

__device__ __forceinline__ float logsigmoidf_(float x) { return fminf(x, 0.f) - log1pf(__expf(-fabsf(x))); }

__device__ __forceinline__ f32x16 mm32_f32(const LAS float* A, int a_rs, int a_ks, const LAS float* B, int b_ks, int b_cs, int lane) {
    f32x16 acc;
#pragma unroll
    for (int i = 0; i < 16; ++i) acc[i] = 0.f;
    const LAS float* ap = A + (lane & 31) * a_rs + (lane >> 5) * a_ks;
    const LAS float* bp = B + (lane >> 5) * b_ks + (lane & 31) * b_cs;
#pragma unroll 8
    for (int k0 = 0; k0 < 64; k0 += 2) acc = __builtin_amdgcn_mfma_f32_32x32x2f32(ap[k0 * a_ks], bp[k0 * b_ks], acc, 0, 0, 0);
    return acc;
}

__device__ __forceinline__ void mlstm_prep_unit(LAS unsigned char* lds, int cidx, const bf16* Hb, const float* Hs, const float* cmw, const float* cmb, const float* wqm, const float* wkm,
                                                const float* bi, const float* bfp, float* MQ, float* MK, float* MC, float* MN, float* SCL, float* BC, float* IG, int tid) {
    asm volatile("" : "+v"(tid));
    const int j = cidx & 127, h = (cidx >> 7) & 3, b = cidx >> 9, t0 = b * L + j * 64;
    const int lane = tid & 63, wave = tid >> 6;
    LAS float* xc = (LAS float*)lds;
    LAS float* wq = xc + 64 * 65;
    LAS float* wk = wq + 64 * 65;
    LAS float* kt = wk + 64 * 65;
    LAS float* vt = kt + 64 * 65;
    LAS float* wg = vt + 64 * 65;
    {
        const int s = tid >> 3, d0 = (tid & 7) * 8, c0 = h * 64 + d0;
        float av[8];
        { const f32x4 b0 = *(const f32x4*)(cmb + c0), b1 = *(const f32x4*)(cmb + c0 + 4); av[0] = b0.x; av[1] = b0.y; av[2] = b0.z; av[3] = b0.w; av[4] = b1.x; av[5] = b1.y; av[6] = b1.z; av[7] = b1.w; }
#pragma unroll
        for (int k = 0; k < 4; ++k) {
            const int pos = j * 64 + s - 3 + k;
            if (pos >= 0) {
                const v4u xv = *(const v4u*)(Hb + (size_t)(b * L + pos) * HN + H_XC + c0);
                const f32x4 w0 = *(const f32x4*)(cmw + k * 256 + c0), w1 = *(const f32x4*)(cmw + k * 256 + c0 + 4);
                av[0] += w0.x * lo16(xv.x); av[1] += w0.y * hi16(xv.x); av[2] += w0.z * lo16(xv.y); av[3] += w0.w * hi16(xv.y);
                av[4] += w1.x * lo16(xv.z); av[5] += w1.y * hi16(xv.z); av[6] += w1.z * lo16(xv.w); av[7] += w1.w * hi16(xv.w);
            }
        }
        const v4u vv = *(const v4u*)(Hb + (size_t)(t0 + s) * HN + H_V + c0);
        const float vf[8] = { lo16(vv.x), hi16(vv.x), lo16(vv.y), hi16(vv.y), lo16(vv.z), hi16(vv.z), lo16(vv.w), hi16(vv.w) };
        const f32x4 q0 = *(const f32x4*)(wqm + h * 4096 + s * 64 + d0), q1 = *(const f32x4*)(wqm + h * 4096 + s * 64 + d0 + 4);
        const f32x4 k0 = *(const f32x4*)(wkm + h * 4096 + s * 64 + d0), k1 = *(const f32x4*)(wkm + h * 4096 + s * 64 + d0 + 4);
        const float qf[8] = { q0.x, q0.y, q0.z, q0.w, q1.x, q1.y, q1.z, q1.w }, kf[8] = { k0.x, k0.y, k0.z, k0.w, k1.x, k1.y, k1.z, k1.w };
#pragma unroll
        for (int e = 0; e < 8; ++e) { xc[s * 65 + d0 + e] = av[e] * sigmoidf_(av[e]); vt[s * 65 + d0 + e] = vf[e]; wq[s * 65 + d0 + e] = qf[e]; wk[s * 65 + d0 + e] = kf[e]; }
    }
    __syncthreads();
    {
        const int tm = (wave >> 1) & 1, tn = wave & 1; const bool isk = wave >= 4;
        const f32x16 acc = mm32_f32(xc + tm * 32 * 65, 65, 1, (isk ? wk : wq) + tn * 32, 65, 1, lane);
        const int col = tn * 32 + (lane & 31);
#pragma unroll
        for (int i = 0; i < 16; ++i) {
            const int row = tm * 32 + (i & 3) + 8 * (i >> 2) + 4 * (lane >> 5);
            if (isk) { MK[(size_t)(t0 + row) * 256 + h * 64 + col] = acc[i]; kt[row * 65 + col] = acc[i]; }
            else MQ[(size_t)(t0 + row) * 256 + h * 64 + col] = acc[i] * 0.125f;
        }
    }
    if (tid < 64) {
        const int s = tid, t = t0 + s;
        const float fl = logsigmoidf_(Hs[(size_t)t * 16 + 8 + h] + bfp[h]);
        const float ig = Hs[(size_t)t * 16 + 4 + h] + bi[h];
        float bs = fl;
#pragma unroll
        for (int o = 1; o < 64; o <<= 1) { const float y = __shfl_up(bs, o); if (s >= o) bs += y; }
        const float bL = __shfl(bs, 63);
        const float g = bL - bs + ig;
        const float mloc = wave_max(g);
        wg[s] = __expf(g - mloc);
        BC[(size_t)t * 4 + h] = bs; IG[(size_t)t * 4 + h] = ig;
        if (s == 0) { SCL[cidx * 4 + 0] = mloc; SCL[cidx * 4 + 1] = bL; }
    }
    __syncthreads();
    for (int i = tid; i < 4096; i += 512) { const int s = i >> 6, d = i & 63; vt[s * 65 + d] *= wg[s]; }
    __syncthreads();
    if (wave < 4) {
        const int tm = wave >> 1, tn = wave & 1;
        const f32x16 acc = mm32_f32(vt + tm * 32, 1, 65, kt + tn * 32, 65, 1, lane);
        const int col = tn * 32 + (lane & 31);
#pragma unroll
        for (int i = 0; i < 16; ++i) { const int row = tm * 32 + (i & 3) + 8 * (i >> 2) + 4 * (lane >> 5); MC[(size_t)cidx * 4096 + row * 64 + col] = acc[i]; }
    } else if (wave == 4) { float s2 = 0.f;
        for (int s = 0; s < 64; ++s) s2 += wg[s] * kt[s * 65 + lane];
        MN[(size_t)cidx * 64 + lane] = s2; }
    __syncthreads();
}

__device__ __forceinline__ void mlstm_scan(int gtid, float* MC, float* MN, float* SCL) {
    const int stream = gtid / 4160, e = gtid - stream * 4160;
    if (stream >= 8) return;
    float* base = (e < 4096) ? (MC + e) : (MN + (e - 4096));
    const size_t stride = (e < 4096) ? 4096 : 64;
    float m = 0.f, C = 0.f;
    for (int j0 = 0; j0 < 128; j0 += 8) {
        float loc[8], ml[8], bl[8];
#pragma unroll
        for (int u = 0; u < 8; ++u) { const int cidx = stream * 128 + j0 + u; loc[u] = base[(size_t)cidx * stride]; ml[u] = SCL[cidx * 4 + 0]; bl[u] = SCL[cidx * 4 + 1]; }
#pragma unroll
        for (int u = 0; u < 8; ++u) {
            const int cidx = stream * 128 + j0 + u;
            const float mn = fmaxf(bl[u] + m, ml[u]);
            const float a = __expf(bl[u] + m - mn), c = __expf(ml[u] - mn);
            base[(size_t)cidx * stride] = C;
            if (e == 0) SCL[cidx * 4 + 2] = m;
            C = a * C + c * loc[u]; m = mn;
        }
    }
}

__device__ __forceinline__ int rel_bucket(int dist) {
    const int d = dist > 0 ? dist : 0;
    if (d < 16) return d;
    const int large = 16 + (int)(logf((float)d / 16.f) / 2.0794415416798357f * 16.f);
    return large < 31 ? large : 31;
}

__device__ __forceinline__ void dsa_attn_query(LAS unsigned char* wl, int t, const bf16* Hb, const bf16* CKV, const unsigned short* SEL, const int* NSEL, const float* relb, bf16* CAT, int lane) {
    LAS float* ql = (LAS float*)wl;
    LAS float* P = ql + 1024;
    LAS int* sl = (LAS int*)(P + 2048);
    const int b = t >> 13, pos = t & (L - 1), n = NSEL[t];
    for (int i = lane; i < 1024; i += 64) ql[i] = bf2f(Hb[(size_t)t * HN + H_QL + i]);
    for (int i = lane; i < 256; i += 64) sl[i] = (i < n) ? (int)SEL[(size_t)t * 256 + i] : 0;
    WAVE_LDS_SYNC();
    float lg[4][8];
#pragma unroll
    for (int i = 0; i < 4; ++i) {
        const int kk = lane + 64 * i;
        float acc[8];
#pragma unroll
        for (int h = 0; h < 8; ++h) acc[h] = 0.f;
        const int s = sl[kk];
        const bf16* cr = CKV + (size_t)(b * L + s) * 128;
        for (int c = 0; c < 128; c += 8) {
            const v4u cv = *(const v4u*)(cr + c);
            const float cf[8] = { lo16(cv.x), hi16(cv.x), lo16(cv.y), hi16(cv.y), lo16(cv.z), hi16(cv.z), lo16(cv.w), hi16(cv.w) };
#pragma unroll
            for (int h = 0; h < 8; ++h) {
#pragma unroll
                for (int jj = 0; jj < 8; ++jj) acc[h] += ql[h * 128 + c + jj] * cf[jj];
            }
        }
        const int bk = rel_bucket(pos - s);
#pragma unroll
        for (int h = 0; h < 8; ++h) lg[i][h] = (kk < n) ? (acc[h] * 0.125f + relb[bk * 8 + h]) : -INFINITY;
    }
#pragma unroll
    for (int h = 0; h < 8; ++h) {
        const float mx = wave_max(fmaxf(fmaxf(lg[0][h], lg[1][h]), fmaxf(lg[2][h], lg[3][h])));
        float e[4], sm = 0.f;
#pragma unroll
        for (int i = 0; i < 4; ++i) { e[i] = (lane + 64 * i < n) ? __expf(lg[i][h] - mx) : 0.f; sm += e[i]; }
        const float inv = 1.f / wave_sum(sm);
#pragma unroll
        for (int i = 0; i < 4; ++i) P[h * 256 + lane + 64 * i] = e[i] * inv;
    }
    WAVE_LDS_SYNC();
    float o[8][2];
#pragma unroll
    for (int h = 0; h < 8; ++h) { o[h][0] = 0.f; o[h][1] = 0.f; }
    for (int kk = 0; kk < n; ++kk) {
        const int s = sl[kk];
        const bf16* cr = CKV + (size_t)(b * L + s) * 128;
        const float c0 = bf2f(cr[lane]), c1 = bf2f(cr[64 + lane]);
#pragma unroll
        for (int h = 0; h < 8; ++h) { const float p = P[h * 256 + kk]; o[h][0] += p * c0; o[h][1] += p * c1; }
    }
#pragma unroll
    for (int h = 0; h < 8; ++h) {
        CAT[(size_t)t * CATW + CAT_B + h * 128 + lane] = (bf16)f2bf(o[h][0]);
        CAT[(size_t)t * CATW + CAT_B + h * 128 + 64 + lane] = (bf16)f2bf(o[h][1]);
    }
    WAVE_LDS_SYNC();
}

__device__ __forceinline__ void mlstm_out_unit(LAS unsigned char* lds, int cidx, const bf16* Hb, const float* MQ, const float* MK, const float* MC, const float* MN, const float* SCL,
                                               const float* BC, const float* IG, const float* nmg, bf16* CAT, int tid) {
    asm volatile("" : "+v"(tid));
    const int j = cidx & 127, h = (cidx >> 7) & 3, b = cidx >> 9, t0 = b * L + j * 64;
    const int lane = tid & 63, wave = tid >> 6;
    LAS float* q = (LAS float*)lds;
    LAS float* k = q + 64 * 65;
    LAS float* v = k + 64 * 65;
    LAS float* C = v + 64 * 65;
    LAS float* S = C + 64 * 65;
    LAS float* hh = S + 64 * 65;
    LAS float* nn = hh + 64 * 65;
    LAS float* bb = nn + 64;
    LAS float* gi = bb + 64;
    LAS float* mrow = gi + 64;
    LAS float* den = mrow + 64;
    LAS float* wint = den + 64;
    {
        const int s = tid >> 3, d0 = (tid & 7) * 8;
        const f32x4 q0 = *(const f32x4*)(MQ + (size_t)(t0 + s) * 256 + h * 64 + d0), q1 = *(const f32x4*)(MQ + (size_t)(t0 + s) * 256 + h * 64 + d0 + 4);
        const f32x4 k0 = *(const f32x4*)(MK + (size_t)(t0 + s) * 256 + h * 64 + d0), k1 = *(const f32x4*)(MK + (size_t)(t0 + s) * 256 + h * 64 + d0 + 4);
        const f32x4 c0 = *(const f32x4*)(MC + (size_t)cidx * 4096 + s * 64 + d0), c1 = *(const f32x4*)(MC + (size_t)cidx * 4096 + s * 64 + d0 + 4);
        const v4u vv = *(const v4u*)(Hb + (size_t)(t0 + s) * HN + H_V + h * 64 + d0);
        const float qf[8] = { q0.x, q0.y, q0.z, q0.w, q1.x, q1.y, q1.z, q1.w }, kf[8] = { k0.x, k0.y, k0.z, k0.w, k1.x, k1.y, k1.z, k1.w };
        const float cf[8] = { c0.x, c0.y, c0.z, c0.w, c1.x, c1.y, c1.z, c1.w };
        const float vf[8] = { lo16(vv.x), hi16(vv.x), lo16(vv.y), hi16(vv.y), lo16(vv.z), hi16(vv.z), lo16(vv.w), hi16(vv.w) };
#pragma unroll
        for (int e = 0; e < 8; ++e) { q[s * 65 + d0 + e] = qf[e]; k[s * 65 + d0 + e] = kf[e]; C[s * 65 + d0 + e] = cf[e]; v[s * 65 + d0 + e] = vf[e]; }
    }
    if (tid < 64) { nn[tid] = MN[(size_t)cidx * 64 + tid]; bb[tid] = BC[(size_t)(t0 + tid) * 4 + h]; gi[tid] = IG[(size_t)(t0 + tid) * 4 + h]; }
    const float m_in = SCL[cidx * 4 + 2];
    __syncthreads();
    if (tid < 64) {
        const int t = tid; const float bt = bb[t]; float rm = -INFINITY;
        for (int s = 0; s <= t; ++s) rm = fmaxf(rm, bt - bb[s] + gi[s]);
        const float mr = fmaxf(bt + m_in, rm);
        mrow[t] = mr; wint[t] = __expf(bt + m_in - mr);
    }
    __syncthreads();
    f32x16 cq;
    if (wave < 4) {
        const int tm = wave >> 1, tn = wave & 1;
        if (!(tm == 0 && tn == 1)) {
            const f32x16 acc = mm32_f32(q + tm * 32 * 65, 65, 1, k + tn * 32 * 65, 1, 65, lane);
            const int s_ = tn * 32 + (lane & 31); const float bs = bb[s_] - gi[s_];
#pragma unroll
            for (int i = 0; i < 16; ++i) { const int t = tm * 32 + (i & 3) + 8 * (i >> 2) + 4 * (lane >> 5);
                S[t * 65 + s_] = (s_ <= t) ? acc[i] * __expf(bb[t] - bs - mrow[t]) : 0.f; }
        } else {
            const int s_ = 32 + (lane & 31);
#pragma unroll
            for (int i = 0; i < 16; ++i) { const int t = (i & 3) + 8 * (i >> 2) + 4 * (lane >> 5); S[t * 65 + s_] = 0.f; }
        }
    } else {
        const int tm = (wave >> 1) & 1, tn = wave & 1;
        cq = mm32_f32(q + tm * 32 * 65, 65, 1, C + tn * 32 * 65, 1, 65, lane);
    }
    __syncthreads();
    if (tid < 64) {
        const int t = tid; float a = 0.f, nq = 0.f;
#pragma unroll 8
        for (int s = 0; s < 64; ++s) a += S[t * 65 + s];
#pragma unroll 8
        for (int d = 0; d < 64; ++d) nq += nn[d] * q[t * 65 + d];
        const float dn = a + wint[t] * nq;
        den[t] = fmaxf(fabsf(dn), __expf(-mrow[t]));
    }
    f32x16 sv;
    if (wave >= 4) {
        const int tm = (wave >> 1) & 1, tn = wave & 1;
        sv = mm32_f32(S + tm * 32 * 65, 65, 1, v + tn * 32, 65, 1, lane);
    }
    __syncthreads();
    if (wave >= 4) {
        const int tm = (wave >> 1) & 1, tn = wave & 1, vv = tn * 32 + (lane & 31);
#pragma unroll
        for (int i = 0; i < 16; ++i) { const int t = tm * 32 + (i & 3) + 8 * (i >> 2) + 4 * (lane >> 5); hh[t * 65 + vv] = (sv[i] + wint[t] * cq[i]) / den[t]; }
    }
    __syncthreads();
    {
        for (int t = wave; t < 64; t += 8) {
            const float x = hh[t * 65 + lane];
            const float mean = wave_sum(x) * (1.f / 64.f);
            const float dx = x - mean;
            const float var = wave_sum(dx * dx) * (1.f / 64.f);
            const float y = dx * rsqrtf(var + LN_EPS) * nmg[h * 64 + lane];
            const float og = bf2f(Hb[(size_t)(t0 + t) * HN + H_O + h * 64 + lane]);
            CAT[(size_t)(t0 + t) * CATW + CAT_C + h * 64 + lane] = (bf16)f2bf(sigmoidf_(og) * y);
        }
    }
    __syncthreads();
}

__device__ __forceinline__ void xattn_token(LAS unsigned char* wl, int t, const bf16* QX, const bf16* KV, bf16* OX, int lane) {
    LAS float* qs = (LAS float*)wl;
    LAS float* P = qs + 256;
    const int b = t >> 13;
    const bf16* kvb = KV + (size_t)b * 256 * 2048;
    for (int h = 0; h < 4; ++h) {
        for (int i = lane; i < 256; i += 64) qs[i] = bf2f(QX[(size_t)t * D + h * 256 + i]);
        WAVE_LDS_SYNC();
        float lg[4];
#pragma unroll
        for (int i = 0; i < 4; ++i) {
            const int m = lane + 64 * i;
            const bf16* kr = kvb + (size_t)m * 2048 + h * 256;
            float a = 0.f;
            for (int c = 0; c < 256; c += 8) {
                const v4u kk = *(const v4u*)(kr + c);
                a += lo16(kk.x) * qs[c] + hi16(kk.x) * qs[c + 1] + lo16(kk.y) * qs[c + 2] + hi16(kk.y) * qs[c + 3] + lo16(kk.z) * qs[c + 4] + hi16(kk.z) * qs[c + 5] + lo16(kk.w) * qs[c + 6] + hi16(kk.w) * qs[c + 7];
            }
            lg[i] = a * 0.0625f;
        }
        const float mx = wave_max(fmaxf(fmaxf(lg[0], lg[1]), fmaxf(lg[2], lg[3])));
        float e[4], sm = 0.f;
#pragma unroll
        for (int i = 0; i < 4; ++i) { e[i] = __expf(lg[i] - mx); sm += e[i]; }
        const float inv = 1.f / wave_sum(sm);
#pragma unroll
        for (int i = 0; i < 4; ++i) P[lane + 64 * i] = e[i] * inv;
        WAVE_LDS_SYNC();
        float o[4] = { 0.f, 0.f, 0.f, 0.f };
        for (int m = 0; m < 256; ++m) {
            const float p = P[m];
            const bf16* vr = kvb + (size_t)m * 2048 + 1024 + h * 256;
#pragma unroll
            for (int i = 0; i < 4; ++i) o[i] += p * bf2f(vr[lane + 64 * i]);
        }
#pragma unroll
        for (int i = 0; i < 4; ++i) OX[(size_t)t * D + h * 256 + lane + 64 * i] = (bf16)f2bf(o[i]);
        WAVE_LDS_SYNC();
    }
}

__device__ __forceinline__ unsigned cvt_pk_bf16_(float lo, float hi) { unsigned r; asm volatile("v_cvt_pk_bf16_f32 %0, %1, %2" : "=v"(r) : "v"(lo), "v"(hi)); return r; }
typedef unsigned u32x4_ __attribute__((ext_vector_type(4)));
__device__ __forceinline__ void xattn_unit(int unit, const bf16* QX, const bf16* Kb, const bf16* VT, bf16* OX, int lane) {
    const int strip = unit >> 2, hd = unit & 3;
    const int t0 = strip * 32, b = t0 >> 13;
    const int r = lane & 31, h = lane >> 5;
    const int sig = 16 * ((r >> 2) & 1) + 4 * (r >> 3) + (r & 3);
    bf16x8s Qf[16];
    {
        const bf16* qp = QX + (size_t)(t0 + r) * D + hd * 256 + 16 * h;
#pragma unroll
        for (int p = 0; p < 8; ++p) { Qf[2 * p] = *(const bf16x8s*)(qp + 32 * p); Qf[2 * p + 1] = *(const bf16x8s*)(qp + 32 * p + 8); }
    }
    f32x16 S[8];
#pragma unroll
    for (int kb = 0; kb < 8; ++kb) {
#pragma unroll
        for (int i = 0; i < 16; ++i) S[kb][i] = 0.f;
        const bf16* kp = Kb + (size_t)(b * 256 + kb * 32 + sig) * D + hd * 256 + 16 * h;
#pragma unroll
        for (int p = 0; p < 8; ++p) {
            if ((p & 3) == 0) asm volatile("" ::: "memory");
            const bf16x8s k0 = *(const bf16x8s*)(kp + 32 * p), k1 = *(const bf16x8s*)(kp + 32 * p + 8);
            S[kb] = __builtin_amdgcn_mfma_f32_32x32x16_bf16(k0, Qf[2 * p], S[kb], 0, 0, 0);
            S[kb] = __builtin_amdgcn_mfma_f32_32x32x16_bf16(k1, Qf[2 * p + 1], S[kb], 0, 0, 0);
        }
    }
    float mx = -INFINITY;
#pragma unroll
    for (int kb = 0; kb < 8; ++kb)
#pragma unroll
        for (int i = 0; i < 16; ++i) mx = fmaxf(mx, S[kb][i]);
    mx = fmaxf(mx, __shfl_xor(mx, 32));
    const float c = 0.0625f * 1.4426950408889634f;
    float sum = 0.f;
    bf16x8s Pf[16];
#pragma unroll
    for (int kb = 0; kb < 8; ++kb) {
#pragma unroll
        for (int i = 0; i < 16; ++i) { const float e = __builtin_amdgcn_exp2f((S[kb][i] - mx) * c); S[kb][i] = e; sum += e; }
#pragma unroll
        for (int s2 = 0; s2 < 2; ++s2) {
            u32x4_ w;
            w.x = cvt_pk_bf16_(S[kb][8 * s2 + 0], S[kb][8 * s2 + 1]); w.y = cvt_pk_bf16_(S[kb][8 * s2 + 2], S[kb][8 * s2 + 3]);
            w.z = cvt_pk_bf16_(S[kb][8 * s2 + 4], S[kb][8 * s2 + 5]); w.w = cvt_pk_bf16_(S[kb][8 * s2 + 6], S[kb][8 * s2 + 7]);
            Pf[2 * kb + s2] = __builtin_bit_cast(bf16x8s, w);
        }
    }
    sum += __shfl_xor(sum, 32);
    const float inv = 1.f / sum;
    bf16* op = OX + (size_t)(t0 + r) * D + hd * 256 + 4 * h;
#pragma unroll
    for (int db = 0; db < 8; ++db) {
        f32x16 O;
#pragma unroll
        for (int i = 0; i < 16; ++i) O[i] = 0.f;
        const bf16* vp = VT + (size_t)(hd * 256 + db * 32 + r) * 512 + b * 256 + 16 * h;
#pragma unroll
        for (int kb = 0; kb < 8; ++kb) {
            if ((kb & 3) == 0) asm volatile("" ::: "memory");
            const bf16x8s v0 = *(const bf16x8s*)(vp + 32 * kb), v1 = *(const bf16x8s*)(vp + 32 * kb + 8);
            O = __builtin_amdgcn_mfma_f32_32x32x16_bf16(v0, Pf[2 * kb], O, 0, 0, 0);
            O = __builtin_amdgcn_mfma_f32_32x32x16_bf16(v1, Pf[2 * kb + 1], O, 0, 0, 0);
        }
#pragma unroll
        for (int g = 0; g < 4; ++g) {
            v2u w; w.x = pk2(O[4 * g] * inv, O[4 * g + 1] * inv); w.y = pk2(O[4 * g + 2] * inv, O[4 * g + 3] * inv);
            *(v2u*)(op + db * 32 + 8 * g) = w;
        }
    }
}

typedef short s16x4 __attribute__((ext_vector_type(4)));
__device__ __forceinline__ unsigned off_b(unsigned row, unsigned ch) { return 256u * row + 16u * (ch ^ (((row & 3u) << 2) | ((row >> 2) & 3u))); }
constexpr int DSA_TILE = 8192;
__device__ __forceinline__ void dsa_fill(LAS unsigned char* tile, const LAS int* slb, const bf16* ckv_b, int ck, int lane) {
    const int pos = lane & 15;
#pragma unroll
    for (int i = 0; i < 8; ++i) {
        const int row = 4 * i + (lane >> 4);
        const int s = slb[ck * 32 + row] & 0xffff;
        const unsigned ch = (unsigned)pos ^ ((((unsigned)row & 3u) << 2) | (((unsigned)row >> 2) & 3u));
        __builtin_amdgcn_global_load_lds((const unsigned*)(ckv_b + (size_t)s * 128 + ch * 8), (LAS unsigned*)(tile + i * 1024), 16, 0, 0);
    }
}
__device__ __forceinline__ void dsa_attn_mfma(LAS unsigned char* wl, LAS int* slb, const LAS float* relb_l, int t, const bf16* Hb, const bf16* CKV,
                                              const unsigned short* SEL, const int* NSEL, bf16* CAT, int lane) {
    const int hd = lane & 15, G = lane >> 4;
    const int b = t >> 13, pos = t & (L - 1), n = NSEL[t];
    const bf16* ckv_b = CKV + (size_t)b * L * 128;
    for (int i = lane; i < 256; i += 64) { const int s = (i < n) ? (int)SEL[(size_t)t * 256 + i] : 0; slb[i] = s | (rel_bucket(pos - s) << 16); }
    bf16x8s Qf[4];
#pragma unroll
    for (int s = 0; s < 4; ++s) {
        if (hd < 8) Qf[s] = *(const bf16x8s*)(Hb + (size_t)t * HN + H_QL + hd * 128 + 32 * s + 8 * G);
        else {
#pragma unroll
            for (int j = 0; j < 8; ++j) Qf[s][j] = 0;
        }
    }
    WAVE_LDS_SYNC();
    const int nch = (n + 31) >> 5;
    dsa_fill(wl, slb, ckv_b, 0, lane);
    float m = -INFINITY, lsum = 0.f;
    f32x4 O[8];
#pragma unroll
    for (int c = 0; c < 8; ++c) O[c] = (f32x4){0.f, 0.f, 0.f, 0.f};
    const unsigned q4 = (unsigned)(lane & 15) >> 2, p4 = (unsigned)lane & 3u;
    for (int ck = 0; ck < nch; ++ck) {
        LAS unsigned char* tile = wl + (ck & 1) * DSA_TILE;
        WAVE_LDS_SYNC();
        if (ck + 1 < nch) { dsa_fill(wl + ((ck + 1) & 1) * DSA_TILE, slb, ckv_b, ck + 1, lane); asm volatile("s_waitcnt vmcnt(8)" ::: "memory"); }
        else asm volatile("s_waitcnt vmcnt(0)" ::: "memory");
        f32x4 acc[2];
#pragma unroll
        for (int rb = 0; rb < 2; ++rb) {
            acc[rb] = (f32x4){0.f, 0.f, 0.f, 0.f};
#pragma unroll
            for (int s = 0; s < 4; ++s) {
                const bf16x8s A = *(const LAS bf16x8s*)(tile + off_b((unsigned)hd + 16u * rb, 4u * s + (unsigned)G));
                acc[rb] = __builtin_amdgcn_mfma_f32_16x16x32_bf16(A, Qf[s], acc[rb], 0, 0, 0);
            }
        }
        float lg[8]; float cm = -INFINITY;
#pragma unroll
        for (int rb = 0; rb < 2; ++rb)
#pragma unroll
            for (int rg = 0; rg < 4; ++rg) {
                const int kk = ck * 32 + 16 * rb + 4 * G + rg;
                const int e = slb[kk];
                const float bias = relb_l[(e >> 16) * 8 + (hd & 7)];
                const float v = (hd < 8) ? (acc[rb][rg] * 0.125f + bias) : 0.f;
                lg[4 * rb + rg] = (kk < n) ? v : -INFINITY;
                cm = fmaxf(cm, lg[4 * rb + rg]);
            }
        cm = fmaxf(cm, __shfl_xor(cm, 16)); cm = fmaxf(cm, __shfl_xor(cm, 32));
        const float mn = fmaxf(m, cm);
        const float scale = __expf(m - mn);
        float ps = 0.f;
#pragma unroll
        for (int j = 0; j < 8; ++j) { lg[j] = __expf(lg[j] - mn); ps += lg[j]; }
        ps += __shfl_xor(ps, 16); ps += __shfl_xor(ps, 32);
        lsum = lsum * scale + ps; m = mn;
        u32x4_ pw; pw.x = cvt_pk_bf16_(lg[0], lg[1]); pw.y = cvt_pk_bf16_(lg[2], lg[3]); pw.z = cvt_pk_bf16_(lg[4], lg[5]); pw.w = cvt_pk_bf16_(lg[6], lg[7]);
        const bf16x8s Pf = __builtin_bit_cast(bf16x8s, pw);
#pragma unroll
        for (int c = 0; c < 8; ++c) {
            const s16x4 c0 = __builtin_amdgcn_ds_read_tr16_b64_v4i16((LAS s16x4*)(tile + off_b(4u * G + q4, 2u * c + (p4 >> 1)) + 8u * (p4 & 1u)));
            const s16x4 c1 = __builtin_amdgcn_ds_read_tr16_b64_v4i16((LAS s16x4*)(tile + off_b(16u + 4u * G + q4, 2u * c + (p4 >> 1)) + 8u * (p4 & 1u)));
            bf16x8s A; A[0] = c0[0]; A[1] = c0[1]; A[2] = c0[2]; A[3] = c0[3]; A[4] = c1[0]; A[5] = c1[1]; A[6] = c1[2]; A[7] = c1[3];
            O[c] = O[c] * scale;
            O[c] = __builtin_amdgcn_mfma_f32_16x16x32_bf16(A, Pf, O[c], 0, 0, 0);
        }
    }
    const float inv = 1.f / lsum;
    if (hd < 8) {
        bf16* op = CAT + (size_t)t * CATW + CAT_B + hd * 128 + 4 * G;
#pragma unroll
        for (int c = 0; c < 8; ++c) { v2u w; w.x = pk2(O[c][0] * inv, O[c][1] * inv); w.y = pk2(O[c][2] * inv, O[c][3] * inv); *(v2u*)(op + 16 * c) = w; }
    }
    WAVE_LDS_SYNC();
}

__device__ __forceinline__ float gelu_exact(float x) { return 0.5f * x * (1.f + erff(x * 0.70710678118654752f)); }

template <int N> __device__ __forceinline__ void bitonic_desc(unsigned (&a)[N]) {
#pragma unroll
    for (int k = 2; k <= N; k <<= 1) {
#pragma unroll
        for (int j = k >> 1; j > 0; j >>= 1) {
#pragma unroll
            for (int i = 0; i < N; ++i) {
                const int l = i ^ j;
                if (l > i) {
                    const unsigned x = a[i], y = a[l];
                    const unsigned mx = x > y ? x : y, mn = x > y ? y : x;
                    if ((i & k) == 0) { a[i] = mx; a[l] = mn; } else { a[i] = mn; a[l] = mx; }
                }
            }
        }
    }
}
__device__ __forceinline__ float funkey(unsigned k) { return __uint_as_float((k & 0x80000000u) ? (k & 0x7fffffffu) : ~k); }

__device__ __forceinline__ void bitonic_merge16_desc(unsigned (&a)[16]) {
#pragma unroll
    for (int j = 8; j > 0; j >>= 1) {
#pragma unroll
        for (int i = 0; i < 16; ++i) {
            const int l = i ^ j;
            if (l > i) { const unsigned x = a[i], y = a[l]; a[i] = x > y ? x : y; a[l] = x > y ? y : x; }
        }
    }
}
__device__ __forceinline__ void merge_top16(unsigned (&top)[16], const unsigned (&b)[16]) {
#pragma unroll
    for (int i = 0; i < 16; ++i) top[i] = top[i] > b[15 - i] ? top[i] : b[15 - i];
    bitonic_merge16_desc(top);
}

__device__ __forceinline__ void peer_route_unit(const LAS unsigned char* sk, int t0, const bf16* QP, int* EXP, float* GATE, int lane) {
    asm volatile("" : "+v"(lane));
    const int r = lane & 31, h = lane >> 5, tokl = r >> 3, hh = r & 7;
    unsigned top[2][16];
#pragma unroll
    for (int sd = 0; sd < 2; ++sd) {
        bf16x8s Qf[8];
        {
            const bf16* qrow = QP + (size_t)(t0 + tokl) * 2048 + hh * 256 + 8 * h + sd * 128;
#pragma unroll
            for (int s = 0; s < 8; ++s) Qf[s] = *(const bf16x8s*)(qrow + 16 * s);
        }
#pragma unroll
        for (int kb = 0; kb < 4; ++kb) {
            f32x16 acc;
#pragma unroll
            for (int i = 0; i < 16; ++i) acc[i] = 0.f;
            const int n = kb * 32 + r;
            asm volatile("" ::: "memory");
#pragma unroll
            for (int s = 0; s < 8; ++s) {
                const bf16x8s A = *(const LAS bf16x8s*)(sk + sd * 32768 + n * 256 + (((2 * s + h) ^ (n & 15)) << 4));
                acc = __builtin_amdgcn_mfma_f32_32x32x16_bf16(A, Qf[s], acc, 0, 0, 0);
            }
            unsigned ky[16];
#pragma unroll
            for (int i = 0; i < 16; ++i) { const int c7 = 127 - (kb * 32 + (i & 3) + 8 * (i >> 2)); ky[i] = ((fkey(acc[i]) & ~127u) | (unsigned)c7) ^ (unsigned)(4 * h); }
            bitonic_desc<16>(ky);
            if (kb == 0) {
#pragma unroll
                for (int i = 0; i < 16; ++i) top[sd][i] = ky[i];
            } else merge_top16(top[sd], ky);
            __builtin_amdgcn_sched_barrier(0);
        }
        unsigned o16[16];
#pragma unroll
        for (int i = 0; i < 16; ++i) o16[i] = (unsigned)__shfl_xor((int)top[sd][i], 32);
        merge_top16(top[sd], o16);
        __builtin_amdgcn_sched_barrier(0);
    }
    float v1[16], v2[16]; unsigned P1[4] = {0u, 0u, 0u, 0u}, P2[4] = {0u, 0u, 0u, 0u};
#pragma unroll
    for (int a = 0; a < 16; ++a) {
        v1[a] = funkey(top[0][a] & ~127u); v2[a] = funkey(top[1][a] & ~127u);
        P1[a >> 2] |= (127u - (top[0][a] & 127u)) << (8 * (a & 3)); P2[a >> 2] |= (127u - (top[1][a] & 127u)) << (8 * (a & 3));
    }
#define CKEY(a, b) ((fkey(v1[a] + v2[b]) & ~255u) | (unsigned)(255 - ((a) * 16 + (b))))
    unsigned ctop[16], g[16];
#pragma unroll
    for (int b = 0; b < 16; ++b) ctop[b] = CKEY(0, b);
#pragma unroll
    for (int b = 0; b < 8; ++b) { g[b] = CKEY(1, b); g[15 - b] = CKEY(8 + b, 0); }
    bitonic_merge16_desc(g);
    merge_top16(ctop, g);
    g[0] = CKEY(2, 0); g[1] = CKEY(2, 1); g[2] = CKEY(2, 2); g[3] = CKEY(2, 3); g[4] = CKEY(2, 4);
    g[5] = CKEY(3, 0); g[6] = CKEY(3, 1); g[7] = CKEY(3, 2); g[8] = CKEY(3, 3);
    g[9] = CKEY(4, 0); g[10] = CKEY(4, 1); g[11] = CKEY(4, 2);
    g[12] = CKEY(5, 0); g[13] = CKEY(5, 1); g[14] = CKEY(6, 0); g[15] = CKEY(6, 1);
    bitonic_desc<16>(g);
    merge_top16(ctop, g);
    {
        const unsigned c0 = CKEY(7, 0), c1 = CKEY(7, 1);
        g[0] = c0 > c1 ? c0 : c1; g[1] = c0 > c1 ? c1 : c0;
#pragma unroll
        for (int i = 2; i < 16; ++i) g[i] = 0u;
        merge_top16(ctop, g);
    }
#undef CKEY
    float ex[16], sum = 0.f;
    const float mx = funkey(ctop[0] & ~255u);
#pragma unroll
    for (int j = 0; j < 16; ++j) { ex[j] = __expf(funkey(ctop[j] & ~255u) - mx); sum += ex[j]; }
    const float inv = 1.f / sum;
    unsigned ev[16]; float gv[16];
#pragma unroll
    for (int j = 0; j < 16; ++j) {
        const unsigned flat = 255u - (ctop[j] & 255u), a = flat >> 4, b = flat & 15u;
        const unsigned w1 = (a >> 2) == 0 ? P1[0] : (a >> 2) == 1 ? P1[1] : (a >> 2) == 2 ? P1[2] : P1[3];
        const unsigned w2 = (b >> 2) == 0 ? P2[0] : (b >> 2) == 1 ? P2[1] : (b >> 2) == 2 ? P2[2] : P2[3];
        const unsigned i1 = (w1 >> (8 * (a & 3))) & 255u, i2 = (w2 >> (8 * (b & 3))) & 255u;
        ev[j] = i1 * 128u + i2; gv[j] = ex[j] * inv;
    }
    const size_t o = (size_t)(t0 + tokl) * 128 + hh * 16;
    if (h == 0) {
#pragma unroll
        for (int j = 0; j < 4; ++j) { v4u w; w.x = ev[4 * j]; w.y = ev[4 * j + 1]; w.z = ev[4 * j + 2]; w.w = ev[4 * j + 3]; *(v4u*)(EXP + o + 4 * j) = w; }
    } else {
#pragma unroll
        for (int j = 0; j < 4; ++j) { f32x4 w; w.x = gv[4 * j]; w.y = gv[4 * j + 1]; w.z = gv[4 * j + 2]; w.w = gv[4 * j + 3]; *(f32x4*)(GATE + o + 4 * j) = w; }
    }
}

typedef float f32x2_ __attribute__((ext_vector_type(2)));
__device__ __forceinline__ float dot16_fp8(v4u w, const float (&x)[16]) {
    const f32x2_ a0 = __builtin_amdgcn_cvt_pk_f32_fp8((int)w.x, false), a1 = __builtin_amdgcn_cvt_pk_f32_fp8((int)w.x, true);
    const f32x2_ b0 = __builtin_amdgcn_cvt_pk_f32_fp8((int)w.y, false), b1 = __builtin_amdgcn_cvt_pk_f32_fp8((int)w.y, true);
    const f32x2_ c0 = __builtin_amdgcn_cvt_pk_f32_fp8((int)w.z, false), c1 = __builtin_amdgcn_cvt_pk_f32_fp8((int)w.z, true);
    const f32x2_ d0 = __builtin_amdgcn_cvt_pk_f32_fp8((int)w.w, false), d1 = __builtin_amdgcn_cvt_pk_f32_fp8((int)w.w, true);
    return ((a0.x * x[0] + a0.y * x[1]) + (a1.x * x[2] + a1.y * x[3])) + ((b0.x * x[4] + b0.y * x[5]) + (b1.x * x[6] + b1.y * x[7]))
         + ((c0.x * x[8] + c0.y * x[9]) + (c1.x * x[10] + c1.y * x[11])) + ((d0.x * x[12] + d0.y * x[13]) + (d1.x * x[14] + d1.y * x[15]));
}
__device__ __forceinline__ void axpy16_fp8(float c, v4u w, float (&o)[16]) {
    const f32x2_ a0 = __builtin_amdgcn_cvt_pk_f32_fp8((int)w.x, false), a1 = __builtin_amdgcn_cvt_pk_f32_fp8((int)w.x, true);
    const f32x2_ b0 = __builtin_amdgcn_cvt_pk_f32_fp8((int)w.y, false), b1 = __builtin_amdgcn_cvt_pk_f32_fp8((int)w.y, true);
    const f32x2_ c0 = __builtin_amdgcn_cvt_pk_f32_fp8((int)w.z, false), c1 = __builtin_amdgcn_cvt_pk_f32_fp8((int)w.z, true);
    const f32x2_ d0 = __builtin_amdgcn_cvt_pk_f32_fp8((int)w.w, false), d1 = __builtin_amdgcn_cvt_pk_f32_fp8((int)w.w, true);
    o[0] += c * a0.x; o[1] += c * a0.y; o[2] += c * a1.x; o[3] += c * a1.y; o[4] += c * b0.x; o[5] += c * b0.y; o[6] += c * b1.x; o[7] += c * b1.y;
    o[8] += c * c0.x; o[9] += c * c0.y; o[10] += c * c1.x; o[11] += c * c1.y; o[12] += c * d0.x; o[13] += c * d0.y; o[14] += c * d1.x; o[15] += c * d1.y;
}
struct PeerRows { v4u w[8]; };
__device__ __forceinline__ void peer_ld_ids(int (&id)[16], const int* EXP, int t, int g) {
    const v4u* ep = (const v4u*)(EXP + (size_t)t * 128 + 16 * g);
#pragma unroll
    for (int i = 0; i < 4; ++i) { const v4u e = ep[i]; id[4 * i] = (int)e.x; id[4 * i + 1] = (int)e.y; id[4 * i + 2] = (int)e.z; id[4 * i + 3] = (int)e.w; }
}
template <int HALF_>
__device__ __forceinline__ void peer_ld_rows(PeerRows& R, const unsigned char* TB, const int (&id)[16], int k) {
#pragma unroll
    for (int i = 0; i < 8; ++i) R.w[i] = *(const v4u*)(TB + (size_t)id[8 * HALF_ + i] * 128 + 16 * k);
}
__device__ __forceinline__ void peer_ld_vec16(float (&x)[16], const float* p) {
    const f32x4* xr = (const f32x4*)p;
#pragma unroll
    for (int i = 0; i < 4; ++i) { const f32x4 v = xr[i]; x[4 * i] = v.x; x[4 * i + 1] = v.y; x[4 * i + 2] = v.z; x[4 * i + 3] = v.w; }
}
__device__ __forceinline__ void peer_u_half(const PeerRows& R, const float (&x)[16], float* PDj, int t, int g, int k, int hb) {
    float p[8];
#pragma unroll
    for (int i = 0; i < 8; ++i) p[i] = dot16_fp8(R.w[i], x);
    const bool b2 = (k & 4) != 0, b1 = (k & 2) != 0, b0 = (k & 1) != 0;
    float a4[4], a2[2];
#pragma unroll
    for (int i = 0; i < 4; ++i) a4[i] = (b2 ? p[i + 4] : p[i]) + __shfl_xor(b2 ? p[i] : p[i + 4], 4);
#pragma unroll
    for (int i = 0; i < 2; ++i) a2[i] = (b1 ? a4[i + 2] : a4[i]) + __shfl_xor(b1 ? a4[i] : a4[i + 2], 2);
    const float a1 = (b0 ? a2[1] : a2[0]) + __shfl_xor(b0 ? a2[0] : a2[1], 1);
    PDj[(size_t)t * 128 + 16 * g + 8 * hb + k] = a1;
}
template <int NT>
__device__ __forceinline__ void peer_u_tokens(const unsigned char* TU, int j, int t0, const int* EXP, const float* X, float* PDj, int lane) {
    asm volatile("" : "+v"(lane) :: "memory");
    const int g = lane >> 3, k = lane & 7;
    const float* xb = X + 128 * j + 16 * k;
    PeerRows R0, R1; float x[16], xn[16]; int idA[16], idB[16];
    peer_ld_ids(idA, EXP, t0, g); peer_ld_vec16(x, xb + (size_t)t0 * D);
    peer_ld_rows<0>(R0, TU, idA, k);
    peer_ld_ids(idB, EXP, t0 + 1, g);
#pragma unroll 1
    for (int i = 0; i < NT; ++i) {
        const int t = t0 + i, tn = (i + 1 < NT) ? t + 1 : t, tnn = (i + 2 < NT) ? t + 2 : t;
        peer_ld_rows<1>(R1, TU, idA, k);
        peer_ld_vec16(xn, xb + (size_t)tn * D);
        peer_u_half(R0, x, PDj, t, g, k, 0);
        peer_ld_rows<0>(R0, TU, idB, k);
        peer_u_half(R1, x, PDj, t, g, k, 1);
#pragma unroll
        for (int q = 0; q < 16; ++q) { idA[q] = idB[q]; x[q] = xn[q]; }
        peer_ld_ids(idB, EXP, tnn, g);
    }
}
template <int HALF_>
__device__ __forceinline__ void peer_v_half(const PeerRows& R, const float (&cf)[16], float (&o)[16]) {
#pragma unroll
    for (int i = 0; i < 8; ++i) axpy16_fp8(cf[8 * HALF_ + i], R.w[i], o);
}
__device__ __forceinline__ void peer_v_finish(float (&o)[16], float* X, int j, int t, int lane) {
    const int g = lane >> 3, k = lane & 7;
    const bool b5 = (lane & 32) != 0, b4 = (lane & 16) != 0, b3 = (lane & 8) != 0;
    float a8[8], a4[4], a2[2];
#pragma unroll
    for (int i = 0; i < 8; ++i) a8[i] = (b5 ? o[i + 8] : o[i]) + __shfl_xor(b5 ? o[i] : o[i + 8], 32);
#pragma unroll
    for (int i = 0; i < 4; ++i) a4[i] = (b4 ? a8[i + 4] : a8[i]) + __shfl_xor(b4 ? a8[i] : a8[i + 4], 16);
#pragma unroll
    for (int i = 0; i < 2; ++i) a2[i] = (b3 ? a4[i + 2] : a4[i]) + __shfl_xor(b3 ? a4[i] : a4[i + 2], 8);
    f32x2_* xp = (f32x2_*)(X + (size_t)t * D + 128 * j + 16 * k + 2 * g);
    const f32x2_ xv = *xp; f32x2_ r; r.x = ALPHA * xv.x + a2[0]; r.y = ALPHA * xv.y + a2[1];
    *xp = r;
}
template <int NT>
__device__ __forceinline__ void peer_v_tokens(const unsigned char* TV, int j, int t0, const int* EXP, const float* COEF, float* X, int lane) {
    asm volatile("" : "+v"(lane) :: "memory");
    const int g = lane >> 3, k = lane & 7;
    const float* cb = COEF + 16 * g;
    PeerRows R0, R1; float cf[16], cn[16], o[16]; int idA[16], idB[16];
    peer_ld_ids(idA, EXP, t0, g); peer_ld_vec16(cf, cb + (size_t)t0 * 128);
    peer_ld_rows<0>(R0, TV, idA, k);
    peer_ld_ids(idB, EXP, t0 + 1, g);
#pragma unroll 1
    for (int i = 0; i < NT; ++i) {
        const int t = t0 + i, tn = (i + 1 < NT) ? t + 1 : t, tnn = (i + 2 < NT) ? t + 2 : t;
        peer_ld_rows<1>(R1, TV, idA, k);
        peer_ld_vec16(cn, cb + (size_t)tn * 128);
#pragma unroll
        for (int q = 0; q < 16; ++q) o[q] = 0.f;
        peer_v_half<0>(R0, cf, o);
        peer_ld_rows<0>(R0, TV, idB, k);
        peer_v_half<1>(R1, cf, o);
        peer_v_finish(o, X, j, t, lane);
#pragma unroll
        for (int q = 0; q < 16; ++q) { idA[q] = idB[q]; cf[q] = cn[q]; }
        peer_ld_ids(idB, EXP, tnn, g);
    }
}
__device__ __forceinline__ int wq_next(unsigned* head, volatile LAS unsigned* slot, int tid) {
    __syncthreads();
    if (tid == 0) *slot = __hip_atomic_fetch_add(head, 1u, __ATOMIC_RELAXED, __HIP_MEMORY_SCOPE_AGENT);
    __syncthreads();
    return (int)*slot;
}

constexpr int PH_PER_LAYER = 16, NPH = 1 + 2 * PH_PER_LAYER;

#define PHASE_ENV() KArgs ap = kargs(); unsigned char* const ws = ap->ws; const int tid = threadIdx.x, lane = tid & 63, wave = __builtin_amdgcn_readfirstlane(tid >> 6); \
    const int G = gridDim.x, bid = blockIdx.x, sub = ap->sub; (void)sub; (void)ws; (void)lane; (void)wave; (void)G; (void)bid
#define P_XB   ((bf16*)(ws + WS_XB))
#define P_HB   ((bf16*)(ws + WS_HB))
#define P_HS   ((float*)(ws + WS_HS))
#define P_CAT  ((bf16*)(ws + WS_CAT))
#define P_CKV  ((bf16*)(ws + WS_CKV))
#define P_SEL  ((unsigned short*)(ws + WS_SEL))
#define P_NSEL ((int*)(ws + WS_NSEL))
#define P_MQ   ((float*)(ws + WS_MQ))
#define P_MK   ((float*)(ws + WS_MK))
#define P_MC   ((float*)(ws + WS_MC))
#define P_MN   ((float*)(ws + WS_MN))
#define P_SCL  ((float*)(ws + WS_SCL))
#define P_BC   ((float*)(ws + WS_BC))
#define P_IG   ((float*)(ws + WS_IG))
#define P_QX   ((bf16*)(ws + WS_QX))
#define P_OX   ((bf16*)(ws + WS_OX))
#define P_QP   ((bf16*)(ws + WS_QP))

#ifndef ONLYSITE
#define SITE(j) true
#else
#define SITE(j) ((j) == ONLYSITE)
#endif
#define IN(k) (lo <= (k) && (k) < hi)
#define SEAM(k) do { if (IN(k) && IN((k) + 1)) xcd_barrier(bar); } while (0)


template <int l>
__device__ __forceinline__ void run_layer(LAS unsigned char* lds, const int lo, const int hi, const XcdBarrier& bar) {
        const int pb = 1 + PH_PER_LAYER * l;
        if (IN(pb + 0) && SITE(1)) {
            PHASE_ENV();
            {
                pg8::Gemm g{P_XB, (const bf16*)(ws + WS_WIN) + (size_t)l * HN * D, T, HN, D}; pg8::StaticOrder S; S.init(T, HN, G, bid);
                EpiH E{P_HB, P_HS};
                pg8::gemm_phase<EpiH, pg8::StaticOrder, true, true>(lds, g, S, E);
            }
            if (l == 0) {
                const int base = (G > 64) ? G - 64 : 0;
                for (int u = bid - base; u >= 0 && u < 32; u += G - base) {
                    const int l2 = u >> 4, kind = (u >> 3) & 1, unit = u & 7;
                    __syncthreads();
                    if (kind == 0) {
                        pg8::Gemm g2{(const bf16*)(ws + WS_MEMB), (const bf16*)(ws + WS_WCKV) + (size_t)l2 * 2048 * D, 512, 1024, D}; pg8::StaticOrder S2; S2.init(512, 1024, 8, unit);
                        EpiB16 E2{(bf16*)(ws + WS_KV) + (size_t)l2 * 512 * 1024, 1024};
                        pg8::gemm_phase<EpiB16, pg8::StaticOrder, true, true>(lds, g2, S2, E2);
                    } else {
                        pg8::Gemm g3{(const bf16*)(ws + WS_WCKV) + (size_t)l2 * 2048 * D + (size_t)1024 * D, (const bf16*)(ws + WS_MEMB), 1024, 512, D}; pg8::StaticOrder S3; S3.init(1024, 512, 8, unit);
                        EpiB16 E3{(bf16*)(ws + WS_KV) + (size_t)(2 + l2) * 512 * 1024, 512};
                        pg8::gemm_phase<EpiB16, pg8::StaticOrder, true, true>(lds, g3, S3, E3);
                    }
                }
            }
        }
        SEAM(pb + 0);
        if (IN(pb + 1) && SITE(2)) {
            PHASE_ENV();
            if (sub & 1) for (int tile = bid; tile < T / 64; tile += G)
                conv_unit(lds, tile, P_HB, ap->in[I_CAW] + (size_t)l * 31 * 256, ap->in[I_CAB] + l * 256, ap->in[I_NAG] + l * 256, ap->in[I_NAB] + l * 256, P_CAT, tid);
            if (sub & 2) {
                const float* kg = ap->in[I_KVG] + l * 128; const bf16* HB = P_HB; bf16* CKV = P_CKV;
                for (int t = bid * 8 + wave; t < T; t += G * 8) {
                    const float c0 = bf2f(HB[(size_t)t * HN + H_CB + lane]), c1 = bf2f(HB[(size_t)t * HN + H_CB + 64 + lane]);
                    const float r = rsqrtf(wave_sum(c0 * c0 + c1 * c1) * (1.f / 128.f) + LN_EPS);
                    CKV[(size_t)t * 128 + lane] = (bf16)f2bf(c0 * r * kg[lane]); CKV[(size_t)t * 128 + 64 + lane] = (bf16)f2bf(c1 * r * kg[64 + lane]);
                }
            }
            if (sub & 4) for (int cidx = bid; cidx < NCHUNK; cidx += G)
                mlstm_prep_unit(lds, cidx, P_HB, P_HS, ap->in[I_CMW] + (size_t)l * 4 * 256, ap->in[I_CMB] + l * 256, ap->in[I_WQM] + (size_t)l * 4 * 4096, ap->in[I_WKM] + (size_t)l * 4 * 4096,
                                ap->in[I_BI] + l * 4, ap->in[I_BF] + l * 4, P_MQ, P_MK, P_MC, P_MN, P_SCL, P_BC, P_IG, tid);
#ifdef NAIVE_INDEXER
            if (sub & 8) for (int t = bid; t < T; t += G) indexer_query(lds, t, P_HB, P_HS, P_SEL, P_NSEL, tid);
#else
            if (sub & 8) for (int pr = bid; pr < 256; pr += G) {
                const int b = pr >> 7, i0 = pr & 127;
                indexer_strip(lds, b, 255 - i0, P_HB, P_HS, P_SEL, P_NSEL, tid);
                indexer_strip(lds, b, i0, P_HB, P_HS, P_SEL, P_NSEL, tid);
            }
#endif
        }
        SEAM(pb + 1);
        if (IN(pb + 2) && SITE(3)) {
            PHASE_ENV();
            if ((sub & 1) && bid < 65) mlstm_scan(bid * 512 + tid, P_MC, P_MN, P_SCL);
#ifdef NAIVE_DSA
            if (sub & 2) for (int t = bid * 8 + wave; t < T; t += G * 8) dsa_attn_query(lds + wave * 16384, t, P_HB, P_CKV, P_SEL, P_NSEL, ap->in[I_RELB], P_CAT, lane);
#else
            if (sub & 2) {
                LAS float* relb_l = (LAS float*)(lds + 131072 + 1024);
                if (tid < 256) relb_l[tid] = ap->in[I_RELB][tid];
                __syncthreads();
                LAS int* slb = (LAS int*)(lds + 131072 + 2048 + wave * 1024);
                for (int t = bid * 8 + wave; t < T; t += G * 8) dsa_attn_mfma(lds + wave * 16384, slb, relb_l, t, P_HB, P_CKV, P_SEL, P_NSEL, P_CAT, lane);
            }
#endif
        }
        SEAM(pb + 2);
        if (IN(pb + 3) && SITE(4)) {
            PHASE_ENV();
            for (int cidx = bid; cidx < NCHUNK; cidx += G)
                mlstm_out_unit(lds, cidx, P_HB, P_MQ, P_MK, P_MC, P_MN, P_SCL, P_BC, P_IG, ap->in[I_NMG] + l * 256, P_CAT, tid);
        }
        SEAM(pb + 3);
        if (IN(pb + 4) && SITE(5)) {
            PHASE_ENV();
            pg8::Gemm g{P_CAT, (const bf16*)(ws + WS_WOUT) + (size_t)l * D * CATW, T, D, CATW}; pg8::StaticOrder S; S.init(T, D, G, bid);
            EpiResid E{ap->out, D, ALPHA};
            pg8::gemm_phase<EpiResid, pg8::StaticOrder, true, true>(lds, g, S, E);
        }
        SEAM(pb + 4);
        if (IN(pb + 5) && SITE(6)) {
            PHASE_ENV();
            float* X = ap->out; bf16* XB = P_XB; const float* g1 = ap->in[I_LN1G] + l * D; const float* b1 = ap->in[I_LN1B] + l * D;
            for (int m = bid * 8 + wave; m < T; m += G * 8) ln_row(X + (size_t)m * D, g1, b1, X + (size_t)m * D, XB + (size_t)m * D, lane);
        }
        SEAM(pb + 5);
        if (IN(pb + 6) && SITE(7)) {
            PHASE_ENV();
            pg8::Gemm g{P_XB, (const bf16*)(ws + WS_WCQ) + (size_t)l * D * D, T, D, D}; pg8::StaticOrder S; S.init(T, D, G, bid);
            EpiB16 E{P_QX, D};
            pg8::gemm_phase<EpiB16, pg8::StaticOrder, true, true>(lds, g, S, E);
        }
        SEAM(pb + 6);
        if (IN(pb + 7) && SITE(8)) {
            PHASE_ENV();
            const bf16* Kb = (const bf16*)(ws + WS_KV) + (size_t)l * 512 * 1024; const bf16* VT = (const bf16*)(ws + WS_KV) + (size_t)(2 + l) * 512 * 1024;
            for (int u = bid * 8 + wave; u < 2048; u += G * 8) xattn_unit(u, P_QX, Kb, VT, P_OX, lane);
        }
        SEAM(pb + 7);
        if (IN(pb + 8) && SITE(9)) {
            PHASE_ENV();
            pg8::Gemm g{P_OX, (const bf16*)(ws + WS_WCO) + (size_t)l * D * D, T, D, D}; pg8::StaticOrder S; S.init(T, D, G, bid);
            EpiResid E{ap->out, D, ALPHA};
            pg8::gemm_phase<EpiResid, pg8::StaticOrder, true, true>(lds, g, S, E);
        }
        SEAM(pb + 8);
        if (IN(pb + 9) && SITE(10)) {
            PHASE_ENV();
            float* X = ap->out; bf16* XB = P_XB; const float* g2 = ap->in[I_LN2G] + l * D; const float* b2 = ap->in[I_LN2B] + l * D;
            for (int m = bid * 8 + wave; m < T; m += G * 8) ln_row(X + (size_t)m * D, g2, b2, X + (size_t)m * D, XB + (size_t)m * D, lane);
        }
        SEAM(pb + 9);
        if (IN(pb + 10) && SITE(11)) {
            PHASE_ENV();
            pg8::Gemm g{P_XB, (const bf16*)(ws + WS_WPQ) + (size_t)l * 2048 * D, T, 2048, D}; pg8::StaticOrder S; S.init(T, 2048, G, bid);
            EpiB16 E{P_QP, 2048};
            pg8::gemm_phase<EpiB16, pg8::StaticOrder, true, true>(lds, g, S, E);
        }
        SEAM(pb + 10);
        if (IN(pb + 11) && SITE(12)) {
            PHASE_ENV();
            LAS unsigned char* sk = lds;
            const float* k1 = ap->in[I_SK1] + (size_t)l * 128 * 128; const float* k2 = ap->in[I_SK2] + (size_t)l * 128 * 128;
            for (int i = tid; i < 128 * 128; i += 512) { const int n = i >> 7, d = i & 127; const int off = n * 256 + ((((d >> 3) ^ (n & 15))) << 4) + (d & 7) * 2;
                *(LAS bf16*)(sk + off) = (bf16)f2bf(k1[i]); *(LAS bf16*)(sk + 32768 + off) = (bf16)f2bf(k2[i]); }
            __syncthreads();
            int* EXP = (int*)(ws + WS_EXP); float* GATE = (float*)(ws + WS_GATE);
            for (int u = bid * 8 + wave; u < T / 4; u += G * 8) { peer_route_unit(sk, u * 4, P_QP, EXP, GATE, lane); __builtin_amdgcn_sched_barrier(0); }
            __syncthreads();
        }
        SEAM(pb + 11);
        if (IN(pb + 12) && SITE(13)) {
            PHASE_ENV();
            volatile LAS unsigned* slot = (volatile LAS unsigned*)(lds + MISC_OFF) + 16;
            const int x0 = (int)(xb_xcc_id() & 7u);
            const int* EXP = (const int*)(ws + WS_EXP); const float* X = ap->out;
            for (int a = 0; a < 8; ++a) {
                const int j = (x0 + a) & 7;
                unsigned* head = (unsigned*)(ws + WS_CTL) + CW_QUEUE + ((l * 2 + 0) * 8 + j) * 64 + ((sub == -1) ? 0 : (sub & 7) * 2048);
                const unsigned char* TU = ws + WS_PU8 + (size_t)(l * 8 + j) * 16384 * 128;
                float* PDj = (float*)(ws + WS_PD) + (size_t)j * T * 128;
                for (;;) {
                    const int c = wq_next(head, slot, tid);
                    if (c >= T / 128) break;
                    peer_u_tokens<16>(TU, j, c * 128 + wave * 16, EXP, X, PDj, lane);
                }
            }
        }
        SEAM(pb + 12);
        if (IN(pb + 13) && SITE(14)) {
            PHASE_ENV();
            const int* EXP = (const int*)(ws + WS_EXP); const float* GATE = (const float*)(ws + WS_GATE); float* COEF = (float*)(ws + WS_COEF);
            const float* PD = (const float*)(ws + WS_PD);
            const float* SCU = (const float*)(ws + WS_PSC) + l * 16384; const float* SCV = (const float*)(ws + WS_PSC) + 32768 + l * 16384;
            for (int i = bid * 512 + tid; i < T * 128; i += G * 512) {
                const int e = EXP[i]; float z = 0.f;
#pragma unroll
                for (int j = 0; j < 8; ++j) z += PD[(size_t)j * T * 128 + i];
                COEF[i] = GATE[i] * SCV[e] * gelu_exact(z * SCU[e]);
            }
        }
        SEAM(pb + 13);
        if (IN(pb + 14) && SITE(15)) {
            PHASE_ENV();
            volatile LAS unsigned* slot = (volatile LAS unsigned*)(lds + MISC_OFF) + 16;
            const int x0 = (int)(xb_xcc_id() & 7u);
            const int* EXP = (const int*)(ws + WS_EXP); const float* COEF = (const float*)(ws + WS_COEF); float* X = ap->out;
            for (int a = 0; a < 8; ++a) {
                const int j = (x0 + a) & 7;
                unsigned* head = (unsigned*)(ws + WS_CTL) + CW_QUEUE + ((l * 2 + 1) * 8 + j) * 64;
                const unsigned char* TV = ws + WS_PV8 + (size_t)(l * 8 + j) * 16384 * 128;
                for (;;) {
                    const int c = wq_next(head, slot, tid);
                    if (c >= T / 128) break;
                    peer_v_tokens<16>(TV, j, c * 128 + wave * 16, EXP, COEF, X, lane);
                }
            }
        }
        SEAM(pb + 14);
        if (IN(pb + 15) && SITE(16)) {
            PHASE_ENV();
            float* X = ap->out; bf16* XB = P_XB; const float* g3 = ap->in[I_LN3G] + l * D; const float* b3 = ap->in[I_LN3B] + l * D;
            for (int m = bid * 8 + wave; m < T; m += G * 8) ln_row(X + (size_t)m * D, g3, b3, X + (size_t)m * D, XB + (size_t)m * D, lane);
        }
        SEAM(pb + 15);
}

__global__ void __launch_bounds__(512, 2) fwd(Args a_unused) {
    extern __shared__ __attribute__((aligned(16))) unsigned char lds_raw[];
    LAS unsigned char* lds = (LAS unsigned char*)lds_raw;
    volatile LAS unsigned* MISC = (volatile LAS unsigned*)(lds + MISC_OFF);
    if (threadIdx.x < 32) MISC[threadIdx.x] = 0u;
    __syncthreads();
    int lo, hi;
    XcdBarrier bar;
    { KArgs ap = kargs(); lo = ap->lo; hi = ap->hi; bar = xcd_barrier_post((unsigned*)(ap->ws + WS_CTL) + 4096 + ap->li * XCD_BAR_WORDS, MISC + 8); }
    if (IN(0) && SITE(0)) { p0_prologue(lds, threadIdx.x, gridDim.x, blockIdx.x); }
    SEAM(0);

    run_layer<0>(lds, lo, hi, bar);
    run_layer<1>(lds, lo, hi, bar);
#undef IN
#undef SEAM
}

extern "C" void kernel_launch(void* const* d_in, const int* in_sizes, int n_in, void* d_out, int out_size, void* d_ws, size_t ws_size, hipStream_t stream) {
    static int grid = 0;
    if (grid == 0) {
        if (n_in != 35 || out_size != T * D || ws_size < WS_END) { fprintf(stderr, "kernel_launch: unexpected shapes (n_in %d, out %d, ws %zu)\n", n_in, out_size, ws_size); grid = -1; return; }
        int dev = 0, cus = 0, per_cu = 0;
        if (hipGetDevice(&dev) != hipSuccess || hipDeviceGetAttribute(&cus, hipDeviceAttributeMultiprocessorCount, dev) != hipSuccess) { grid = -1; return; }
        if (hipFuncSetAttribute((const void*)fwd, hipFuncAttributeMaxDynamicSharedMemorySize, LDS_BYTES) != hipSuccess) { fprintf(stderr, "kernel_launch: hipFuncSetAttribute failed\n"); grid = -1; return; }
        if (hipOccupancyMaxActiveBlocksPerMultiprocessor(&per_cu, (const void*)fwd, 512, LDS_BYTES) != hipSuccess || per_cu < 1) fprintf(stderr, "kernel_launch: occupancy query reports %d\n", per_cu);
        (void)hipGetLastError();
        grid = cus;
    }
    if (grid < 0) return;
    (void)hipMemsetAsync((char*)d_ws + WS_CTL, 0, CTL_ZERO_BYTES, stream);
    Args a{};
    for (int i = 0; i < 35; ++i) a.in[i] = (const float*)d_in[i];
    a.out = (float*)d_out; a.ws = (unsigned char*)d_ws;
#if MK_SINGLE
    a.lo = 0; a.hi = NPH; a.li = 0; a.sub = -1;
    hipLaunchKernelGGL(fwd, dim3(grid), dim3(512), LDS_BYTES, stream, a);
#else
#ifndef PROBE_PHASE
#define PROBE_PHASE -1
#endif
#ifndef PROBE_EXTRA
#define PROBE_EXTRA 0
#endif
#ifndef PROBE_SUB
#define PROBE_SUB -1
#endif
    for (int p = 0; p < NPH; ++p) {
        a.lo = p; a.hi = p + 1; a.li = 0; a.sub = -1; hipLaunchKernelGGL(fwd, dim3(grid), dim3(512), LDS_BYTES, stream, a);
        if (p == PROBE_PHASE) for (int e = 0; e < PROBE_EXTRA; ++e) { a.sub = (PROBE_SUB == -2) ? (e + 1) : PROBE_SUB; hipLaunchKernelGGL(fwd, dim3(grid), dim3(512), LDS_BYTES, stream, a); }
    }
#endif
}
```
